# Optimizing an MI355X kernel written in HIP

```python
import jax, jax.numpy as jnp
from jax import lax
import numpy as np

D_MODEL = 1024
BATCH = 16
SEQ = 2048
DEPTH = 1

D_CONV = 1024
CONV_WIDTH = 31
RWKV_HEAD = 64
RWKV_HEADS = D_MODEL // RWKV_HEAD
D_RWKV = RWKV_HEADS * RWKV_HEAD
DECAY_LORA = 64
AAA_LORA = 64
TS_WIDTH = 3 * D_RWKV + DECAY_LORA + AAA_LORA
SPLITS = (D_CONV, 2 * D_CONV, 3 * D_CONV, 3 * D_CONV + TS_WIDTH, 3 * D_CONV + TS_WIDTH + D_RWKV, 3 * D_CONV + TS_WIDTH + D_RWKV + D_MODEL)
D_IN = 3 * D_CONV + TS_WIDTH + D_RWKV + 2 * D_MODEL
RWKV_SPLITS = (D_RWKV, 2 * D_RWKV, 3 * D_RWKV, 3 * D_RWKV + DECAY_LORA)

RMS_EPS = 1e-6
LN_EPS = 1e-5
GN_EPS = 64e-5
L2_EPS = 1e-12

kernel_name = 'hybrid_conformer_conv_rwkv7_adaln'


def _rmsnorm(x, g):
    xf = x.astype(jnp.float32)
    y = xf * lax.rsqrt(jnp.mean(xf * xf, axis=-1, keepdims=True) + RMS_EPS)
    return (y * g.astype(jnp.float32)).astype(x.dtype)


def _layernorm(x, g, b, eps):
    xf = x.astype(jnp.float32)
    mu = jnp.mean(xf, axis=-1, keepdims=True)
    var = jnp.mean(jnp.square(xf - mu), axis=-1, keepdims=True)
    y = (xf - mu) * lax.rsqrt(var + eps) * g.astype(jnp.float32) + b.astype(jnp.float32)
    return y.astype(x.dtype)


def _causal_depthwise_conv(u, w, b):
    y = lax.conv_general_dilated(
        u, w[:, None, :].astype(u.dtype), window_strides=(1,),
        padding=((CONV_WIDTH - 1, 0),), dimension_numbers=('NWC', 'WIO', 'NWC'),
        feature_group_count=u.shape[-1])
    return y + b


def _token_shift(z, mu):
    prev = jnp.pad(z, ((0, 0), (1, 0), (0, 0)))[:, :-1]
    return z + mu * (prev - z)


def _rwkv7_scan(r, decay, k, v, kk, b):
    bsz, _, h, n = r.shape

    def step(state, inp):
        r_t, w_t, k_t, v_t, kk_t, b_t = inp
        sk = jnp.einsum('bhvk,bhk->bhv', state, kk_t)
        state = (state * w_t[:, :, None, :] - sk[..., None] * b_t[:, :, None, :]
                 + v_t[..., None] * k_t[:, :, None, :])
        return state, jnp.einsum('bhvk,bhk->bhv', state, r_t)

    xs = tuple(jnp.moveaxis(t, 1, 0) for t in (r, decay, k, v, kk, b))
    s0 = jnp.zeros((bsz, h, n, n), jnp.float32)
    _, out = lax.scan(step, s0, xs)
    return jnp.moveaxis(out, 0, 1)


def _rwkv7_branch(ts, og, mu, w0, w2, a0, a2, k_k, k_a, r_k, gn_g, gn_b, w_o):
    f32 = jnp.float32
    bsz, seq, _ = ts.shape
    hd = (bsz, seq, RWKV_HEADS, RWKV_HEAD)
    r, k, v, w_low, a_low = jnp.split(_token_shift(ts, mu), RWKV_SPLITS, axis=-1)
    w_pre = (w0 + jnp.tanh(w_low) @ w2).astype(f32)
    decay = jnp.exp(-jnp.exp(-jax.nn.softplus(-w_pre) - 0.5))
    a = jax.nn.sigmoid((a0 + a_low @ a2).astype(f32))
    kk = (k * k_k).astype(f32).reshape(hd)
    kk = kk / jnp.maximum(jnp.sqrt(jnp.sum(kk * kk, axis=-1, keepdims=True)), L2_EPS)
    k = (k.astype(f32) * (1.0 + (a - 1.0) * k_a.astype(f32))).reshape(hd)
    r = r.astype(f32).reshape(hd)
    v = v.astype(f32).reshape(hd)
    a = a.reshape(hd)
    o = _rwkv7_scan(r, decay.reshape(hd), k, v, kk, kk * a)
    o = _layernorm(o, gn_g.reshape(RWKV_HEADS, RWKV_HEAD), gn_b.reshape(RWKV_HEADS, RWKV_HEAD), GN_EPS)
    o = o + jnp.sum(r * k * r_k.astype(f32), axis=-1, keepdims=True) * v
    o = o.reshape(bsz, seq, D_RWKV).astype(og.dtype) * jax.nn.silu(og)
    return o @ w_o


def _conv_branch(val, gate, og, conv_k, conv_b, ln_g, ln_b, w_o):
    u = val * jax.nn.sigmoid(gate)
    u = _causal_depthwise_conv(u, conv_k, conv_b)
    u = _layernorm(u, ln_g, ln_b, LN_EPS)
    u = jax.nn.silu(u) * jax.nn.silu(og)
    return u @ w_o


def setup_inputs(seed: int = 0) -> dict:
    key = jax.random.key(seed)
    ks = jax.random.split(key, 24)
    f32 = jnp.float32
    nrm = lambda k, shape, s: jax.random.normal(k, shape, f32) * s
    L = DEPTH
    return {
        'x': nrm(ks[0], (BATCH, SEQ, D_MODEL), 1.0),
        'c': nrm(ks[1], (BATCH, D_MODEL), 1.0),
        'ada_w': nrm(ks[2], (L, D_MODEL, 3 * D_MODEL), 0.5 * D_MODEL ** -0.5),
        'ada_b': nrm(ks[3], (L, 3 * D_MODEL), 0.01),
        'norm_g': 1.0 + nrm(ks[4], (L, D_MODEL), 0.1),
        'w_in': nrm(ks[5], (L, D_MODEL, D_IN), D_MODEL ** -0.5),
        'conv_k': nrm(ks[6], (L, CONV_WIDTH, D_CONV), CONV_WIDTH ** -0.5),
        'conv_b': nrm(ks[7], (L, D_CONV), 0.01),
        'conv_ln_g': 1.0 + nrm(ks[8], (L, D_CONV), 0.1),
        'conv_ln_b': nrm(ks[9], (L, D_CONV), 0.01),
        'w_conv_out': nrm(ks[10], (L, D_CONV, D_MODEL), D_CONV ** -0.5),
        'rwkv_mu': jax.random.uniform(ks[11], (L, TS_WIDTH), f32, 0.0, 1.0),
        'rwkv_w0': jax.random.uniform(ks[12], (L, D_RWKV), f32, -6.0, -1.0),
        'rwkv_w2': nrm(ks[13], (L, DECAY_LORA, D_RWKV), 0.1 * DECAY_LORA ** -0.5),
        'rwkv_a0': nrm(ks[14], (L, D_RWKV), 0.1),
        'rwkv_a2': nrm(ks[15], (L, AAA_LORA, D_RWKV), 0.5 * AAA_LORA ** -0.5),
        'rwkv_k_k': 0.85 + nrm(ks[16], (L, D_RWKV), 0.05),
        'rwkv_k_a': 1.0 + nrm(ks[17], (L, D_RWKV), 0.05),
        'rwkv_r_k': nrm(ks[18], (L, RWKV_HEADS, RWKV_HEAD), 0.1),
        'rwkv_gn_g': 1.0 + nrm(ks[19], (L, D_RWKV), 0.1),
        'rwkv_gn_b': nrm(ks[20], (L, D_RWKV), 0.01),
        'w_rwkv_out': nrm(ks[21], (L, D_RWKV, D_MODEL), D_RWKV ** -0.5),
        'w_out': nrm(ks[22], (L, D_MODEL, D_MODEL), D_MODEL ** -0.5),
        'final_g': 1.0 + nrm(ks[23], (D_MODEL,), 0.1),
    }


def reference(x, c, ada_w, ada_b, norm_g, w_in, conv_k, conv_b, conv_ln_g, conv_ln_b, w_conv_out,
              rwkv_mu, rwkv_w0, rwkv_w2, rwkv_a0, rwkv_a2, rwkv_k_k, rwkv_k_a, rwkv_r_k,
              rwkv_gn_g, rwkv_gn_b, w_rwkv_out, w_out, final_g):
    for l in range(DEPTH):
        mod = jnp.einsum('bd,de->be', jax.nn.silu(c), ada_w[l]) + ada_b[l]
        shift, scale, gate = jnp.split(mod, 3, axis=-1)
        h = _rmsnorm(x, norm_g[l]) * (1.0 + scale[:, None, :]) + shift[:, None, :]
        p = jnp.einsum('bsd,de->bse', h, w_in[l])
        c_val, c_gate, c_og, ts, r_og, g_conv, g_rwkv = jnp.split(p, SPLITS, axis=-1)
        y_conv = _conv_branch(c_val, c_gate, c_og, conv_k[l], conv_b[l], conv_ln_g[l], conv_ln_b[l],
                              w_conv_out[l])
        y_rwkv = _rwkv7_branch(ts, r_og, rwkv_mu[l], rwkv_w0[l], rwkv_w2[l], rwkv_a0[l], rwkv_a2[l],
                               rwkv_k_k[l], rwkv_k_a[l], rwkv_r_k[l], rwkv_gn_g[l], rwkv_gn_b[l],
                               w_rwkv_out[l])
        m = jax.nn.sigmoid(g_conv) * y_conv + jax.nn.sigmoid(g_rwkv) * y_rwkv
        out = jnp.einsum('bsd,de->bse', m, w_out[l])
        x = x + gate[:, None, :] * out
    return _rmsnorm(x, final_g)
```

```cpp
#include <hip/hip_runtime.h>
#include <hip/hip_cooperative_groups.h>
#include <cstdio>
namespace cg = cooperative_groups;

#ifndef SINGLE_LAUNCH
#define SINGLE_LAUNCH 1
#endif

#define LAS __attribute__((address_space(3)))
typedef unsigned short bf16_t;
typedef short bf16x8 __attribute__((ext_vector_type(8)));
typedef float f32x8 __attribute__((ext_vector_type(8)));
typedef float f32x4 __attribute__((ext_vector_type(4)));
typedef float f32x2 __attribute__((ext_vector_type(2)));
typedef unsigned u32x4 __attribute__((ext_vector_type(4)));
typedef unsigned u32x2 __attribute__((ext_vector_type(2)));

constexpr int T = 32768, DM = 1024, SEQ = 2048, NB_ = 16;
constexpr int N1 = 9472;
constexpr int LDR = 3328;
constexpr int LDS_BYTES = 131072;
constexpr int NPHASE = 9;

constexpr size_t MiB = 1u << 20;
constexpr size_t OFF_U = 0, OFF_OGC = 64 * MiB, OFF_RKVL = 128 * MiB, OFF_OGR = 336 * MiB, OFF_GC = 400 * MiB, OFF_WINT = 464 * MiB;
constexpr size_t OFF_ALORA = OFF_WINT + (size_t)N1 * 1024 * 2;
constexpr size_t OFF_W2T = OFF_ALORA + 16 * MiB, OFF_WOT = OFF_W2T + 4 * MiB, OFF_LBT = OFF_WOT + 2 * MiB, OFF_MOD = OFF_LBT + 1 * MiB;
constexpr size_t OFF_BAR = OFF_MOD + 16 * 3072 * 4;
constexpr size_t WS_END = OFF_BAR + 3456 * 4;
constexpr size_t OFF_MP = OFF_RKVL, OFF_M = OFF_RKVL + 128 * MiB, OFF_DW = OFF_U;

struct Params {
    const float *x, *c, *ada_w, *ada_b, *norm_g, *w_in, *conv_k, *conv_b, *conv_ln_g, *conv_ln_b, *w_conv_out, *rwkv_mu, *rwkv_w0, *rwkv_w2, *rwkv_a0, *rwkv_a2,
        *rwkv_k_k, *rwkv_k_a, *rwkv_r_k, *rwkv_gn_g, *rwkv_gn_b, *w_rwkv_out, *w_out, *final_g;
    float* out;
    unsigned char* ws;
};

typedef __bf16 bf16x2_t __attribute__((ext_vector_type(2)));
__device__ __forceinline__ unsigned cvt_pk_bf16(float lo, float hi) { const bf16x2_t r = __builtin_convertvector((f32x2){lo, hi}, bf16x2_t); return __builtin_bit_cast(unsigned, r); }
__device__ __forceinline__ bf16_t f2bf(float f) { return (bf16_t)(cvt_pk_bf16(f, 0.f) & 0xffffu); }
__device__ __forceinline__ float bf2f(bf16_t b) { return __uint_as_float(((unsigned)b) << 16); }
__device__ __forceinline__ float bflo(unsigned v) { return __uint_as_float(v << 16); }
__device__ __forceinline__ float bfhi(unsigned v) { return __uint_as_float(v & 0xffff0000u); }
__device__ __forceinline__ float sigm(float x) { return __builtin_amdgcn_rcpf(1.f + __expf(-x)); }
__device__ __forceinline__ int tid_opaque() { int t = threadIdx.x; asm volatile("" : "+v"(t)); return t; }
__device__ __forceinline__ unsigned char* uniform_ptr(unsigned char* p) { const size_t v = (size_t)p; const unsigned lo = __builtin_amdgcn_readfirstlane((unsigned)v), hi = __builtin_amdgcn_readfirstlane((unsigned)(v >> 32)); return (unsigned char*)(((size_t)hi << 32) | lo); }
template <int CTRL> __device__ __forceinline__ float dpp_add(float v) { return v + __int_as_float(__builtin_amdgcn_update_dpp(0, __float_as_int(v), CTRL, 0xF, 0xF, true)); }
__device__ __forceinline__ float wave_sum(float v) {
    v = dpp_add<0xB1>(v); v = dpp_add<0x4E>(v); v = dpp_add<0x141>(v); v = dpp_add<0x140>(v);
    const int iv = __float_as_int(v);
    return (__int_as_float(__builtin_amdgcn_readlane(iv, 0)) + __int_as_float(__builtin_amdgcn_readlane(iv, 16))) + (__int_as_float(__builtin_amdgcn_readlane(iv, 32)) + __int_as_float(__builtin_amdgcn_readlane(iv, 48)));
}

#define XB_TMO      128
#define XB_XCNT(j)  (256  + 64 * (j))
#define XB_XSUB(j)  (1280 + 64 * (j))
#define XB_XGEN(j)  (2304 + 64 * (j))
#define XB_TOP      3328
#define XB_TOPGEN   3392
#define XB_WORDS    3456
#define XB_SPIN_CAP (1u << 22)
__device__ __forceinline__ unsigned xb_ld(unsigned* p)              { return __hip_atomic_load(p, __ATOMIC_RELAXED, __HIP_MEMORY_SCOPE_AGENT); }
__device__ __forceinline__ unsigned xb_add(unsigned* p, unsigned v) { return __hip_atomic_fetch_add(p, v, __ATOMIC_RELAXED, __HIP_MEMORY_SCOPE_AGENT); }
__device__ __forceinline__ unsigned xb_xcc_id() { return (unsigned)__builtin_amdgcn_s_getreg((3 << 11) | 20) & 0xFu; }
#define XB_SPIN(cond, bar) do { unsigned _sp = 0; while (cond) { __builtin_amdgcn_s_sleep(1); \
    if ((++_sp & 255u) == 0u) { if (xb_ld(&(bar)[XB_TMO])) break; if (_sp > XB_SPIN_CAP) { atomicAdd(&(bar)[XB_TMO], 1u); break; } } } } while (0)
__device__ __forceinline__ void xcd_barrier_complete(unsigned* bar, unsigned x, unsigned& nloc, unsigned& nx) {
    const unsigned G = gridDim.x; unsigned sum, cnt, mine, sp = 0u;
    for (;;) { sum = 0u; cnt = 0u; mine = 0u;
#pragma unroll
        for (unsigned j = 0; j < 16; ++j) { const unsigned c = xb_ld(&bar[XB_XCNT(j)]); sum += c; cnt += (c > 0u) ? 1u : 0u; mine = (j == x) ? c : mine; }
        if (sum == G) break;
        __builtin_amdgcn_s_sleep(1);
        if ((++sp & 255u) == 0u) { if (xb_ld(&bar[XB_TMO])) break; if (sp > XB_SPIN_CAP) { atomicAdd(&bar[XB_TMO], 1u); break; } } }
    nloc = mine > 0u ? mine : 1u; nx = cnt > 0u ? cnt : 1u;
}
__device__ __forceinline__ void grid_barrier(unsigned* bar, volatile LAS unsigned* st) {
    asm volatile("s_waitcnt vmcnt(0) lgkmcnt(0)" ::: "memory");
    __syncthreads();
    if (threadIdx.x == 0) {
        const unsigned x = xb_xcc_id();
        unsigned nloc = st[0], nx = st[1];
        if (nloc == 0u) { xcd_barrier_complete(bar, x, nloc, nx); st[0] = nloc; st[1] = nx; }
        const unsigned old = xb_add(&bar[XB_XSUB(x)], 1u);
        const unsigned gen = old / nloc;
        if (old + 1u == (gen + 1u) * nloc) {
            __builtin_amdgcn_fence(__ATOMIC_RELEASE, "agent");
            asm volatile("s_waitcnt vmcnt(0)" ::: "memory");
            const unsigned og = xb_add(&bar[XB_TOP], 1u);
            const unsigned tg = og / nx;
            if (og + 1u == (tg + 1u) * nx) xb_add(&bar[XB_TOPGEN], 1u);
            else XB_SPIN(xb_ld(&bar[XB_TOPGEN]) == tg, bar);
            __builtin_amdgcn_fence(__ATOMIC_ACQUIRE, "agent");
            xb_add(&bar[XB_XGEN(x)], 1u);
            asm volatile("s_waitcnt vmcnt(0)" ::: "memory");
        } else {
            XB_SPIN(xb_ld(&bar[XB_XGEN(x)]) == gen, bar);
            __builtin_amdgcn_fence(__ATOMIC_ACQUIRE, "agent");
            asm volatile("s_waitcnt vmcnt(0)" ::: "memory");
        }
    }
    __syncthreads();
}

namespace pg8 {
constexpr int BM = 256, BK = 64, HALF = 128, HTB = HALF * BK * 2, NXCD = 8, WGM = 8;
__host__ __device__ __forceinline__ int lds_byte(int r, int c) { const int st = (r >> 4) * 2 + (c >> 5), rr = r & 15, cc = c & 31, ob = rr * 64 + cc * 2; return st * 1024 + (ob ^ (((ob >> 9) & 1) << 5)); }
__host__ __device__ __forceinline__ void stage_rc(int b, int& R, int& C) { const int st = b / 1024, sb = b % 1024, swz = sb ^ (((sb >> 9) & 1) << 5); R = (st >> 1) * 16 + swz / 64; C = (st & 1) * 32 + (swz % 64) / 2; }
__host__ __device__ __forceinline__ int perm32(int rho) { const int n = rho >> 4, i = rho & 15; return 8 * (i >> 2) + 4 * n + (i & 3); }
struct Unit { int pm, pn, kind; };

__device__ __forceinline__ void map_unit(int L, int nM, int nN, Unit& u) {
    const int nwg = nM * nN; int wgid = L;
    { const int q = nwg / NXCD, r = nwg % NXCD, xcd = wgid % NXCD, off = wgid / NXCD; wgid = (xcd < r ? xcd * (q + 1) : r * (q + 1) + (xcd - r) * q) + off; }
    const int nig = WGM * nN, gid = wgid / nig, fm = gid * WGM, gsz = (nM - fm) < WGM ? (nM - fm) : WGM;
    u.pm = fm + ((wgid % nig) % gsz); u.pn = (wgid % nig) / gsz;
}
struct Sched1 {
    int nM, nN, G, c; const char* A; const char* Bt; size_t tstep;
    __device__ __forceinline__ bool next(int i, Unit& u) const { const long L = (long)i * G + c; if (L >= (long)nM * nN) return false; map_unit((int)L, nM, nN, u); u.kind = 0; return true; }
    __device__ __forceinline__ const char* aptr(const Unit& u) const { return A + (size_t)u.pm * tstep; }
    __device__ __forceinline__ const char* bptr(const Unit& u) const { return Bt + (size_t)u.pn * tstep; }
};
struct Sched2 {
    int nM, nN, G, c; const char* A0; const char* A1; const char* B0; const char* B1; size_t tstep;
    __device__ __forceinline__ bool next(int i, Unit& u) const { const long L = (long)(i >> 1) * G + c; if (L >= (long)nM * nN) return false; map_unit((int)L, nM, nN, u); u.kind = i & 1; return true; }
    __device__ __forceinline__ const char* aptr(const Unit& u) const { return (u.kind ? A1 : A0) + (size_t)u.pm * tstep; }
    __device__ __forceinline__ const char* bptr(const Unit& u) const { return (u.kind ? B1 : B0) + (size_t)u.pn * tstep; }
};

template <class Epi, class Sched>
__device__ __forceinline__ void gemm_phase(LAS unsigned char* lds, const int K, const Sched& S, const Epi& E) {
    const int tid = tid_opaque(), wid = __builtin_amdgcn_readfirstlane(tid >> 6), lane = tid & 63, wr = wid >> 2, wc = wid & 3, fr = lane & 15, fq = lane >> 4;
    const int nt = K / BK;
    unsigned voffA[2], voffB[2];
#pragma unroll
    for (int i = 0; i < 2; ++i) { int R, C; stage_rc(tid * 16 + i * 8192, R, C); const int Rb = Epi::PERM ? ((R & ~31) + perm32(R & 31)) : R;
        voffA[i] = (unsigned)(R * K + C) * 2u; voffB[i] = (unsigned)(Rb * K + C) * 2u; }
    const size_t kstep = (size_t)(BK * 2);
    const size_t hstep = (size_t)HALF * K * 2;
    const unsigned ldsw = (unsigned)wid * 1024u;
    const int aoff = lds_byte(wr * 64 + fr, fq * 8), boff = lds_byte(wc * 32 + fr, fq * 8);
#define PG8_SA(b, h) (((b) * 2 + (h)) * HTB)
#define PG8_SB(b, h) ((4 + (b) * 2 + (h)) * HTB)
#define PG8_STAGE(bufoff, gbase, voff) do { _Pragma("unroll") for (int _i = 0; _i < 2; ++_i) \
        __builtin_amdgcn_global_load_lds((const unsigned*)((const char*)(gbase) + (voff)[_i]), (LAS unsigned*)(lds + (bufoff) + ldsw + _i * 8192), 16, 0, 0); } while (0)
#define PG8_LDA(dst, b, h) do { _Pragma("unroll") for (int m = 0; m < 4; ++m) _Pragma("unroll") for (int k = 0; k < 2; ++k) dst[m][k] = *(const LAS bf16x8*)(lds + PG8_SA(b, h) + aoff + m * 2048 + k * 1024); } while (0)
#define PG8_LDB(dst, b, h) do { _Pragma("unroll") for (int n = 0; n < 2; ++n) _Pragma("unroll") for (int k = 0; k < 2; ++k) dst[n][k] = *(const LAS bf16x8*)(lds + PG8_SB(b, h) + boff + n * 2048 + k * 1024); } while (0)
#define PG8_MMA(ai, bj, At, Bt) do { __builtin_amdgcn_s_setprio(1); _Pragma("unroll") for (int m = 0; m < 4; ++m) _Pragma("unroll") for (int n = 0; n < 2; ++n) _Pragma("unroll") for (int k = 0; k < 2; ++k) \
        acc[ai][bj][m][n] = __builtin_amdgcn_mfma_f32_16x16x32_bf16(Bt[n][k], At[m][k], acc[ai][bj][m][n], 0, 0, 0); __builtin_amdgcn_s_setprio(0); } while (0)
#define PG8_WAIT_V(n) asm volatile("s_waitcnt vmcnt(" #n ")" ::: "memory")
#define PG8_WAIT_L(n) asm volatile("s_waitcnt lgkmcnt(" #n ")" ::: "memory")
#define PG8_BAR __builtin_amdgcn_s_barrier()
#define PG8_SCHED __builtin_amdgcn_sched_barrier(0)
    Unit cur, nxt; int ui = 0;
    if (!S.next(0, cur)) return;
    f32x4 acc[2][2][4][2];
#pragma unroll
    for (int a = 0; a < 2; ++a)
#pragma unroll
        for (int b = 0; b < 2; ++b)
#pragma unroll
            for (int m = 0; m < 4; ++m)
#pragma unroll
                for (int n = 0; n < 2; ++n) acc[a][b][m][n] = (f32x4){0.f, 0.f, 0.f, 0.f};
    bf16x8 At[4][2], B0[2][2], B1[2][2];
    const char* cA = S.aptr(cur); const char* cB = S.bptr(cur);
    PG8_STAGE(PG8_SB(0, 0), cB, voffB); PG8_STAGE(PG8_SA(0, 0), cA, voffA); PG8_STAGE(PG8_SB(0, 1), cB + hstep, voffB); PG8_STAGE(PG8_SA(0, 1), cA + hstep, voffA);
    if (wr == 1) PG8_BAR;
    PG8_WAIT_V(4); PG8_BAR;
    PG8_STAGE(PG8_SB(1, 0), cB + kstep, voffB); PG8_STAGE(PG8_SA(1, 0), cA + kstep, voffA); PG8_STAGE(PG8_SB(1, 1), cB + hstep + kstep, voffB);
    PG8_WAIT_V(6); PG8_BAR;
    for (;;) {
        const bool has_next = S.next(ui + 1, nxt);
        const char* nA = has_next ? S.aptr(nxt) : cA; const char* nB = has_next ? S.bptr(nxt) : cB;
        for (int t = 0; t < nt; t += 2) {
            const bool last = (t == nt - 2);
            const char* a1 = cA + (size_t)(t + 1) * kstep;
            const char* a2 = last ? nA : cA + (size_t)(t + 2) * kstep; const char* b2 = last ? nB : cB + (size_t)(t + 2) * kstep;
            const char* a3 = a2 + kstep; const char* b3 = b2 + kstep;
            PG8_LDB(B0, 0, 0); PG8_SCHED; PG8_LDA(At, 0, 0); PG8_STAGE(PG8_SA(1, 1), a1 + hstep, voffA);
            PG8_WAIT_L(8); PG8_BAR; PG8_WAIT_L(0); PG8_MMA(0, 0, At, B0); PG8_BAR; PG8_SCHED;
            PG8_LDB(B1, 0, 1); PG8_STAGE(PG8_SB(0, 0), b2, voffB);
            PG8_BAR; PG8_WAIT_L(0); PG8_MMA(0, 1, At, B1); PG8_BAR;
            PG8_LDA(At, 0, 1); PG8_STAGE(PG8_SA(0, 0), a2, voffA);
            PG8_BAR; PG8_WAIT_L(0); PG8_MMA(1, 0, At, B0); PG8_BAR; PG8_SCHED;
            PG8_STAGE(PG8_SB(0, 1), b2 + hstep, voffB);
            PG8_WAIT_V(6); PG8_BAR; PG8_MMA(1, 1, At, B1); PG8_BAR;
            PG8_LDB(B0, 1, 0); PG8_SCHED; PG8_LDA(At, 1, 0); PG8_STAGE(PG8_SA(0, 1), a2 + hstep, voffA);
            PG8_WAIT_L(8); PG8_BAR; PG8_WAIT_L(0); PG8_MMA(0, 0, At, B0); PG8_BAR; PG8_SCHED;
            PG8_LDB(B1, 1, 1); PG8_STAGE(PG8_SB(1, 0), b3, voffB);
            PG8_BAR; PG8_WAIT_L(0); PG8_MMA(0, 1, At, B1); PG8_BAR;
            PG8_LDA(At, 1, 1); PG8_STAGE(PG8_SA(1, 0), a3, voffA);
            PG8_BAR; PG8_WAIT_L(0); PG8_MMA(1, 0, At, B0); PG8_BAR; PG8_SCHED;
            PG8_STAGE(PG8_SB(1, 1), b3 + hstep, voffB);
            PG8_WAIT_V(6); PG8_BAR; PG8_MMA(1, 1, At, B1); PG8_BAR;
        }
        E(acc, cur, wr, wc, fr, fq);
        if (!has_next) break;
        if (!E.keep(cur)) {
#pragma unroll
        for (int a = 0; a < 2; ++a)
#pragma unroll
            for (int b = 0; b < 2; ++b)
#pragma unroll
                for (int m = 0; m < 4; ++m)
#pragma unroll
                    for (int n = 0; n < 2; ++n) acc[a][b][m][n] = (f32x4){0.f, 0.f, 0.f, 0.f};
        }
        cur = nxt; cA = nA; cB = nB; ++ui;
    }
    PG8_WAIT_V(0);
    if (wr == 0) PG8_BAR;
    PG8_BAR;
#undef PG8_SA
#undef PG8_SB
#undef PG8_STAGE
#undef PG8_LDA
#undef PG8_LDB
#undef PG8_MMA
#undef PG8_WAIT_V
#undef PG8_WAIT_L
#undef PG8_BAR
#undef PG8_SCHED
}
}
using pg8::Unit;

template <int ACT> __device__ __forceinline__ float actf(float v) { return ACT == 1 ? v * sigm(v) : (ACT == 2 ? sigm(v) : v); }
template <int ACT> __device__ __forceinline__ void store_tile_bf16(const f32x4 (&acc)[2][2][4][2], bf16_t* base  , int ld) {
#pragma unroll
    for (int ai = 0; ai < 2; ++ai)
#pragma unroll
        for (int m = 0; m < 4; ++m) { bf16_t* rowp = base + (size_t)(ai * 128 + m * 16) * ld;
#pragma unroll
            for (int bj = 0; bj < 2; ++bj) { const f32x4 v0 = acc[ai][bj][m][0], v1 = acc[ai][bj][m][1]; u32x4 w;
                w.x = cvt_pk_bf16(actf<ACT>(v0[0]), actf<ACT>(v0[1])); w.y = cvt_pk_bf16(actf<ACT>(v0[2]), actf<ACT>(v0[3]));
                w.z = cvt_pk_bf16(actf<ACT>(v1[0]), actf<ACT>(v1[1])); w.w = cvt_pk_bf16(actf<ACT>(v1[2]), actf<ACT>(v1[3]));
                *(u32x4*)(rowp + bj * 128) = w; } }
}
struct EpiG1 {
    static constexpr bool PERM = true;
    __device__ __forceinline__ bool keep(const Unit&) const { return false; }
    unsigned char *ws, *outb;
    __device__ __forceinline__ void operator()(const f32x4 (&acc)[2][2][4][2], const Unit& u, int wr, int wc, int fr, int fq) const {
        unsigned char* w = uniform_ptr(ws); unsigned char* ob = uniform_ptr(outb); asm volatile("" : "+s"(w), "+s"(ob));
        const int row0 = u.pm * 256 + wr * 64 + fr, pn = u.pn, cw = wc * 32 + 8 * fq;
        if (pn < 8) {
            bf16_t* base = (bf16_t*)(w + OFF_U) + (size_t)row0 * 1024 + pn * 128 + cw;
#pragma unroll
            for (int ai = 0; ai < 2; ++ai)
#pragma unroll
                for (int m = 0; m < 4; ++m) { const f32x4 a0 = acc[ai][0][m][0], a1 = acc[ai][0][m][1], g0 = acc[ai][1][m][0], g1 = acc[ai][1][m][1]; u32x4 wv;
                    wv.x = cvt_pk_bf16(a0[0] * sigm(g0[0]), a0[1] * sigm(g0[1])); wv.y = cvt_pk_bf16(a0[2] * sigm(g0[2]), a0[3] * sigm(g0[3]));
                    wv.z = cvt_pk_bf16(a1[0] * sigm(g1[0]), a1[1] * sigm(g1[1])); wv.w = cvt_pk_bf16(a1[2] * sigm(g1[2]), a1[3] * sigm(g1[3]));
                    *(u32x4*)(base + (size_t)(ai * 128 + m * 16) * 1024) = wv; }
        } else if (pn < 12) store_tile_bf16<1>(acc, (bf16_t*)(w + OFF_OGC) + (size_t)row0 * 1024 + (pn - 8) * 256 + cw, 1024);
        else if (pn < 25) store_tile_bf16<0>(acc, (bf16_t*)(w + OFF_RKVL) + (size_t)row0 * LDR + (pn - 12) * 256 + cw, LDR);
        else if (pn < 29) store_tile_bf16<1>(acc, (bf16_t*)(w + OFF_OGR) + (size_t)row0 * 1024 + (pn - 25) * 256 + cw, 1024);
        else if (pn < 33) store_tile_bf16<2>(acc, (bf16_t*)(w + OFF_GC) + (size_t)row0 * 1024 + (pn - 29) * 256 + cw, 1024);
        else store_tile_bf16<2>(acc, (bf16_t*)(ob + 64 * MiB) + (size_t)row0 * 1024 + (pn - 33) * 256 + cw, 1024);
    }
};
struct EpiLora {
    static constexpr bool PERM = true;
    __device__ __forceinline__ bool keep(const Unit&) const { return false; }
    bf16_t *DW, *AP;
    __device__ __forceinline__ void operator()(const f32x4 (&acc)[2][2][4][2], const Unit& u, int wr, int wc, int fr, int fq) const {
        const int row0 = u.pm * 256 + wr * 64 + fr, cw = wc * 32 + 8 * fq;
        bf16_t* base = (u.pn < 4 ? DW + (size_t)u.pn * 256 : AP + (size_t)(u.pn - 4) * 256) + (size_t)row0 * 1024 + cw;
        store_tile_bf16<0>(acc, base, 1024);
    }
};
struct EpiG2 {
    static constexpr bool PERM = true;
    const bf16_t *GC, *GR; bf16_t* M;
    __device__ __forceinline__ bool keep(const Unit& u) const { return u.kind == 0; }
    __device__ __forceinline__ void operator()(f32x4 (&acc)[2][2][4][2], const Unit& u, int wr, int wc, int fr, int fq) const {
        const size_t off0 = (size_t)(u.pm * 256 + wr * 64 + fr) * 1024 + u.pn * 256 + wc * 32 + 8 * fq;
#pragma unroll
        for (int ai = 0; ai < 2; ++ai)
#pragma unroll
            for (int m = 0; m < 4; ++m)
#pragma unroll
                for (int bj = 0; bj < 2; ++bj) { const size_t off = off0 + (size_t)(ai * 128 + m * 16) * 1024 + bj * 128;
                    const u32x4 gr = *(const u32x4*)(GR + off); f32x4& v0 = acc[ai][bj][m][0]; f32x4& v1 = acc[ai][bj][m][1];
                    const f32x4 r0 = {bflo(gr.x), bfhi(gr.x), bflo(gr.y), bfhi(gr.y)}, r1 = {bflo(gr.z), bfhi(gr.z), bflo(gr.w), bfhi(gr.w)};
                    if (u.kind == 0) { const u32x4 gc = *(const u32x4*)(GC + off);
                        const f32x4 c0 = {bflo(gc.x), bfhi(gc.x), bflo(gc.y), bfhi(gc.y)}, c1 = {bflo(gc.z), bfhi(gc.z), bflo(gc.w), bfhi(gc.w)};
#pragma unroll
                        for (int j = 0; j < 4; ++j) { v0[j] *= c0[j] * __builtin_amdgcn_rcpf(fmaxf(r0[j], 1e-30f)); v1[j] *= c1[j] * __builtin_amdgcn_rcpf(fmaxf(r1[j], 1e-30f)); }
                    } else { const f32x4 m0 = v0 * r0, m1 = v1 * r1; u32x4 w;
                        w.x = cvt_pk_bf16(m0[0], m0[1]); w.y = cvt_pk_bf16(m0[2], m0[3]); w.z = cvt_pk_bf16(m1[0], m1[1]); w.w = cvt_pk_bf16(m1[2], m1[3]);
                        *(u32x4*)(M + off) = w; } }
    }
};
struct EpiG3 {
    static constexpr bool PERM = false;
    __device__ __forceinline__ bool keep(const Unit&) const { return false; }
    const float *x, *mod; float* out;
    __device__ __forceinline__ void operator()(const f32x4 (&acc)[2][2][4][2], const Unit& u, int wr, int wc, int fr, int fq) const {
        const int col0 = u.pn * 256 + wc * 32 + 4 * fq; const size_t off0 = (size_t)(u.pm * 256 + wr * 64 + fr) * 1024 + col0;
        const float* gp = mod + (size_t)(u.pm >> 3) * 3072 + 2048 + col0;
        f32x4 gv[2][2];
#pragma unroll
        for (int bj = 0; bj < 2; ++bj)
#pragma unroll
            for (int n = 0; n < 2; ++n) gv[bj][n] = *(const f32x4*)(gp + bj * 128 + n * 16);
#pragma unroll
        for (int ai = 0; ai < 2; ++ai)
#pragma unroll
            for (int m = 0; m < 4; ++m)
#pragma unroll
                for (int bj = 0; bj < 2; ++bj)
#pragma unroll
                    for (int n = 0; n < 2; ++n) { const size_t off = off0 + (size_t)(ai * 128 + m * 16) * 1024 + bj * 128 + n * 16;
                        *(f32x4*)(out + off) = *(const f32x4*)(x + off) + gv[bj][n] * acc[ai][bj][m][n]; }
    }
};

__device__ void phase_mod(const Params& p, unsigned char* smem) {
    if (blockIdx.x >= 48) return;
    float* sc = (float*)smem;
    float* red = sc + 16384;
    const int tid = tid_opaque(), w = tid >> 6, lane = tid & 63;
    for (int i = tid; i < 16384; i += 512) { const int b = i >> 10, d = i & 1023; const float cv = p.c[i]; sc[d * 16 + b] = cv * sigm(cv); }
    __syncthreads();
    const int e = blockIdx.x * 64 + lane;
    float acc[16];
#pragma unroll
    for (int b = 0; b < 16; ++b) acc[b] = 0.f;
    for (int d0 = w * 128; d0 < w * 128 + 128; d0 += 16) {
        float wvs[16];
#pragma unroll
        for (int u = 0; u < 16; ++u) wvs[u] = p.ada_w[(size_t)(d0 + u) * 3072 + e];
#pragma unroll
        for (int u = 0; u < 16; ++u) { const int d = d0 + u; const float wv = wvs[u];
        const f32x4* s4 = (const f32x4*)(sc + d * 16);
#pragma unroll
        for (int q = 0; q < 4; ++q) { const f32x4 s = s4[q]; acc[4 * q] += s[0] * wv; acc[4 * q + 1] += s[1] * wv; acc[4 * q + 2] += s[2] * wv; acc[4 * q + 3] += s[3] * wv; }
        }
    }
#pragma unroll
    for (int b = 0; b < 16; ++b) red[(w * 16 + b) * 64 + lane] = acc[b];
    __syncthreads();
    float* mod = (float*)(p.ws + OFF_MOD);
    for (int i = tid; i < 1024; i += 512) { const int b = i >> 6, l = i & 63; float s = 0.f;
#pragma unroll
        for (int ww = 0; ww < 8; ++ww) s += red[(ww * 16 + b) * 64 + l];
        mod[b * 3072 + blockIdx.x * 64 + l] = s + p.ada_b[blockIdx.x * 64 + l]; }
    __syncthreads();
}
__device__ __forceinline__ void transpose_tile(const float* src, int ld, int n_src0, int k0, bf16_t* dst, int n_dst0, float* tile) {
    const int tid = tid_opaque();
#pragma unroll
    for (int r = 0; r < 2; ++r) { const int i = (tid >> 4) + 32 * r, j4 = (tid & 15) * 4;
        f32x4 v = {0.f, 0.f, 0.f, 0.f}; if (n_src0 >= 0) v = *(const f32x4*)(src + (size_t)(k0 + i) * ld + n_src0 + j4);
        tile[i * 65 + j4] = v[0]; tile[i * 65 + j4 + 1] = v[1]; tile[i * 65 + j4 + 2] = v[2]; tile[i * 65 + j4 + 3] = v[3]; }
    __syncthreads();
    const int j = tid >> 3, i8 = (tid & 7) * 8; u32x4 w;
    w.x = cvt_pk_bf16(tile[(i8 + 0) * 65 + j], tile[(i8 + 1) * 65 + j]); w.y = cvt_pk_bf16(tile[(i8 + 2) * 65 + j], tile[(i8 + 3) * 65 + j]);
    w.z = cvt_pk_bf16(tile[(i8 + 4) * 65 + j], tile[(i8 + 5) * 65 + j]); w.w = cvt_pk_bf16(tile[(i8 + 6) * 65 + j], tile[(i8 + 7) * 65 + j]);
    *(u32x4*)(dst + (size_t)(n_dst0 + j) * 1024 + k0 + i8) = w;
    __syncthreads();
}
__device__ void phase_weights(const Params& p, unsigned char* smem) {
    float* tile = (float*)smem;
    bf16_t* WinT = (bf16_t*)(p.ws + OFF_WINT); bf16_t* W2T = (bf16_t*)(p.ws + OFF_W2T); bf16_t* WoT = (bf16_t*)(p.ws + OFF_WOT); bf16_t* LBt = (bf16_t*)(p.ws + OFF_LBT);
    constexpr int NT1 = (N1 / 64) * 16;
    for (int idx = blockIdx.x; idx < NT1 + 768; idx += gridDim.x) {
        if (idx < NT1) { const int a = idx >> 4, kt = idx & 15, n0 = a * 64; int src;
            if (n0 < 2048) { const int j = n0 >> 8, wi = n0 & 255; src = wi < 128 ? 128 * j + wi : 1024 + 128 * j + wi - 128; }
            else if (n0 < 6272) src = n0; else if (n0 < 6400) src = -1; else src = n0 - 128;
            transpose_tile(p.w_in, 9344, src, kt * 64, WinT, n0, tile);
        } else { const int r = idx - NT1, which = r >> 8, a = (r >> 4) & 15, kt = r & 15;
            const float* src = which == 0 ? p.w_conv_out : (which == 1 ? p.w_rwkv_out : p.w_out);
            bf16_t* dst = which == 0 ? W2T : (which == 1 ? W2T + (size_t)1024 * 1024 : WoT);
            transpose_tile(src, 1024, a * 64, kt * 64, dst, a * 64, tile); }
    }
    for (int idx = blockIdx.x * 512 + tid_opaque(); idx < 2048 * 128; idx += gridDim.x * 512) { const int n = idx >> 7, k = idx & 127; float v = 0.f;
        if (n < 1024) { if (k < 64) v = p.rwkv_w2[k * 1024 + n]; } else { if (k >= 64) v = p.rwkv_a2[(k - 64) * 1024 + n - 1024]; }
        LBt[idx] = f2bf(v); }
}
__device__ void phase_h(const Params& p) {
    const int tid = tid_opaque(), w = tid >> 6, lane = tid & 63;
    const float* mod = (const float*)(p.ws + OFF_MOD); bf16_t* Hh = (bf16_t*)p.out;
    for (int tok = blockIdx.x * 8 + w; tok < T; tok += gridDim.x * 8) {
        const int b = tok >> 11; const float* xr = p.x + (size_t)tok * 1024; f32x4 v[4]; float ss = 0.f;
#pragma unroll
        for (int q = 0; q < 4; ++q) { v[q] = *(const f32x4*)(xr + q * 256 + lane * 4); ss += v[q][0] * v[q][0] + v[q][1] * v[q][1] + v[q][2] * v[q][2] + v[q][3] * v[q][3]; }
        ss = wave_sum(ss); const float rstd = rsqrtf(ss * (1.f / 1024.f) + 1e-6f);
#pragma unroll
        for (int q = 0; q < 4; ++q) { const int col = q * 256 + lane * 4; const f32x4 g = *(const f32x4*)(p.norm_g + col), sh = *(const f32x4*)(mod + b * 3072 + col), sc = *(const f32x4*)(mod + b * 3072 + 1024 + col);
            const f32x4 y = v[q] * rstd * g * (sc + 1.f) + sh; u32x2 o; o.x = cvt_pk_bf16(y[0], y[1]); o.y = cvt_pk_bf16(y[2], y[3]);
            *(u32x2*)(Hh + (size_t)tok * 1024 + col) = o; }
    }
}
__device__ void phase_conv(const Params& p, unsigned char* smem) {
    const int tid = tid_opaque(), w = tid >> 6, lane = tid & 63, c0 = tid * 2;
    const bf16_t* U = (const bf16_t*)(p.ws + OFF_U); bf16_t* OGC = (bf16_t*)(p.ws + OFF_OGC);
    float* part = (float*)smem;
    float* stat = part + 32 * 512;
    f32x2 wk[31];
#pragma unroll
    for (int j = 0; j < 31; ++j) wk[j] = *(const f32x2*)(p.conv_k + j * 1024 + c0);
    const f32x2 cb = *(const f32x2*)(p.conv_b + c0), lg = *(const f32x2*)(p.conv_ln_g + c0), lb = *(const f32x2*)(p.conv_ln_b + c0);
    for (int tile = blockIdx.x; tile < T / 16; tile += gridDim.x) {
        const int b = tile >> 7, t0 = (tile & 127) * 16; const size_t row0 = (size_t)b * SEQ + t0;
        f32x2 u[46];
#pragma unroll
        for (int i = 0; i < 46; ++i) { const int t = t0 - 30 + i; unsigned v = 0u; if (t >= 0) v = *(const unsigned*)(U + ((size_t)b * SEQ + t) * 1024 + c0); u[i] = (f32x2){bflo(v), bfhi(v)}; }
        f32x2 o[16];
#pragma unroll
        for (int i = 0; i < 16; ++i) { f32x2 a = cb;
#pragma unroll
            for (int j = 0; j < 31; ++j) a = wk[j] * u[i + j] + a;
            o[i] = a; }
#pragma unroll
        for (int i = 0; i < 16; ++i) { part[i * 512 + tid] = o[i].x + o[i].y; part[(16 + i) * 512 + tid] = o[i].x * o[i].x + o[i].y * o[i].y; }
        __syncthreads();
#pragma unroll
        for (int q = 0; q < 4; ++q) { const int v = 4 * w + q; float s = 0.f;
#pragma unroll
            for (int r = 0; r < 8; ++r) s += part[v * 512 + lane + 64 * r];
            s = wave_sum(s); if (lane == 0) stat[v] = s; }
        __syncthreads();
#pragma unroll
        for (int i = 0; i < 16; ++i) { const float mean = stat[i] * (1.f / 1024.f), var = stat[16 + i] * (1.f / 1024.f) - mean * mean, rstd = __builtin_amdgcn_rsqf(var + 1e-5f);
            float y0 = (o[i].x - mean) * rstd * lg.x + lb.x, y1 = (o[i].y - mean) * rstd * lg.y + lb.y; y0 *= sigm(y0); y1 *= sigm(y1);
            bf16_t* gp = OGC + (row0 + i) * 1024 + c0; const unsigned og = *(const unsigned*)gp;
            *(unsigned*)gp = cvt_pk_bf16(y0 * bflo(og), y1 * bfhi(og)); }
    }
    const bf16_t* RK = (const bf16_t*)(p.ws + OFF_RKVL); bf16_t* AL = (bf16_t*)(p.ws + OFF_ALORA);
    for (int idx = blockIdx.x * 512 + tid; idx < T * 128; idx += gridDim.x * 512) { const int t = idx >> 7, j = idx & 127;
        const float z = bf2f(RK[(size_t)t * LDR + 3072 + j]), pv = (t & (SEQ - 1)) ? bf2f(RK[(size_t)(t - 1) * LDR + 3072 + j]) : 0.f;
        const float s = z + p.rwkv_mu[3072 + j] * (pv - z); const float val = j < 64 ? tanhf(s) : s;
        AL[(size_t)t * 128 + j] = f2bf(val); }
}
constexpr int SCH = 32, SNCH = SEQ / SCH, SREC = 288;
struct ScanRaw { unsigned v[8], wa[8]; };
struct ScanOps { f32x4 a[4], b[2], k[2]; };
struct ScanC { float mu_r, mu_k, mu_v, w0c, a0c, kkc, kac, rkc, gng, gnb; };
__device__ __forceinline__ void scan_load_raw(ScanRaw& R, f32x2 (&S)[8], const bf16_t* RK, const bf16_t* DW, const bf16_t* AP, int b, int c, int pw, int ch) {
#pragma unroll
    for (int i = 0; i < 8; ++i) { const int t = c * SCH + 8 * pw + i; const size_t row = (size_t)b * SEQ + t; const bf16_t* rp = RK + row * LDR + ch;
        const bf16_t* rq = t > 0 ? rp - LDR : rp;
        S[i >> 1][i & 1] = __uint_as_float((unsigned)rp[0] | ((unsigned)rq[0] << 16)); S[4 + (i >> 1)][i & 1] = __uint_as_float((unsigned)rp[1024] | ((unsigned)rq[1024] << 16));
        R.v[i] = (unsigned)rp[2048] | ((unsigned)rq[2048] << 16); R.wa[i] = (unsigned)DW[row * 1024 + ch] | ((unsigned)AP[row * 1024 + ch] << 16); }
}
__device__ __forceinline__ void scan_prep(const ScanRaw& R, const f32x2 (&S)[8], const ScanC& C, int c, int pw, int lane, unsigned seq, float* rec, float* vbuf, f32x4* scl, float* wtot, float* ptot, volatile unsigned* flag) {
    float kkA[8], rA[8], nbA[8], kpA[8], LA[8]; float L = 1.f;
#pragma unroll
    for (int i = 0; i < 8; ++i) { const int tt = 8 * pw + i, t = c * SCH + tt;
        const unsigned Rr = __float_as_uint(S[i >> 1][i & 1]), Rk = __float_as_uint(S[4 + (i >> 1)][i & 1]);
        float r = bflo(Rr), k = bflo(Rk), v = bflo(R.v[i]); const float pm = t > 0 ? 1.f : 0.f;
        const float r1 = pm * bfhi(Rr), k1 = pm * bfhi(Rk), v1 = pm * bfhi(R.v[i]);
        r += C.mu_r * (r1 - r); k += C.mu_k * (k1 - k); v += C.mu_v * (v1 - v);
        const float wpre = C.w0c + bflo(R.wa[i]), apre = C.a0c + bfhi(R.wa[i]);
        const float decay = __expf(-0.60653066f * sigm(wpre)), a = sigm(apre);
        const float kkv = k * C.kkc, n2 = wave_sum(kkv * kkv), kk = kkv * __builtin_amdgcn_rsqf(fmaxf(n2, 1e-24f));
        const float kp = k * (1.f + (a - 1.f) * C.kac), bv = kk * a;
        const float br = wave_sum(bv * r), kr = wave_sum(kp * r), bonus = wave_sum(r * kp * C.rkc);
        L *= decay; kkA[i] = kk; rA[i] = r; nbA[i] = -bv; kpA[i] = kp; LA[i] = L;
        vbuf[tt * 64 + lane] = v;
        if (lane == 0) scl[tt] = (f32x4){-br, kr, bonus, 0.f};
        if (i & 1) __builtin_amdgcn_sched_barrier(0);
    }
    wtot[pw * 64 + lane] = L;
    asm volatile("s_waitcnt lgkmcnt(0)" ::: "memory");
    if (lane == 0) flag[pw] = seq;
    float Pw = 1.f;
    for (int ww = 0; ww < pw; ++ww) { while (flag[ww] != seq) __builtin_amdgcn_s_sleep(1);
        asm volatile("" ::: "memory"); Pw *= wtot[ww * 64 + lane]; }
    if (pw == 3) ptot[lane] = Pw * L;
    float Pprev = Pw;
#pragma unroll
    for (int i = 0; i < 8; ++i) { const int tt = 8 * pw + i; const float Pt = Pw * LA[i], ip = __builtin_amdgcn_rcpf(Pt);
        float* rc = rec + tt * SREC + (lane >> 3) * 36; const int e = lane & 7;
        *(f32x2*)(rc + 2 * e) = (f32x2){Pprev * kkA[i], Pt * rA[i]}; rc[16 + e] = nbA[i] * ip; rc[24 + e] = kpA[i] * ip;
        Pprev = Pt; }
}
__device__ __forceinline__ void scan_post(const bf16_t (&og)[8], bf16_t* dst0, const ScanC& C, int pw, int lane, const float* obuf, const float* vbuf, const f32x4* scl) {
#pragma unroll
    for (int i = 0; i < 8; ++i) { const int tt = pw + 4 * i;
        const float o = obuf[tt * 64 + lane], mean = wave_sum(o) * (1.f / 64.f), d = o - mean, var = wave_sum(d * d) * (1.f / 64.f);
        float y = d * __builtin_amdgcn_rsqf(var + 64e-5f) * C.gng + C.gnb; y += scl[tt].z * vbuf[tt * 64 + lane];
        dst0[(size_t)i * 4096] = f2bf(y * bf2f(og[i])); }
}
__device__ __forceinline__ void scan_load_ops(ScanOps& o, const f32x4* rq) {
#pragma unroll
    for (int j = 0; j < 4; ++j) o.a[j] = rq[j];
    o.b[0] = rq[4]; o.b[1] = rq[5]; o.k[0] = rq[6]; o.k[1] = rq[7];
}
__device__ __forceinline__ void scan_step(f32x2 (&S)[8], const ScanOps& q, const f32x2 v2, const bool lead, const f32x2 sc, float* obuf, float* dump, int tt, int srow) {
    f32x2 va = {v2.x, v2.x}, vb = {v2.y, v2.y}; asm volatile("" : "+v"(va), "+v"(vb));
    f32x2 dA = S[0].x * (f32x2){q.a[0][0], q.a[0][1]}, eA = S[0].y * (f32x2){q.a[0][2], q.a[0][3]}, dB = S[4].x * (f32x2){q.a[0][0], q.a[0][1]}, eB = S[4].y * (f32x2){q.a[0][2], q.a[0][3]};
#pragma unroll
    for (int j = 1; j < 4; ++j) { dA += S[j].x * (f32x2){q.a[j][0], q.a[j][1]}; eA += S[j].y * (f32x2){q.a[j][2], q.a[j][3]};
        dB += S[4 + j].x * (f32x2){q.a[j][0], q.a[j][1]}; eB += S[4 + j].y * (f32x2){q.a[j][2], q.a[j][3]}; }
    dA += eA; dB += eB;
    float skA = dA.x, oA = dA.y, skB = dB.x, oB = dB.y;
    skA = dpp_add<0xB1>(skA); skB = dpp_add<0xB1>(skB); oA = dpp_add<0xB1>(oA); oB = dpp_add<0xB1>(oB);
    skA = dpp_add<0x4E>(skA); skB = dpp_add<0x4E>(skB); oA = dpp_add<0x4E>(oA); oB = dpp_add<0x4E>(oB);
    skA = dpp_add<0x141>(skA); skB = dpp_add<0x141>(skB); oA = dpp_add<0x141>(oA); oB = dpp_add<0x141>(oB);
#pragma unroll
    for (int j = 0; j < 2; ++j) { const f32x2 b0 = {q.b[j][0], q.b[j][1]}, b1 = {q.b[j][2], q.b[j][3]}, k0 = {q.k[j][0], q.k[j][1]}, k1 = {q.k[j][2], q.k[j][3]};
        S[2 * j] += skA * b0; S[2 * j + 1] += skA * b1; S[4 + 2 * j] += skB * b0; S[4 + 2 * j + 1] += skB * b1;
        S[2 * j] += va * k0; S[2 * j + 1] += va * k1; S[4 + 2 * j] += vb * k0; S[4 + 2 * j + 1] += vb * k1; }
    f32x2* op = (f32x2*)(lead ? obuf + tt * 64 + srow : dump);
    *op = (f32x2){oA + skA * sc.x + v2.x * sc.y, oB + skB * sc.x + v2.y * sc.y};
}
__device__ void phase_scan(const Params& p, unsigned char* smem) {
    const int tid = tid_opaque(), w = tid >> 6, lane = tid & 63, g = lane & 7, srow = (w & 3) * 16 + 2 * (lane >> 3), pw = w & 3;
    const bool cons = w < 4, lead = (g == 0);
    float* recb = (float*)smem;
    float* vbufb = recb + 2 * SCH * SREC;
    float* obufb = vbufb + 3 * SCH * 64;
    f32x4* sclb = (f32x4*)(obufb + 2 * SCH * 64);
    float* wtot = (float*)(sclb + 3 * SCH);
    float* ptotb = wtot + 256;
    volatile unsigned* flag = (volatile unsigned*)(ptotb + 128);
    float* dump = (float*)(ptotb + 128) + 8;
    const bf16_t* RK = (const bf16_t*)(p.ws + OFF_RKVL); const bf16_t* DW = (const bf16_t*)(p.ws + OFF_DW); const bf16_t* AP = (const bf16_t*)p.out;
    bf16_t* OGR = (bf16_t*)(p.ws + OFF_OGR);
    unsigned seq = 0;
    for (int bh = blockIdx.x; bh < 256; bh += gridDim.x) {
        const int b = bh >> 4, h = bh & 15, ch = h * 64 + lane;
        const ScanC C{p.rwkv_mu[ch], p.rwkv_mu[1024 + ch], p.rwkv_mu[2048 + ch], p.rwkv_w0[ch], p.rwkv_a0[ch], p.rwkv_k_k[ch], p.rwkv_k_a[ch], p.rwkv_r_k[ch], p.rwkv_gn_g[ch], p.rwkv_gn_b[ch]};
        f32x2 S[8];
#pragma unroll
        for (int i = 0; i < 8; ++i) S[i] = (f32x2){0.f, 0.f};
        ScanRaw R;
        if (tid < 4) flag[tid] = 0u;
        __syncthreads();
        ++seq;
        if (!cons) { scan_load_raw(R, S, RK, DW, AP, b, 0, pw, ch); scan_prep(R, S, C, 0, pw, lane, seq, recb, vbufb, sclb, wtot, ptotb, flag); scan_load_raw(R, S, RK, DW, AP, b, 1, pw, ch); }
        __syncthreads();
        for (int c = 0; c < SNCH; ++c) {
            const int cb = c & 1, c3 = c % 3, n3 = (c + 1) % 3, p3 = (c + 2) % 3;
            ++seq;
            if (cons) {
                const float* vb = vbufb + c3 * (SCH * 64); const f32x2* sc2 = (const f32x2*)(sclb + c3 * SCH); float* ob = obufb + cb * (SCH * 64);
                const f32x4* rq = (const f32x4*)(recb + cb * (SCH * SREC) + g * 36);
                ScanOps A, B; scan_load_ops(A, rq);
                f32x2 v0 = *(const f32x2*)(vb + srow), v1 = *(const f32x2*)(vb + 64 + srow); f32x2 s0 = sc2[0], s1 = sc2[2];
                for (int tt = 0; tt < SCH; tt += 2) {
                    const int tn = tt + 2 < SCH ? tt + 2 : SCH - 2;
                    scan_load_ops(B, rq + (tt + 1) * (SREC / 4));
                    const f32x2 nv0 = *(const f32x2*)(vb + tn * 64 + srow), nv1 = *(const f32x2*)(vb + (tn + 1) * 64 + srow); const f32x2 ns0 = sc2[2 * tn], ns1 = sc2[2 * tn + 2];
                    scan_step(S, A, v0, lead, s0, ob, dump, tt, srow);
                    scan_load_ops(A, rq + tn * (SREC / 4));
                    scan_step(S, B, v1, lead, s1, ob, dump, tt + 1, srow);
                    v0 = nv0; v1 = nv1; s0 = ns0; s1 = ns1;
                }
                { const f32x4 p0 = *(const f32x4*)(ptotb + cb * 64 + g * 8), p1 = *(const f32x4*)(ptotb + cb * 64 + g * 8 + 4);
                    const f32x2 q0 = {p0[0], p0[1]}, q1 = {p0[2], p0[3]}, q2 = {p1[0], p1[1]}, q3 = {p1[2], p1[3]};
                    S[0] *= q0; S[1] *= q1; S[2] *= q2; S[3] *= q3; S[4] *= q0; S[5] *= q1; S[6] *= q2; S[7] *= q3; }
            } else {
                bf16_t og[8]; bf16_t* dst0 = OGR + ((size_t)b * SEQ + (c > 0 ? c - 1 : 0) * SCH + pw) * 1024 + ch;
#pragma unroll
                for (int i = 0; i < 8; ++i) og[i] = dst0[(size_t)i * 4096];
                if (c + 1 < SNCH) { scan_prep(R, S, C, c + 1, pw, lane, seq, recb + (cb ^ 1) * (SCH * SREC), vbufb + n3 * (SCH * 64), sclb + n3 * SCH, wtot, ptotb + (cb ^ 1) * 64, flag);
                    if (c + 2 < SNCH) scan_load_raw(R, S, RK, DW, AP, b, c + 2, pw, ch); }
                if (c > 0) scan_post(og, dst0, C, pw, lane, obufb + (cb ^ 1) * (SCH * 64), vbufb + p3 * (SCH * 64), sclb + p3 * SCH);
            }
            __syncthreads();
        }
        if (!cons) { const int cl = SNCH - 1; bf16_t og[8]; bf16_t* dst0 = OGR + ((size_t)b * SEQ + cl * SCH + pw) * 1024 + ch;
#pragma unroll
            for (int i = 0; i < 8; ++i) og[i] = dst0[(size_t)i * 4096];
            scan_post(og, dst0, C, pw, lane, obufb + (cl & 1) * (SCH * 64), vbufb + (cl % 3) * (SCH * 64), sclb + (cl % 3) * SCH); }
        __syncthreads();
    }
}
__device__ void phase_final(const Params& p) {
    const int tid = tid_opaque(), w = tid >> 6, lane = tid & 63;
    for (int tok = blockIdx.x * 8 + w; tok < T; tok += gridDim.x * 8) {
        float* xr = p.out + (size_t)tok * 1024; f32x4 v[4]; float ss = 0.f;
#pragma unroll
        for (int q = 0; q < 4; ++q) { v[q] = *(const f32x4*)(xr + q * 256 + lane * 4); ss += v[q][0] * v[q][0] + v[q][1] * v[q][1] + v[q][2] * v[q][2] + v[q][3] * v[q][3]; }
        ss = wave_sum(ss); const float rstd = rsqrtf(ss * (1.f / 1024.f) + 1e-6f);
#pragma unroll
        for (int q = 0; q < 4; ++q) { const int col = q * 256 + lane * 4; *(f32x4*)(xr + col) = v[q] * rstd * *(const f32x4*)(p.final_g + col); }
    }
}

template <int FIRST, int LAST> __global__ __launch_bounds__(512, 2) void mega(Params p) {
    extern __shared__ __attribute__((aligned(16))) unsigned char smem[];
    LAS unsigned char* lds = (LAS unsigned char*)smem;
    cg::grid_group grid = cg::this_grid();
    unsigned* bar = (unsigned*)(uniform_ptr(p.ws) + OFF_BAR);
    volatile LAS unsigned* st = (volatile LAS unsigned*)(lds + LDS_BYTES);
    if (threadIdx.x == 0) { st[0] = 0u; st[1] = 0u; (void)xb_add(&bar[XB_XCNT(xb_xcc_id())], 1u); }
    __syncthreads();
    if (p.ws == nullptr) grid.sync();
    unsigned char* ws = p.ws;
    const int G = gridDim.x, c = blockIdx.x;
    if (FIRST <= 0 && 0 < LAST) { phase_mod(p, smem); phase_weights(p, smem); }
    if (FIRST <= 1 && 1 < LAST) { if (FIRST < 1) grid_barrier(bar, st); phase_h(p); }
    if (FIRST <= 2 && 2 < LAST) { if (FIRST < 2) grid_barrier(bar, st);
        pg8::Sched1 S{T / 256, N1 / 256, G, c, (const char*)p.out, (const char*)(ws + OFF_WINT), (size_t)256 * 1024 * 2};
        EpiG1 E{ws, (unsigned char*)p.out};
        pg8::gemm_phase(lds, 1024, S, E); }
    if (FIRST <= 3 && 3 < LAST) { if (FIRST < 3) grid_barrier(bar, st); phase_conv(p, smem); }
    if (FIRST <= 4 && 4 < LAST) { if (FIRST < 4) grid_barrier(bar, st);
        pg8::Sched1 S{T / 256, 2048 / 256, G, c, (const char*)(ws + OFF_ALORA), (const char*)(ws + OFF_LBT), (size_t)256 * 128 * 2};
        EpiLora E{(bf16_t*)(ws + OFF_DW), (bf16_t*)p.out};
        pg8::gemm_phase(lds, 128, S, E); }
    if (FIRST <= 5 && 5 < LAST) { if (FIRST < 5) grid_barrier(bar, st); phase_scan(p, smem); }
    if (FIRST <= 6 && 6 < LAST) { if (FIRST < 6) grid_barrier(bar, st);
        pg8::Sched2 S{T / 256, 4, G, c, (const char*)(ws + OFF_OGC), (const char*)(ws + OFF_OGR), (const char*)(ws + OFF_W2T), (const char*)(ws + OFF_W2T + 2 * MiB), (size_t)256 * 1024 * 2};
        EpiG2 E{(const bf16_t*)(ws + OFF_GC), (const bf16_t*)((unsigned char*)p.out + 64 * MiB), (bf16_t*)(ws + OFF_M)};
        pg8::gemm_phase(lds, 1024, S, E); }
    if (FIRST <= 7 && 7 < LAST) { if (FIRST < 7) grid_barrier(bar, st);
        pg8::Sched1 S{T / 256, 4, G, c, (const char*)(ws + OFF_M), (const char*)(ws + OFF_WOT), (size_t)256 * 1024 * 2};
        EpiG3 E{p.x, (const float*)(ws + OFF_MOD), p.out};
        pg8::gemm_phase(lds, 1024, S, E); }
    if (FIRST <= 8 && 8 < LAST) { if (FIRST < 8) grid_barrier(bar, st); phase_final(p); }
}

template <int PH> static void launch_one(const Params& p, hipStream_t stream) {
    hipFuncSetAttribute((const void*)mega<PH, PH + 1>, hipFuncAttributeMaxDynamicSharedMemorySize, LDS_BYTES);
    mega<PH, PH + 1><<<256, 512, LDS_BYTES, stream>>>(p);
}

extern "C" void kernel_launch(void* const* d_in, const int* in_sizes, int n_in, void* d_out, int out_size, void* d_ws, size_t ws_size, hipStream_t stream) {
    Params p{};
    const float** f = (const float**)&p;
    for (int i = 0; i < 24; ++i) f[i] = (const float*)d_in[i];
    p.out = (float*)d_out; p.ws = (unsigned char*)d_ws;
    if (ws_size < WS_END) { fprintf(stderr, "workspace too small: %zu < %zu\n", ws_size, (size_t)WS_END); return; }
#if SINGLE_LAUNCH
    static int grid_blocks = 0;
    if (!grid_blocks) {
        int dev = 0, cus = 0, per_cu = 0;
        hipGetDevice(&dev);
        hipDeviceGetAttribute(&cus, hipDeviceAttributeMultiprocessorCount, dev);
        hipFuncSetAttribute((const void*)mega<0, NPHASE>, hipFuncAttributeMaxDynamicSharedMemorySize, LDS_BYTES + 16);
        hipOccupancyMaxActiveBlocksPerMultiprocessor(&per_cu, mega<0, NPHASE>, 512, LDS_BYTES + 16);
        grid_blocks = cus * (per_cu > 1 ? 1 : per_cu);
        if (grid_blocks > 256) grid_blocks = 256;
    }
    hipMemsetAsync((unsigned char*)d_ws + OFF_BAR, 0, 3456 * 4, stream);
    void* args[] = {(void*)&p};
    hipError_t e = hipLaunchCooperativeKernel((const void*)mega<0, NPHASE>, dim3(grid_blocks), dim3(512), args, LDS_BYTES + 16, stream);
    if (e != hipSuccess) fprintf(stderr, "cooperative launch failed: %s (grid %d)\n", hipGetErrorString(e), grid_blocks);
#else
    launch_one<0>(p, stream); launch_one<1>(p, stream); launch_one<2>(p, stream); launch_one<3>(p, stream); launch_one<4>(p, stream);
    launch_one<5>(p, stream); launch_one<6>(p, stream); launch_one<7>(p, stream); launch_one<8>(p, stream);
#endif
}
```

```cpp
#include <hip/hip_runtime.h>
#include <hip/hip_cooperative_groups.h>
#include <cstdio>
namespace cg = cooperative_groups;

#ifndef SINGLE_LAUNCH
#define SINGLE_LAUNCH 1
#endif

#define LAS __attribute__((address_space(3)))
typedef unsigned short bf16_t;
typedef short bf16x8 __attribute__((ext_vector_type(8)));
typedef float f32x8 __attribute__((ext_vector_type(8)));
typedef float f32x4 __attribute__((ext_vector_type(4)));
typedef float f32x2 __attribute__((ext_vector_type(2)));
typedef unsigned u32x4 __attribute__((ext_vector_type(4)));
typedef unsigned u32x2 __attribute__((ext_vector_type(2)));

constexpr int T = 32768, DM = 1024, SEQ = 2048, NB_ = 16;
constexpr int N1 = 9472;
constexpr int LDR = 3328;
constexpr int LDS_BYTES = 131072;
constexpr int NPHASE = 9;

constexpr size_t MiB = 1u << 20;
constexpr size_t OFF_U = 0, OFF_OGC = 64 * MiB, OFF_RKVL = 128 * MiB, OFF_OGR = 336 * MiB, OFF_GC = 400 * MiB, OFF_WINT = 464 * MiB;
constexpr size_t OFF_ALORA = OFF_WINT + (size_t)N1 * 1024 * 2;
constexpr size_t OFF_W2T = OFF_ALORA + 16 * MiB, OFF_WOT = OFF_W2T + 4 * MiB, OFF_LBT = OFF_WOT + 2 * MiB, OFF_MOD = OFF_LBT + 1 * MiB;
constexpr size_t OFF_BAR = OFF_MOD + 16 * 3072 * 4;
constexpr size_t OFF_ROWSS = OFF_BAR + 3456 * 4 + 128;
constexpr size_t OFF_PCNT = OFF_ROWSS + (size_t)T * 4;
constexpr size_t WS_END = OFF_PCNT + 256 * 4;
constexpr size_t OFF_MP = OFF_RKVL, OFF_M = OFF_RKVL + 128 * MiB, OFF_DW = OFF_U;

struct Params {
    const float *x, *c, *ada_w, *ada_b, *norm_g, *w_in, *conv_k, *conv_b, *conv_ln_g, *conv_ln_b, *w_conv_out, *rwkv_mu, *rwkv_w0, *rwkv_w2, *rwkv_a0, *rwkv_a2,
        *rwkv_k_k, *rwkv_k_a, *rwkv_r_k, *rwkv_gn_g, *rwkv_gn_b, *w_rwkv_out, *w_out, *final_g;
    float* out;
    unsigned char* ws;
};

typedef __bf16 bf16x2_t __attribute__((ext_vector_type(2)));
__device__ __forceinline__ unsigned cvt_pk_bf16(float lo, float hi) { const bf16x2_t r = __builtin_convertvector((f32x2){lo, hi}, bf16x2_t); return __builtin_bit_cast(unsigned, r); }
__device__ __forceinline__ bf16_t f2bf(float f) { return (bf16_t)(cvt_pk_bf16(f, 0.f) & 0xffffu); }
__device__ __forceinline__ float bf2f(bf16_t b) { return __uint_as_float(((unsigned)b) << 16); }
__device__ __forceinline__ float bflo(unsigned v) { return __uint_as_float(v << 16); }
__device__ __forceinline__ float bfhi(unsigned v) { return __uint_as_float(v & 0xffff0000u); }
__device__ __forceinline__ float sigm(float x) { return __builtin_amdgcn_rcpf(1.f + __expf(-x)); }
__device__ __forceinline__ int tid_opaque() { int t = threadIdx.x; asm volatile("" : "+v"(t)); return t; }
__device__ __forceinline__ unsigned char* uniform_ptr(unsigned char* p) { const size_t v = (size_t)p; const unsigned lo = __builtin_amdgcn_readfirstlane((unsigned)v), hi = __builtin_amdgcn_readfirstlane((unsigned)(v >> 32)); return (unsigned char*)(((size_t)hi << 32) | lo); }
template <int CTRL> __device__ __forceinline__ float dpp_add(float v) { return v + __int_as_float(__builtin_amdgcn_update_dpp(0, __float_as_int(v), CTRL, 0xF, 0xF, true)); }
__device__ __forceinline__ float wave_sum(float v) {
    v = dpp_add<0xB1>(v); v = dpp_add<0x4E>(v); v = dpp_add<0x141>(v); v = dpp_add<0x140>(v);
    const int iv = __float_as_int(v);
    return (__int_as_float(__builtin_amdgcn_readlane(iv, 0)) + __int_as_float(__builtin_amdgcn_readlane(iv, 16))) + (__int_as_float(__builtin_amdgcn_readlane(iv, 32)) + __int_as_float(__builtin_amdgcn_readlane(iv, 48)));
}

#define XB_TMO      128
#define XB_XCNT(j)  (256  + 64 * (j))
#define XB_XSUB(j)  (1280 + 64 * (j))
#define XB_XGEN(j)  (2304 + 64 * (j))
#define XB_TOP      3328
#define XB_TOPGEN   3392
#define XB_WORDS    3456
#define XB_SPIN_CAP (1u << 22)
__device__ __forceinline__ unsigned xb_ld(unsigned* p)              { return __hip_atomic_load(p, __ATOMIC_RELAXED, __HIP_MEMORY_SCOPE_AGENT); }
__device__ __forceinline__ unsigned xb_add(unsigned* p, unsigned v) { return __hip_atomic_fetch_add(p, v, __ATOMIC_RELAXED, __HIP_MEMORY_SCOPE_AGENT); }
__device__ __forceinline__ unsigned xb_xcc_id() { return (unsigned)__builtin_amdgcn_s_getreg((3 << 11) | 20) & 0xFu; }
#define XB_SPIN(cond, bar) do { unsigned _sp = 0; while (cond) { __builtin_amdgcn_s_sleep(1); \
    if ((++_sp & 255u) == 0u) { if (xb_ld(&(bar)[XB_TMO])) break; if (_sp > XB_SPIN_CAP) { atomicAdd(&(bar)[XB_TMO], 1u); break; } } } } while (0)
__device__ __forceinline__ void xcd_barrier_complete(unsigned* bar, unsigned x, unsigned& nloc, unsigned& nx) {
    const unsigned G = gridDim.x; unsigned sum, cnt, mine, sp = 0u;
    for (;;) { sum = 0u; cnt = 0u; mine = 0u;
#pragma unroll
        for (unsigned j = 0; j < 16; ++j) { const unsigned c = xb_ld(&bar[XB_XCNT(j)]); sum += c; cnt += (c > 0u) ? 1u : 0u; mine = (j == x) ? c : mine; }
        if (sum == G) break;
        __builtin_amdgcn_s_sleep(1);
        if ((++sp & 255u) == 0u) { if (xb_ld(&bar[XB_TMO])) break; if (sp > XB_SPIN_CAP) { atomicAdd(&bar[XB_TMO], 1u); break; } } }
    nloc = mine > 0u ? mine : 1u; nx = cnt > 0u ? cnt : 1u;
}
__device__ __forceinline__ void grid_barrier(unsigned* bar, volatile LAS unsigned* st) {
    asm volatile("s_waitcnt vmcnt(0) lgkmcnt(0)" ::: "memory");
    __syncthreads();
    if (threadIdx.x == 0) {
        const unsigned x = xb_xcc_id();
        unsigned nloc = st[0], nx = st[1];
        if (nloc == 0u) { xcd_barrier_complete(bar, x, nloc, nx); st[0] = nloc; st[1] = nx; }
        const unsigned old = xb_add(&bar[XB_XSUB(x)], 1u);
        const unsigned gen = old / nloc;
        if (old + 1u == (gen + 1u) * nloc) {
            __builtin_amdgcn_fence(__ATOMIC_RELEASE, "agent");
            asm volatile("s_waitcnt vmcnt(0)" ::: "memory");
            const unsigned og = xb_add(&bar[XB_TOP], 1u);
            const unsigned tg = og / nx;
            if (og + 1u == (tg + 1u) * nx) xb_add(&bar[XB_TOPGEN], 1u);
            else XB_SPIN(xb_ld(&bar[XB_TOPGEN]) == tg, bar);
            __builtin_amdgcn_fence(__ATOMIC_ACQUIRE, "agent");
            xb_add(&bar[XB_XGEN(x)], 1u);
            asm volatile("s_waitcnt vmcnt(0)" ::: "memory");
        } else {
            XB_SPIN(xb_ld(&bar[XB_XGEN(x)]) == gen, bar);
            __builtin_amdgcn_fence(__ATOMIC_ACQUIRE, "agent");
            asm volatile("s_waitcnt vmcnt(0)" ::: "memory");
        }
    }
    __syncthreads();
}

namespace pg8 {
constexpr int BM = 256, BK = 64, HALF = 128, HTB = HALF * BK * 2, NXCD = 8, WGM = 8;
__host__ __device__ __forceinline__ int lds_byte(int r, int c) { const int st = (r >> 4) * 2 + (c >> 5), rr = r & 15, cc = c & 31, ob = rr * 64 + cc * 2; return st * 1024 + (ob ^ (((ob >> 9) & 1) << 5)); }
__host__ __device__ __forceinline__ void stage_rc(int b, int& R, int& C) { const int st = b / 1024, sb = b % 1024, swz = sb ^ (((sb >> 9) & 1) << 5); R = (st >> 1) * 16 + swz / 64; C = (st & 1) * 32 + (swz % 64) / 2; }
__host__ __device__ __forceinline__ int perm32(int rho) { const int n = rho >> 4, i = rho & 15; return 8 * (i >> 2) + 4 * n + (i & 3); }
struct Unit { int pm, pn, kind; };

__device__ __forceinline__ void map_unit(int L, int nM, int nN, Unit& u) {
    const int nwg = nM * nN; int wgid = L;
    { const int q = nwg / NXCD, r = nwg % NXCD, xcd = wgid % NXCD, off = wgid / NXCD; wgid = (xcd < r ? xcd * (q + 1) : r * (q + 1) + (xcd - r) * q) + off; }
    const int nig = WGM * nN, gid = wgid / nig, fm = gid * WGM, gsz = (nM - fm) < WGM ? (nM - fm) : WGM;
    u.pm = fm + ((wgid % nig) % gsz); u.pn = (wgid % nig) / gsz;
}
struct Sched1 {
    int nM, nN, G, c; const char* A; const char* Bt; size_t tstep;
    __device__ __forceinline__ bool next(int i, Unit& u) const { const long L = (long)i * G + c; if (L >= (long)nM * nN) return false; map_unit((int)L, nM, nN, u); u.kind = 0; return true; }
    __device__ __forceinline__ const char* aptr(const Unit& u) const { return A + (size_t)u.pm * tstep; }
    __device__ __forceinline__ const char* bptr(const Unit& u) const { return Bt + (size_t)u.pn * tstep; }
};
struct Sched2 {
    int nM, nN, G, c; const char* A0; const char* A1; const char* B0; const char* B1; size_t tstep;
    __device__ __forceinline__ bool next(int i, Unit& u) const { const long L = (long)(i >> 1) * G + c; if (L >= (long)nM * nN) return false; map_unit((int)L, nM, nN, u); u.kind = i & 1; return true; }
    __device__ __forceinline__ const char* aptr(const Unit& u) const { return (u.kind ? A1 : A0) + (size_t)u.pm * tstep; }
    __device__ __forceinline__ const char* bptr(const Unit& u) const { return (u.kind ? B1 : B0) + (size_t)u.pn * tstep; }
};

template <class Epi, class Sched>
__device__ __forceinline__ void gemm_phase(LAS unsigned char* lds, const int K, const Sched& S, const Epi& E) {
    const int tid = tid_opaque(), wid = __builtin_amdgcn_readfirstlane(tid >> 6), lane = tid & 63, wr = wid >> 2, wc = wid & 3, fr = lane & 15, fq = lane >> 4;
    const int nt = K / BK;
    unsigned voffA[2], voffB[2];
#pragma unroll
    for (int i = 0; i < 2; ++i) { int R, C; stage_rc(tid * 16 + i * 8192, R, C); const int Rb = Epi::PERM ? ((R & ~31) + perm32(R & 31)) : R;
        voffA[i] = (unsigned)(R * K + C) * 2u; voffB[i] = (unsigned)(Rb * K + C) * 2u; }
    const size_t kstep = (size_t)(BK * 2);
    const size_t hstep = (size_t)HALF * K * 2;
    const unsigned ldsw = (unsigned)wid * 1024u;
    const int aoff = lds_byte(wr * 64 + fr, fq * 8), boff = lds_byte(wc * 32 + fr, fq * 8);
#define PG8_SA(b, h) (((b) * 2 + (h)) * HTB)
#define PG8_SB(b, h) ((4 + (b) * 2 + (h)) * HTB)
#define PG8_STAGE(bufoff, gbase, voff) do { _Pragma("unroll") for (int _i = 0; _i < 2; ++_i) \
        __builtin_amdgcn_global_load_lds((const unsigned*)((const char*)(gbase) + (voff)[_i]), (LAS unsigned*)(lds + (bufoff) + ldsw + _i * 8192), 16, 0, 0); } while (0)
#define PG8_LDA(dst, b, h) do { _Pragma("unroll") for (int m = 0; m < 4; ++m) _Pragma("unroll") for (int k = 0; k < 2; ++k) dst[m][k] = *(const LAS bf16x8*)(lds + PG8_SA(b, h) + aoff + m * 2048 + k * 1024); } while (0)
#define PG8_LDB(dst, b, h) do { _Pragma("unroll") for (int n = 0; n < 2; ++n) _Pragma("unroll") for (int k = 0; k < 2; ++k) dst[n][k] = *(const LAS bf16x8*)(lds + PG8_SB(b, h) + boff + n * 2048 + k * 1024); } while (0)
#define PG8_MMA(ai, bj, At, Bt) do { __builtin_amdgcn_s_setprio(1); _Pragma("unroll") for (int m = 0; m < 4; ++m) _Pragma("unroll") for (int n = 0; n < 2; ++n) _Pragma("unroll") for (int k = 0; k < 2; ++k) \
        acc[ai][bj][m][n] = __builtin_amdgcn_mfma_f32_16x16x32_bf16(Bt[n][k], At[m][k], acc[ai][bj][m][n], 0, 0, 0); __builtin_amdgcn_s_setprio(0); } while (0)
#define PG8_WAIT_V(n) asm volatile("s_waitcnt vmcnt(" #n ")" ::: "memory")
#define PG8_WAIT_L(n) asm volatile("s_waitcnt lgkmcnt(" #n ")" ::: "memory")
#define PG8_BAR __builtin_amdgcn_s_barrier()
#define PG8_SCHED __builtin_amdgcn_sched_barrier(0)
    Unit cur, nxt; int ui = 0;
    if (!S.next(0, cur)) return;
    f32x4 acc[2][2][4][2];
#pragma unroll
    for (int a = 0; a < 2; ++a)
#pragma unroll
        for (int b = 0; b < 2; ++b)
#pragma unroll
            for (int m = 0; m < 4; ++m)
#pragma unroll
                for (int n = 0; n < 2; ++n) acc[a][b][m][n] = (f32x4){0.f, 0.f, 0.f, 0.f};
    bf16x8 At[4][2], B0[2][2], B1[2][2];
    const char* cA = S.aptr(cur); const char* cB = S.bptr(cur);
    PG8_STAGE(PG8_SB(0, 0), cB, voffB); PG8_STAGE(PG8_SA(0, 0), cA, voffA); PG8_STAGE(PG8_SB(0, 1), cB + hstep, voffB); PG8_STAGE(PG8_SA(0, 1), cA + hstep, voffA);
    if (wr == 1) PG8_BAR;
    PG8_WAIT_V(4); PG8_BAR;
    PG8_STAGE(PG8_SB(1, 0), cB + kstep, voffB); PG8_STAGE(PG8_SA(1, 0), cA + kstep, voffA); PG8_STAGE(PG8_SB(1, 1), cB + hstep + kstep, voffB);
    PG8_WAIT_V(6); PG8_BAR;
    for (;;) {
        const bool has_next = S.next(ui + 1, nxt);
        const char* nA = has_next ? S.aptr(nxt) : cA; const char* nB = has_next ? S.bptr(nxt) : cB;
        for (int t = 0; t < nt; t += 2) {
            const bool last = (t == nt - 2);
            const char* a1 = cA + (size_t)(t + 1) * kstep;
            const char* a2 = last ? nA : cA + (size_t)(t + 2) * kstep; const char* b2 = last ? nB : cB + (size_t)(t + 2) * kstep;
            const char* a3 = a2 + kstep; const char* b3 = b2 + kstep;
            PG8_LDB(B0, 0, 0); PG8_SCHED; PG8_LDA(At, 0, 0); PG8_STAGE(PG8_SA(1, 1), a1 + hstep, voffA);
            PG8_WAIT_L(8); PG8_BAR; PG8_WAIT_L(0); PG8_MMA(0, 0, At, B0); PG8_BAR; PG8_SCHED;
            PG8_LDB(B1, 0, 1); PG8_STAGE(PG8_SB(0, 0), b2, voffB);
            PG8_BAR; PG8_WAIT_L(0); PG8_MMA(0, 1, At, B1); PG8_BAR;
            PG8_LDA(At, 0, 1); PG8_STAGE(PG8_SA(0, 0), a2, voffA);
            PG8_BAR; PG8_WAIT_L(0); PG8_MMA(1, 0, At, B0); PG8_BAR; PG8_SCHED;
            PG8_STAGE(PG8_SB(0, 1), b2 + hstep, voffB);
            PG8_WAIT_V(6); PG8_BAR; PG8_MMA(1, 1, At, B1); PG8_BAR;
            PG8_LDB(B0, 1, 0); PG8_SCHED; PG8_LDA(At, 1, 0); PG8_STAGE(PG8_SA(0, 1), a2 + hstep, voffA);
            PG8_WAIT_L(8); PG8_BAR; PG8_WAIT_L(0); PG8_MMA(0, 0, At, B0); PG8_BAR; PG8_SCHED;
            PG8_LDB(B1, 1, 1); PG8_STAGE(PG8_SB(1, 0), b3, voffB);
            PG8_BAR; PG8_WAIT_L(0); PG8_MMA(0, 1, At, B1); PG8_BAR;
            PG8_LDA(At, 1, 1); PG8_STAGE(PG8_SA(1, 0), a3, voffA);
            PG8_BAR; PG8_WAIT_L(0); PG8_MMA(1, 0, At, B0); PG8_BAR; PG8_SCHED;
            PG8_STAGE(PG8_SB(1, 1), b3 + hstep, voffB);
            PG8_WAIT_V(6); PG8_BAR; PG8_MMA(1, 1, At, B1); PG8_BAR;
        }
        E(acc, cur, wr, wc, fr, fq);
        if (!has_next) break;
        if (!E.keep(cur)) {
#pragma unroll
        for (int a = 0; a < 2; ++a)
#pragma unroll
            for (int b = 0; b < 2; ++b)
#pragma unroll
                for (int m = 0; m < 4; ++m)
#pragma unroll
                    for (int n = 0; n < 2; ++n) acc[a][b][m][n] = (f32x4){0.f, 0.f, 0.f, 0.f};
        }
        cur = nxt; cA = nA; cB = nB; ++ui;
    }
    PG8_WAIT_V(0);
    if (wr == 0) PG8_BAR;
    PG8_BAR;
#undef PG8_SA
#undef PG8_SB
#undef PG8_STAGE
#undef PG8_LDA
#undef PG8_LDB
#undef PG8_MMA
#undef PG8_WAIT_V
#undef PG8_WAIT_L
#undef PG8_BAR
#undef PG8_SCHED
}
}
using pg8::Unit;

template <int ACT> __device__ __forceinline__ float actf(float v) { return ACT == 1 ? v * sigm(v) : (ACT == 2 ? sigm(v) : v); }
template <int ACT> __device__ __forceinline__ void store_tile_bf16(const f32x4 (&acc)[2][2][4][2], bf16_t* base  , int ld) {
#pragma unroll
    for (int ai = 0; ai < 2; ++ai)
#pragma unroll
        for (int m = 0; m < 4; ++m) { bf16_t* rowp = base + (size_t)(ai * 128 + m * 16) * ld;
#pragma unroll
            for (int bj = 0; bj < 2; ++bj) { const f32x4 v0 = acc[ai][bj][m][0], v1 = acc[ai][bj][m][1]; u32x4 w;
                w.x = cvt_pk_bf16(actf<ACT>(v0[0]), actf<ACT>(v0[1])); w.y = cvt_pk_bf16(actf<ACT>(v0[2]), actf<ACT>(v0[3]));
                w.z = cvt_pk_bf16(actf<ACT>(v1[0]), actf<ACT>(v1[1])); w.w = cvt_pk_bf16(actf<ACT>(v1[2]), actf<ACT>(v1[3]));
                *(u32x4*)(rowp + bj * 128) = w; } }
}
struct EpiG1 {
    static constexpr bool PERM = true;
    __device__ __forceinline__ bool keep(const Unit&) const { return false; }
    unsigned char *ws, *outb;
    __device__ __forceinline__ void operator()(const f32x4 (&acc)[2][2][4][2], const Unit& u, int wr, int wc, int fr, int fq) const {
        unsigned char* w = uniform_ptr(ws); unsigned char* ob = uniform_ptr(outb); asm volatile("" : "+s"(w), "+s"(ob));
        const int row0 = u.pm * 256 + wr * 64 + fr, pn = u.pn, cw = wc * 32 + 8 * fq;
        if (pn < 8) {
            bf16_t* base = (bf16_t*)(w + OFF_U) + (size_t)row0 * 1024 + pn * 128 + cw;
#pragma unroll
            for (int ai = 0; ai < 2; ++ai)
#pragma unroll
                for (int m = 0; m < 4; ++m) { const f32x4 a0 = acc[ai][0][m][0], a1 = acc[ai][0][m][1], g0 = acc[ai][1][m][0], g1 = acc[ai][1][m][1]; u32x4 wv;
                    wv.x = cvt_pk_bf16(a0[0] * sigm(g0[0]), a0[1] * sigm(g0[1])); wv.y = cvt_pk_bf16(a0[2] * sigm(g0[2]), a0[3] * sigm(g0[3]));
                    wv.z = cvt_pk_bf16(a1[0] * sigm(g1[0]), a1[1] * sigm(g1[1])); wv.w = cvt_pk_bf16(a1[2] * sigm(g1[2]), a1[3] * sigm(g1[3]));
                    *(u32x4*)(base + (size_t)(ai * 128 + m * 16) * 1024) = wv; }
        } else if (pn < 12) store_tile_bf16<1>(acc, (bf16_t*)(w + OFF_OGC) + (size_t)row0 * 1024 + (pn - 8) * 256 + cw, 1024);
        else if (pn < 25) store_tile_bf16<0>(acc, (bf16_t*)(w + OFF_RKVL) + (size_t)row0 * LDR + (pn - 12) * 256 + cw, LDR);
        else if (pn < 29) store_tile_bf16<1>(acc, (bf16_t*)(w + OFF_OGR) + (size_t)row0 * 1024 + (pn - 25) * 256 + cw, 1024);
        else if (pn < 33) store_tile_bf16<2>(acc, (bf16_t*)(w + OFF_GC) + (size_t)row0 * 1024 + (pn - 29) * 256 + cw, 1024);
        else store_tile_bf16<2>(acc, (bf16_t*)(ob + 64 * MiB) + (size_t)row0 * 1024 + (pn - 33) * 256 + cw, 1024);
    }
};
struct EpiLora {
    static constexpr bool PERM = true;
    __device__ __forceinline__ bool keep(const Unit&) const { return false; }
    bf16_t *DW, *AP;
    __device__ __forceinline__ void operator()(const f32x4 (&acc)[2][2][4][2], const Unit& u, int wr, int wc, int fr, int fq) const {
        const int row0 = u.pm * 256 + wr * 64 + fr, cw = wc * 32 + 8 * fq;
        bf16_t* base = (u.pn < 4 ? DW + (size_t)u.pn * 256 : AP + (size_t)(u.pn - 4) * 256) + (size_t)row0 * 1024 + cw;
        store_tile_bf16<0>(acc, base, 1024);
    }
};
struct EpiG2 {
    static constexpr bool PERM = true;
    const bf16_t *GC, *GR; bf16_t* M;
    __device__ __forceinline__ bool keep(const Unit& u) const { return u.kind == 0; }
    __device__ __forceinline__ void operator()(f32x4 (&acc)[2][2][4][2], const Unit& u, int wr, int wc, int fr, int fq) const {
        const size_t off0 = (size_t)(u.pm * 256 + wr * 64 + fr) * 1024 + u.pn * 256 + wc * 32 + 8 * fq;
#pragma unroll
        for (int ai = 0; ai < 2; ++ai)
#pragma unroll
            for (int m = 0; m < 4; ++m)
#pragma unroll
                for (int bj = 0; bj < 2; ++bj) { const size_t off = off0 + (size_t)(ai * 128 + m * 16) * 1024 + bj * 128;
                    const u32x4 gr = *(const u32x4*)(GR + off); f32x4& v0 = acc[ai][bj][m][0]; f32x4& v1 = acc[ai][bj][m][1];
                    const f32x4 r0 = {bflo(gr.x), bfhi(gr.x), bflo(gr.y), bfhi(gr.y)}, r1 = {bflo(gr.z), bfhi(gr.z), bflo(gr.w), bfhi(gr.w)};
                    if (u.kind == 0) { const u32x4 gc = *(const u32x4*)(GC + off);
                        const f32x4 c0 = {bflo(gc.x), bfhi(gc.x), bflo(gc.y), bfhi(gc.y)}, c1 = {bflo(gc.z), bfhi(gc.z), bflo(gc.w), bfhi(gc.w)};
#pragma unroll
                        for (int j = 0; j < 4; ++j) { v0[j] *= c0[j] * __builtin_amdgcn_rcpf(fmaxf(r0[j], 1e-30f)); v1[j] *= c1[j] * __builtin_amdgcn_rcpf(fmaxf(r1[j], 1e-30f)); }
                    } else { const f32x4 m0 = v0 * r0, m1 = v1 * r1; u32x4 w;
                        w.x = cvt_pk_bf16(m0[0], m0[1]); w.y = cvt_pk_bf16(m0[2], m0[3]); w.z = cvt_pk_bf16(m1[0], m1[1]); w.w = cvt_pk_bf16(m1[2], m1[3]);
                        *(u32x4*)(M + off) = w; } }
    }
};
struct EpiG3 {
    static constexpr bool PERM = false;
    const float *x, *mod, *fg; float* out; float* rowss; unsigned* pcnt;
    __device__ __forceinline__ bool keep(const Unit&) const { return false; }
    __device__ __forceinline__ void operator()(f32x4 (&acc)[2][2][4][2], const Unit& u, int wr, int wc, int fr, int fq) const {
        const int col0 = u.pn * 256 + wc * 32 + 4 * fq, row0 = u.pm * 256 + wr * 64 + fr; const size_t off0 = (size_t)row0 * 1024 + col0;
        const float* gp = mod + (size_t)(u.pm >> 3) * 3072 + 2048 + col0;
        { f32x4 gv[2][2];
#pragma unroll
        for (int bj = 0; bj < 2; ++bj)
#pragma unroll
            for (int n = 0; n < 2; ++n) gv[bj][n] = *(const f32x4*)(gp + bj * 128 + n * 16);
#pragma unroll
        for (int ai = 0; ai < 2; ++ai)
#pragma unroll
            for (int m = 0; m < 4; ++m) { float ps = 0.f;
#pragma unroll
                for (int bj = 0; bj < 2; ++bj)
#pragma unroll
                    for (int n = 0; n < 2; ++n) { const size_t off = off0 + (size_t)(ai * 128 + m * 16) * 1024 + bj * 128 + n * 16;
                        const f32x4 v = *(const f32x4*)(x + off) + gv[bj][n] * acc[ai][bj][m][n]; acc[ai][bj][m][n] = v; ps += v[0] * v[0] + v[1] * v[1] + v[2] * v[2] + v[3] * v[3]; }
                ps += __shfl_xor(ps, 16); ps += __shfl_xor(ps, 32);
                if (fq == 0) __hip_atomic_fetch_add(rowss + row0 + ai * 128 + m * 16, ps, __ATOMIC_RELAXED, __HIP_MEMORY_SCOPE_AGENT); } }
        asm volatile("s_waitcnt vmcnt(0)" ::: "memory");
        unsigned* pc = pcnt + u.pm * 2 + wr;
        if (fr == 0 && fq == 0) __hip_atomic_fetch_add(pc, 1u, __ATOMIC_RELAXED, __HIP_MEMORY_SCOPE_AGENT);
        { unsigned sp = 0; while (__hip_atomic_load(pc, __ATOMIC_RELAXED, __HIP_MEMORY_SCOPE_AGENT) < 16u && ++sp < (1u << 22)) __builtin_amdgcn_s_sleep(1); }
#pragma unroll
        for (int ai = 0; ai < 2; ++ai)
#pragma unroll
            for (int m = 0; m < 4; ++m) { const float ss = __hip_atomic_load(rowss + row0 + ai * 128 + m * 16, __ATOMIC_RELAXED, __HIP_MEMORY_SCOPE_AGENT);
                const float rstd = __builtin_amdgcn_rsqf(ss * (1.f / 1024.f) + 1e-6f);
#pragma unroll
                for (int bj = 0; bj < 2; ++bj)
#pragma unroll
                    for (int n = 0; n < 2; ++n) { const size_t off = off0 + (size_t)(ai * 128 + m * 16) * 1024 + bj * 128 + n * 16;
                        *(f32x4*)(out + off) = acc[ai][bj][m][n] * rstd * *(const f32x4*)(fg + col0 + bj * 128 + n * 16); } }
    }
};

__device__ void phase_mod(const Params& p, unsigned char* smem) {
    if (blockIdx.x >= 48) return;
    float* sc = (float*)smem;
    float* red = sc + 16384;
    const int tid = tid_opaque(), w = tid >> 6, lane = tid & 63;
    for (int i = tid; i < 16384; i += 512) { const int b = i >> 10, d = i & 1023; const float cv = p.c[i]; sc[d * 16 + b] = cv * sigm(cv); }
    __syncthreads();
    const int e = blockIdx.x * 64 + lane;
    float acc[16];
#pragma unroll
    for (int b = 0; b < 16; ++b) acc[b] = 0.f;
    for (int d0 = w * 128; d0 < w * 128 + 128; d0 += 16) {
        float wvs[16];
#pragma unroll
        for (int u = 0; u < 16; ++u) wvs[u] = p.ada_w[(size_t)(d0 + u) * 3072 + e];
#pragma unroll
        for (int u = 0; u < 16; ++u) { const int d = d0 + u; const float wv = wvs[u];
        const f32x4* s4 = (const f32x4*)(sc + d * 16);
#pragma unroll
        for (int q = 0; q < 4; ++q) { const f32x4 s = s4[q]; acc[4 * q] += s[0] * wv; acc[4 * q + 1] += s[1] * wv; acc[4 * q + 2] += s[2] * wv; acc[4 * q + 3] += s[3] * wv; }
        }
    }
#pragma unroll
    for (int b = 0; b < 16; ++b) red[(w * 16 + b) * 64 + lane] = acc[b];
    __syncthreads();
    float* mod = (float*)(p.ws + OFF_MOD);
    for (int i = tid; i < 1024; i += 512) { const int b = i >> 6, l = i & 63; float s = 0.f;
#pragma unroll
        for (int ww = 0; ww < 8; ++ww) s += red[(ww * 16 + b) * 64 + l];
        mod[b * 3072 + blockIdx.x * 64 + l] = s + p.ada_b[blockIdx.x * 64 + l]; }
    __syncthreads();
}
__device__ __forceinline__ void transpose_tile(const float* src, int ld, int n_src0, int k0, bf16_t* dst, int n_dst0, float* tile) {
    const int tid = tid_opaque();
#pragma unroll
    for (int r = 0; r < 2; ++r) { const int i = (tid >> 4) + 32 * r, j4 = (tid & 15) * 4;
        f32x4 v = {0.f, 0.f, 0.f, 0.f}; if (n_src0 >= 0) v = *(const f32x4*)(src + (size_t)(k0 + i) * ld + n_src0 + j4);
        tile[i * 65 + j4] = v[0]; tile[i * 65 + j4 + 1] = v[1]; tile[i * 65 + j4 + 2] = v[2]; tile[i * 65 + j4 + 3] = v[3]; }
    __syncthreads();
    const int j = tid >> 3, i8 = (tid & 7) * 8; u32x4 w;
    w.x = cvt_pk_bf16(tile[(i8 + 0) * 65 + j], tile[(i8 + 1) * 65 + j]); w.y = cvt_pk_bf16(tile[(i8 + 2) * 65 + j], tile[(i8 + 3) * 65 + j]);
    w.z = cvt_pk_bf16(tile[(i8 + 4) * 65 + j], tile[(i8 + 5) * 65 + j]); w.w = cvt_pk_bf16(tile[(i8 + 6) * 65 + j], tile[(i8 + 7) * 65 + j]);
    *(u32x4*)(dst + (size_t)(n_dst0 + j) * 1024 + k0 + i8) = w;
    __syncthreads();
}
__device__ void phase_weights(const Params& p, unsigned char* smem) {
    float* tile = (float*)smem;
    for (int i = blockIdx.x * 512 + threadIdx.x; i < T + 256; i += gridDim.x * 512) ((unsigned*)(p.ws + OFF_ROWSS))[i] = 0u;
    bf16_t* WinT = (bf16_t*)(p.ws + OFF_WINT); bf16_t* W2T = (bf16_t*)(p.ws + OFF_W2T); bf16_t* WoT = (bf16_t*)(p.ws + OFF_WOT); bf16_t* LBt = (bf16_t*)(p.ws + OFF_LBT);
    constexpr int NT1 = (N1 / 64) * 16;
    for (int idx = blockIdx.x; idx < NT1 + 768; idx += gridDim.x) {
        if (idx < NT1) { const int a = idx >> 4, kt = idx & 15, n0 = a * 64; int src;
            if (n0 < 2048) { const int j = n0 >> 8, wi = n0 & 255; src = wi < 128 ? 128 * j + wi : 1024 + 128 * j + wi - 128; }
            else if (n0 < 6272) src = n0; else if (n0 < 6400) src = -1; else src = n0 - 128;
            transpose_tile(p.w_in, 9344, src, kt * 64, WinT, n0, tile);
        } else { const int r = idx - NT1, which = r >> 8, a = (r >> 4) & 15, kt = r & 15;
            const float* src = which == 0 ? p.w_conv_out : (which == 1 ? p.w_rwkv_out : p.w_out);
            bf16_t* dst = which == 0 ? W2T : (which == 1 ? W2T + (size_t)1024 * 1024 : WoT);
            transpose_tile(src, 1024, a * 64, kt * 64, dst, a * 64, tile); }
    }
    for (int idx = blockIdx.x * 512 + tid_opaque(); idx < 2048 * 128; idx += gridDim.x * 512) { const int n = idx >> 7, k = idx & 127; float v = 0.f;
        if (n < 1024) { if (k < 64) v = p.rwkv_w2[k * 1024 + n]; } else { if (k >= 64) v = p.rwkv_a2[(k - 64) * 1024 + n - 1024]; }
        LBt[idx] = f2bf(v); }
}
__device__ void phase_h(const Params& p) {
    const int tid = tid_opaque(), w = tid >> 6, lane = tid & 63;
    const float* mod = (const float*)(p.ws + OFF_MOD); bf16_t* Hh = (bf16_t*)p.out;
    for (int tok = blockIdx.x * 8 + w; tok < T; tok += gridDim.x * 8) {
        const int b = tok >> 11; const float* xr = p.x + (size_t)tok * 1024; f32x4 v[4]; float ss = 0.f;
#pragma unroll
        for (int q = 0; q < 4; ++q) { v[q] = *(const f32x4*)(xr + q * 256 + lane * 4); ss += v[q][0] * v[q][0] + v[q][1] * v[q][1] + v[q][2] * v[q][2] + v[q][3] * v[q][3]; }
        ss = wave_sum(ss); const float rstd = rsqrtf(ss * (1.f / 1024.f) + 1e-6f);
#pragma unroll
        for (int q = 0; q < 4; ++q) { const int col = q * 256 + lane * 4; const f32x4 g = *(const f32x4*)(p.norm_g + col), sh = *(const f32x4*)(mod + b * 3072 + col), sc = *(const f32x4*)(mod + b * 3072 + 1024 + col);
            const f32x4 y = v[q] * rstd * g * (sc + 1.f) + sh; u32x2 o; o.x = cvt_pk_bf16(y[0], y[1]); o.y = cvt_pk_bf16(y[2], y[3]);
            *(u32x2*)(Hh + (size_t)tok * 1024 + col) = o; }
    }
}
__device__ void phase_conv(const Params& p, unsigned char* smem) {
    const int tid = tid_opaque(), w = tid >> 6, lane = tid & 63, c0 = tid * 2;
    const bf16_t* U = (const bf16_t*)(p.ws + OFF_U); bf16_t* OGC = (bf16_t*)(p.ws + OFF_OGC);
    float* part = (float*)smem;
    float* stat = part + 32 * 512;
    f32x2 wk[31];
#pragma unroll
    for (int j = 0; j < 31; ++j) wk[j] = *(const f32x2*)(p.conv_k + j * 1024 + c0);
    const f32x2 cb = *(const f32x2*)(p.conv_b + c0), lg = *(const f32x2*)(p.conv_ln_g + c0), lb = *(const f32x2*)(p.conv_ln_b + c0);
    for (int tile = blockIdx.x; tile < T / 16; tile += gridDim.x) {
        const int b = tile >> 7, t0 = (tile & 127) * 16; const size_t row0 = (size_t)b * SEQ + t0;
        f32x2 u[46];
#pragma unroll
        for (int i = 0; i < 46; ++i) { const int t = t0 - 30 + i; unsigned v = 0u; if (t >= 0) v = *(const unsigned*)(U + ((size_t)b * SEQ + t) * 1024 + c0); u[i] = (f32x2){bflo(v), bfhi(v)}; }
        f32x2 o[16];
#pragma unroll
        for (int i = 0; i < 16; ++i) { f32x2 a = cb;
#pragma unroll
            for (int j = 0; j < 31; ++j) a = wk[j] * u[i + j] + a;
            o[i] = a; }
#pragma unroll
        for (int i = 0; i < 16; ++i) { part[i * 512 + tid] = o[i].x + o[i].y; part[(16 + i) * 512 + tid] = o[i].x * o[i].x + o[i].y * o[i].y; }
        __syncthreads();
#pragma unroll
        for (int q = 0; q < 4; ++q) { const int v = 4 * w + q; float s = 0.f;
#pragma unroll
            for (int r = 0; r < 8; ++r) s += part[v * 512 + lane + 64 * r];
            s = wave_sum(s); if (lane == 0) stat[v] = s; }
        __syncthreads();
#pragma unroll
        for (int i = 0; i < 16; ++i) { const float mean = stat[i] * (1.f / 1024.f), var = stat[16 + i] * (1.f / 1024.f) - mean * mean, rstd = __builtin_amdgcn_rsqf(var + 1e-5f);
            float y0 = (o[i].x - mean) * rstd * lg.x + lb.x, y1 = (o[i].y - mean) * rstd * lg.y + lb.y; y0 *= sigm(y0); y1 *= sigm(y1);
            bf16_t* gp = OGC + (row0 + i) * 1024 + c0; const unsigned og = *(const unsigned*)gp;
            *(unsigned*)gp = cvt_pk_bf16(y0 * bflo(og), y1 * bfhi(og)); }
    }
    const bf16_t* RK = (const bf16_t*)(p.ws + OFF_RKVL); bf16_t* AL = (bf16_t*)(p.ws + OFF_ALORA);
    for (int idx = blockIdx.x * 512 + tid; idx < T * 128; idx += gridDim.x * 512) { const int t = idx >> 7, j = idx & 127;
        const float z = bf2f(RK[(size_t)t * LDR + 3072 + j]), pv = (t & (SEQ - 1)) ? bf2f(RK[(size_t)(t - 1) * LDR + 3072 + j]) : 0.f;
        const float s = z + p.rwkv_mu[3072 + j] * (pv - z); const float val = j < 64 ? tanhf(s) : s;
        AL[(size_t)t * 128 + j] = f2bf(val); }
}
constexpr int SCH = 32, SNCH = SEQ / SCH, SREC = 272;
struct ScanRaw { unsigned v[8], wa[8]; };
struct ScanOps { f32x4 a[8], b[4], k[4]; };
struct ScanC { float mu_r, mu_k, mu_v, w0c, a0c, kkc, kac, rkc, gng, gnb; };
__device__ __forceinline__ void scan_load_raw(ScanRaw& R, f32x2 (&S)[8], const bf16_t* RK, const bf16_t* DW, const bf16_t* AP, int b, int c, int pw, int ch) {
#pragma unroll
    for (int i = 0; i < 8; ++i) { const int t = c * SCH + 8 * pw + i; const size_t row = (size_t)b * SEQ + t; const bf16_t* rp = RK + row * LDR + ch;
        const bf16_t* rq = t > 0 ? rp - LDR : rp;
        S[i >> 1][i & 1] = __uint_as_float((unsigned)rp[0] | ((unsigned)rq[0] << 16)); S[4 + (i >> 1)][i & 1] = __uint_as_float((unsigned)rp[1024] | ((unsigned)rq[1024] << 16));
        R.v[i] = (unsigned)rp[2048] | ((unsigned)rq[2048] << 16); R.wa[i] = (unsigned)DW[row * 1024 + ch] | ((unsigned)AP[row * 1024 + ch] << 16); }
}
__device__ __forceinline__ void scan_prep(const ScanRaw& R, const f32x2 (&S)[8], const ScanC& C, int c, int pw, int lane, unsigned seq, float* rec, float* vbuf, f32x4* scl, float* wtot, float* ptot, volatile unsigned* flag) {
    float kkA[8], rA[8], nbA[8], kpA[8], LA[8]; float L = 1.f;
#pragma unroll
    for (int i = 0; i < 8; ++i) { const int tt = 8 * pw + i, t = c * SCH + tt;
        const unsigned Rr = __float_as_uint(S[i >> 1][i & 1]), Rk = __float_as_uint(S[4 + (i >> 1)][i & 1]);
        float r = bflo(Rr), k = bflo(Rk), v = bflo(R.v[i]); const float pm = t > 0 ? 1.f : 0.f;
        const float r1 = pm * bfhi(Rr), k1 = pm * bfhi(Rk), v1 = pm * bfhi(R.v[i]);
        r += C.mu_r * (r1 - r); k += C.mu_k * (k1 - k); v += C.mu_v * (v1 - v);
        const float wpre = C.w0c + bflo(R.wa[i]), apre = C.a0c + bfhi(R.wa[i]);
        const float decay = __expf(-0.60653066f * sigm(wpre)), a = sigm(apre);
        const float kkv = k * C.kkc, n2 = wave_sum(kkv * kkv), kk = kkv * __builtin_amdgcn_rsqf(fmaxf(n2, 1e-24f));
        const float kp = k * (1.f + (a - 1.f) * C.kac), bv = kk * a;
        const float br = wave_sum(bv * r), kr = wave_sum(kp * r), bonus = wave_sum(r * kp * C.rkc);
        L *= decay; kkA[i] = kk; rA[i] = r; nbA[i] = -bv; kpA[i] = kp; LA[i] = L;
        vbuf[tt * 64 + lane] = v;
        if (lane == 0) scl[tt] = (f32x4){-br, kr, bonus, 0.f};
        if (i & 1) __builtin_amdgcn_sched_barrier(0);
    }
    wtot[pw * 64 + lane] = L;
    asm volatile("s_waitcnt lgkmcnt(0)" ::: "memory");
    if (lane == 0) flag[pw] = seq;
    float Pw = 1.f;
    for (int ww = 0; ww < pw; ++ww) { while (flag[ww] != seq) __builtin_amdgcn_s_sleep(1);
        asm volatile("" ::: "memory"); Pw *= wtot[ww * 64 + lane]; }
    if (pw == 3) ptot[lane] = Pw * L;
    float Pprev = Pw;
#pragma unroll
    for (int i = 0; i < 8; ++i) { const int tt = 8 * pw + i; const float Pt = Pw * LA[i], ip = __builtin_amdgcn_rcpf(Pt);
        float* rc = rec + tt * SREC + (lane >> 4) * 68; const int e = lane & 15;
        *(f32x2*)(rc + 2 * e) = (f32x2){Pprev * kkA[i], Pt * rA[i]}; rc[32 + e] = nbA[i] * ip; rc[48 + e] = kpA[i] * ip;
        Pprev = Pt; }
}
__device__ __forceinline__ void scan_post(const bf16_t (&og)[8], bf16_t* dst0, const ScanC& C, int pw, int lane, const float* obuf, const float* vbuf, const f32x4* scl) {
#pragma unroll
    for (int i = 0; i < 8; ++i) { const int tt = pw + 4 * i;
        const float o = obuf[tt * 64 + lane], mean = wave_sum(o) * (1.f / 64.f), d = o - mean, var = wave_sum(d * d) * (1.f / 64.f);
        float y = d * __builtin_amdgcn_rsqf(var + 64e-5f) * C.gng + C.gnb; y += scl[tt].z * vbuf[tt * 64 + lane];
        dst0[(size_t)i * 4096] = f2bf(y * bf2f(og[i])); }
}
__device__ __forceinline__ void scan_load_ops(ScanOps& o, const f32x4* rq) {
#pragma unroll
    for (int j = 0; j < 8; ++j) o.a[j] = rq[j];
#pragma unroll
    for (int j = 0; j < 4; ++j) { o.b[j] = rq[8 + j]; o.k[j] = rq[12 + j]; }
}
__device__ __forceinline__ void scan_step(f32x2 (&S)[8], ScanOps& q, const f32x4* rn, const float v, const bool lead, const f32x2 sc, float* obuf, float* dump, int tt, int srow) {
    f32x2 vv = {v, v}; asm volatile("" : "+v"(vv));
    f32x2 d0 = S[0].x * (f32x2){q.a[0][0], q.a[0][1]}, d1 = S[0].y * (f32x2){q.a[0][2], q.a[0][3]}, d2 = S[1].x * (f32x2){q.a[1][0], q.a[1][1]}, d3 = S[1].y * (f32x2){q.a[1][2], q.a[1][3]};
#pragma unroll
    for (int j = 2; j < 8; j += 2) { d0 += S[j].x * (f32x2){q.a[j][0], q.a[j][1]}; d1 += S[j].y * (f32x2){q.a[j][2], q.a[j][3]};
        d2 += S[j + 1].x * (f32x2){q.a[j + 1][0], q.a[j + 1][1]}; d3 += S[j + 1].y * (f32x2){q.a[j + 1][2], q.a[j + 1][3]}; }
#pragma unroll
    for (int j = 0; j < 8; ++j) q.a[j] = rn[j];
    const f32x2 d = (d0 + d1) + (d2 + d3);
    float sk = d.x, o = d.y;
    sk = dpp_add<0xB1>(sk); o = dpp_add<0xB1>(o); sk = dpp_add<0x4E>(sk); o = dpp_add<0x4E>(o);
#pragma unroll
    for (int j = 0; j < 4; ++j) { S[2 * j] += sk * (f32x2){q.b[j][0], q.b[j][1]}; S[2 * j + 1] += sk * (f32x2){q.b[j][2], q.b[j][3]}; }
#pragma unroll
    for (int j = 0; j < 4; ++j) { S[2 * j] += vv * (f32x2){q.k[j][0], q.k[j][1]}; S[2 * j + 1] += vv * (f32x2){q.k[j][2], q.k[j][3]}; }
#pragma unroll
    for (int j = 0; j < 4; ++j) { q.b[j] = rn[8 + j]; q.k[j] = rn[12 + j]; }
    float* op = lead ? obuf + tt * 64 + srow : dump; *op = o + sk * sc.x + v * sc.y;
}
__device__ void phase_scan(const Params& p, unsigned char* smem) {
    const int tid = tid_opaque(), w = tid >> 6, lane = tid & 63, g = lane & 3, srow = (w & 3) * 16 + (lane >> 2), pw = w & 3;
    const bool cons = w < 4, lead = (g == 0);
    float* recb = (float*)smem;
    float* vbufb = recb + 2 * SCH * SREC;
    float* obufb = vbufb + 3 * SCH * 64;
    f32x4* sclb = (f32x4*)(obufb + 2 * SCH * 64);
    float* wtot = (float*)(sclb + 3 * SCH);
    float* ptotb = wtot + 256;
    volatile unsigned* flag = (volatile unsigned*)(ptotb + 128);
    float* dump = (float*)(ptotb + 128) + 8;
    const bf16_t* RK = (const bf16_t*)(p.ws + OFF_RKVL); const bf16_t* DW = (const bf16_t*)(p.ws + OFF_DW); const bf16_t* AP = (const bf16_t*)p.out;
    bf16_t* OGR = (bf16_t*)(p.ws + OFF_OGR);
    unsigned seq = 0;
    for (int bh = blockIdx.x; bh < 256; bh += gridDim.x) {
        const int b = bh >> 4, h = bh & 15, ch = h * 64 + lane;
        const ScanC C{p.rwkv_mu[ch], p.rwkv_mu[1024 + ch], p.rwkv_mu[2048 + ch], p.rwkv_w0[ch], p.rwkv_a0[ch], p.rwkv_k_k[ch], p.rwkv_k_a[ch], p.rwkv_r_k[ch], p.rwkv_gn_g[ch], p.rwkv_gn_b[ch]};
        f32x2 S[8];
#pragma unroll
        for (int i = 0; i < 8; ++i) S[i] = (f32x2){0.f, 0.f};
        ScanRaw R;
        if (tid < 4) flag[tid] = 0u;
        __syncthreads();
        ++seq;
        if (!cons) { scan_load_raw(R, S, RK, DW, AP, b, 0, pw, ch); scan_prep(R, S, C, 0, pw, lane, seq, recb, vbufb, sclb, wtot, ptotb, flag); scan_load_raw(R, S, RK, DW, AP, b, 1, pw, ch); }
        __syncthreads();
        for (int c = 0; c < SNCH; ++c) {
            const int cb = c & 1, c3 = c % 3, n3 = (c + 1) % 3, p3 = (c + 2) % 3;
            ++seq;
            if (cons) {
                const float* vb = vbufb + c3 * (SCH * 64); const f32x2* sc2 = (const f32x2*)(sclb + c3 * SCH); float* ob = obufb + cb * (SCH * 64);
                const f32x4* rq = (const f32x4*)(recb + cb * (SCH * SREC) + g * 68);
                ScanOps A; scan_load_ops(A, rq);
                float v0 = vb[srow]; f32x2 s0 = sc2[0];
                for (int tt = 0; tt < SCH; ++tt) {
                    const int tn = tt + 1 < SCH ? tt + 1 : SCH - 1;
                    const float nv0 = vb[tn * 64 + srow]; const f32x2 ns0 = sc2[2 * tn];
                    scan_step(S, A, rq + tn * (SREC / 4), v0, lead, s0, ob, dump, tt, srow);
                    v0 = nv0; s0 = ns0;
                }
                { const f32x4* pq = (const f32x4*)(ptotb + cb * 64 + g * 16);
#pragma unroll
                    for (int j = 0; j < 4; ++j) { const f32x4 pp = pq[j]; S[2 * j] *= (f32x2){pp[0], pp[1]}; S[2 * j + 1] *= (f32x2){pp[2], pp[3]}; } }
            } else {
                bf16_t og[8]; bf16_t* dst0 = OGR + ((size_t)b * SEQ + (c > 0 ? c - 1 : 0) * SCH + pw) * 1024 + ch;
#pragma unroll
                for (int i = 0; i < 8; ++i) og[i] = dst0[(size_t)i * 4096];
                if (c + 1 < SNCH) { scan_prep(R, S, C, c + 1, pw, lane, seq, recb + (cb ^ 1) * (SCH * SREC), vbufb + n3 * (SCH * 64), sclb + n3 * SCH, wtot, ptotb + (cb ^ 1) * 64, flag);
                    if (c + 2 < SNCH) scan_load_raw(R, S, RK, DW, AP, b, c + 2, pw, ch); }
                if (c > 0) scan_post(og, dst0, C, pw, lane, obufb + (cb ^ 1) * (SCH * 64), vbufb + p3 * (SCH * 64), sclb + p3 * SCH);
            }
            __syncthreads();
        }
        if (!cons) { const int cl = SNCH - 1; bf16_t og[8]; bf16_t* dst0 = OGR + ((size_t)b * SEQ + cl * SCH + pw) * 1024 + ch;
#pragma unroll
            for (int i = 0; i < 8; ++i) og[i] = dst0[(size_t)i * 4096];
            scan_post(og, dst0, C, pw, lane, obufb + (cl & 1) * (SCH * 64), vbufb + (cl % 3) * (SCH * 64), sclb + (cl % 3) * SCH); }
        __syncthreads();
    }
}
__device__ void phase_final(const Params& p) {
    const int tid = tid_opaque(), w = tid >> 6, lane = tid & 63;
    for (int tok = blockIdx.x * 8 + w; tok < T; tok += gridDim.x * 8) {
        float* xr = p.out + (size_t)tok * 1024; f32x4 v[4]; float ss = 0.f;
#pragma unroll
        for (int q = 0; q < 4; ++q) { v[q] = *(const f32x4*)(xr + q * 256 + lane * 4); ss += v[q][0] * v[q][0] + v[q][1] * v[q][1] + v[q][2] * v[q][2] + v[q][3] * v[q][3]; }
        ss = wave_sum(ss); const float rstd = rsqrtf(ss * (1.f / 1024.f) + 1e-6f);
#pragma unroll
        for (int q = 0; q < 4; ++q) { const int col = q * 256 + lane * 4; *(f32x4*)(xr + col) = v[q] * rstd * *(const f32x4*)(p.final_g + col); }
    }
}

template <int FIRST, int LAST> __global__ __launch_bounds__(512, 2) void mega(Params p) {
    extern __shared__ __attribute__((aligned(16))) unsigned char smem[];
    LAS unsigned char* lds = (LAS unsigned char*)smem;
    cg::grid_group grid = cg::this_grid();
    unsigned* bar = (unsigned*)(uniform_ptr(p.ws) + OFF_BAR);
    volatile LAS unsigned* st = (volatile LAS unsigned*)(lds + LDS_BYTES);
    if (threadIdx.x == 0) { st[0] = 0u; st[1] = 0u; (void)xb_add(&bar[XB_XCNT(xb_xcc_id())], 1u); }
    __syncthreads();
    if (p.ws == nullptr) grid.sync();
    unsigned char* ws = p.ws;
    const int G = gridDim.x, c = blockIdx.x;
    if (FIRST <= 0 && 0 < LAST) { phase_mod(p, smem); phase_weights(p, smem); }
    if (FIRST <= 1 && 1 < LAST) { if (FIRST < 1) grid_barrier(bar, st); phase_h(p); }
    if (FIRST <= 2 && 2 < LAST) { if (FIRST < 2) grid_barrier(bar, st);
        pg8::Sched1 S{T / 256, N1 / 256, G, c, (const char*)p.out, (const char*)(ws + OFF_WINT), (size_t)256 * 1024 * 2};
        EpiG1 E{ws, (unsigned char*)p.out};
        pg8::gemm_phase(lds, 1024, S, E); }
    if (FIRST <= 3 && 3 < LAST) { if (FIRST < 3) grid_barrier(bar, st); phase_conv(p, smem); }
    if (FIRST <= 4 && 4 < LAST) { if (FIRST < 4) grid_barrier(bar, st);
        pg8::Sched1 S{T / 256, 2048 / 256, G, c, (const char*)(ws + OFF_ALORA), (const char*)(ws + OFF_LBT), (size_t)256 * 128 * 2};
        EpiLora E{(bf16_t*)(ws + OFF_DW), (bf16_t*)p.out};
        pg8::gemm_phase(lds, 128, S, E); }
    if (FIRST <= 5 && 5 < LAST) { if (FIRST < 5) grid_barrier(bar, st); phase_scan(p, smem); }
    if (FIRST <= 6 && 6 < LAST) { if (FIRST < 6) grid_barrier(bar, st);
        pg8::Sched2 S{T / 256, 4, G, c, (const char*)(ws + OFF_OGC), (const char*)(ws + OFF_OGR), (const char*)(ws + OFF_W2T), (const char*)(ws + OFF_W2T + 2 * MiB), (size_t)256 * 1024 * 2};
        EpiG2 E{(const bf16_t*)(ws + OFF_GC), (const bf16_t*)((unsigned char*)p.out + 64 * MiB), (bf16_t*)(ws + OFF_M)};
        pg8::gemm_phase(lds, 1024, S, E); }
    if (FIRST <= 7 && 7 < LAST) { if (FIRST < 7) grid_barrier(bar, st);
        pg8::Sched1 S{T / 256, 4, G, c, (const char*)(ws + OFF_M), (const char*)(ws + OFF_WOT), (size_t)256 * 1024 * 2};
        EpiG3 E{p.x, (const float*)(ws + OFF_MOD), p.final_g, p.out, (float*)(ws + OFF_ROWSS), (unsigned*)(ws + OFF_PCNT)};
        pg8::gemm_phase(lds, 1024, S, E); }
}

template <int PH> static void launch_one(const Params& p, hipStream_t stream) {
    hipFuncSetAttribute((const void*)mega<PH, PH + 1>, hipFuncAttributeMaxDynamicSharedMemorySize, LDS_BYTES);
    mega<PH, PH + 1><<<256, 512, LDS_BYTES, stream>>>(p);
}

extern "C" void kernel_launch(void* const* d_in, const int* in_sizes, int n_in, void* d_out, int out_size, void* d_ws, size_t ws_size, hipStream_t stream) {
    Params p{};
    const float** f = (const float**)&p;
    for (int i = 0; i < 24; ++i) f[i] = (const float*)d_in[i];
    p.out = (float*)d_out; p.ws = (unsigned char*)d_ws;
    if (ws_size < WS_END) { fprintf(stderr, "workspace too small: %zu < %zu\n", ws_size, (size_t)WS_END); return; }
#if SINGLE_LAUNCH
    static int grid_blocks = 0;
    if (!grid_blocks) {
        int dev = 0, cus = 0, per_cu = 0;
        hipGetDevice(&dev);
        hipDeviceGetAttribute(&cus, hipDeviceAttributeMultiprocessorCount, dev);
        hipFuncSetAttribute((const void*)mega<0, NPHASE>, hipFuncAttributeMaxDynamicSharedMemorySize, LDS_BYTES + 16);
        hipOccupancyMaxActiveBlocksPerMultiprocessor(&per_cu, mega<0, NPHASE>, 512, LDS_BYTES + 16);
        grid_blocks = cus * (per_cu > 1 ? 1 : per_cu);
        if (grid_blocks > 256) grid_blocks = 256;
    }
    hipMemsetAsync((unsigned char*)d_ws + OFF_BAR, 0, 3456 * 4, stream);
    void* args[] = {(void*)&p};
    hipError_t e = hipLaunchCooperativeKernel((const void*)mega<0, NPHASE>, dim3(grid_blocks), dim3(512), args, LDS_BYTES + 16, stream);
    if (e != hipSuccess) fprintf(stderr, "cooperative launch failed: %s (grid %d)\n", hipGetErrorString(e), grid_blocks);
#else
    launch_one<0>(p, stream); launch_one<1>(p, stream); launch_one<2>(p, stream); launch_one<3>(p, stream); launch_one<4>(p, stream);
    launch_one<5>(p, stream); launch_one<6>(p, stream); launch_one<7>(p, stream); launch_one<8>(p, stream);
#endif
}
```

```cpp
#include <hip/hip_runtime.h>
#include <hip/hip_cooperative_groups.h>
#include <cstdio>
namespace cg = cooperative_groups;

#ifndef SINGLE_LAUNCH
#define SINGLE_LAUNCH 1
#endif

#define LAS __attribute__((address_space(3)))
typedef unsigned short bf16_t;
typedef short bf16x8 __attribute__((ext_vector_type(8)));
typedef float f32x8 __attribute__((ext_vector_type(8)));
typedef float f32x4 __attribute__((ext_vector_type(4)));
typedef float f32x2 __attribute__((ext_vector_type(2)));
typedef unsigned u32x4 __attribute__((ext_vector_type(4)));
typedef unsigned u32x2 __attribute__((ext_vector_type(2)));

constexpr int T = 32768, DM = 1024, SEQ = 2048, NB_ = 16;
constexpr int N1 = 9472;
constexpr int LDR = 3328;
constexpr int LDS_BYTES = 131072;
constexpr int NPHASE = 9;

constexpr size_t MiB = 1u << 20;
constexpr size_t OFF_U = 0, OFF_OGC = 64 * MiB, OFF_RKVL = 128 * MiB, OFF_OGR = 336 * MiB, OFF_GC = 400 * MiB, OFF_WINT = 464 * MiB;
constexpr size_t OFF_ALORA = OFF_WINT + (size_t)N1 * 1024 * 2;
constexpr size_t OFF_W2T = OFF_ALORA + 16 * MiB, OFF_WOT = OFF_W2T + 4 * MiB, OFF_LBT = OFF_WOT + 2 * MiB, OFF_MOD = OFF_LBT + 1 * MiB;
constexpr size_t OFF_BAR = OFF_MOD + 16 * 3072 * 4;
constexpr size_t OFF_ROWSS = OFF_BAR + 3456 * 4 + 128;
constexpr size_t OFF_PCNT = OFF_ROWSS + (size_t)T * 4;
constexpr size_t WS_END = OFF_PCNT + 256 * 4;
constexpr size_t OFF_MP = OFF_RKVL, OFF_M = OFF_RKVL + 128 * MiB, OFF_DW = OFF_U;

struct Params {
    const float *x, *c, *ada_w, *ada_b, *norm_g, *w_in, *conv_k, *conv_b, *conv_ln_g, *conv_ln_b, *w_conv_out, *rwkv_mu, *rwkv_w0, *rwkv_w2, *rwkv_a0, *rwkv_a2,
        *rwkv_k_k, *rwkv_k_a, *rwkv_r_k, *rwkv_gn_g, *rwkv_gn_b, *w_rwkv_out, *w_out, *final_g;
    float* out;
    unsigned char* ws;
};

typedef __bf16 bf16x2_t __attribute__((ext_vector_type(2)));
__device__ __forceinline__ unsigned cvt_pk_bf16(float lo, float hi) { const bf16x2_t r = __builtin_convertvector((f32x2){lo, hi}, bf16x2_t); return __builtin_bit_cast(unsigned, r); }
__device__ __forceinline__ bf16_t f2bf(float f) { return (bf16_t)(cvt_pk_bf16(f, 0.f) & 0xffffu); }
__device__ __forceinline__ float bf2f(bf16_t b) { return __uint_as_float(((unsigned)b) << 16); }
__device__ __forceinline__ float bflo(unsigned v) { return __uint_as_float(v << 16); }
__device__ __forceinline__ float bfhi(unsigned v) { return __uint_as_float(v & 0xffff0000u); }
__device__ __forceinline__ float sigm(float x) { return __builtin_amdgcn_rcpf(1.f + __expf(-x)); }
__device__ __forceinline__ int tid_opaque() { int t = threadIdx.x; asm volatile("" : "+v"(t)); return t; }
__device__ __forceinline__ unsigned char* uniform_ptr(unsigned char* p) { const size_t v = (size_t)p; const unsigned lo = __builtin_amdgcn_readfirstlane((unsigned)v), hi = __builtin_amdgcn_readfirstlane((unsigned)(v >> 32)); return (unsigned char*)(((size_t)hi << 32) | lo); }
template <int CTRL> __device__ __forceinline__ float dpp_add(float v) { return v + __int_as_float(__builtin_amdgcn_update_dpp(0, __float_as_int(v), CTRL, 0xF, 0xF, true)); }
__device__ __forceinline__ float wave_sum(float v) {
    v = dpp_add<0xB1>(v); v = dpp_add<0x4E>(v); v = dpp_add<0x141>(v); v = dpp_add<0x140>(v);
    const int iv = __float_as_int(v);
    return (__int_as_float(__builtin_amdgcn_readlane(iv, 0)) + __int_as_float(__builtin_amdgcn_readlane(iv, 16))) + (__int_as_float(__builtin_amdgcn_readlane(iv, 32)) + __int_as_float(__builtin_amdgcn_readlane(iv, 48)));
}

#define XB_TMO      128
#define XB_XCNT(j)  (256  + 64 * (j))
#define XB_XSUB(j)  (1280 + 64 * (j))
#define XB_XGEN(j)  (2304 + 64 * (j))
#define XB_TOP      3328
#define XB_TOPGEN   3392
#define XB_WORDS    3456
#define XB_SPIN_CAP (1u << 22)
__device__ __forceinline__ unsigned xb_ld(unsigned* p)              { return __hip_atomic_load(p, __ATOMIC_RELAXED, __HIP_MEMORY_SCOPE_AGENT); }
__device__ __forceinline__ unsigned xb_add(unsigned* p, unsigned v) { return __hip_atomic_fetch_add(p, v, __ATOMIC_RELAXED, __HIP_MEMORY_SCOPE_AGENT); }
__device__ __forceinline__ unsigned xb_xcc_id() { return (unsigned)__builtin_amdgcn_s_getreg((3 << 11) | 20) & 0xFu; }
#define XB_SPIN(cond, bar) do { unsigned _sp = 0; while (cond) { __builtin_amdgcn_s_sleep(1); \
    if ((++_sp & 255u) == 0u) { if (xb_ld(&(bar)[XB_TMO])) break; if (_sp > XB_SPIN_CAP) { atomicAdd(&(bar)[XB_TMO], 1u); break; } } } } while (0)
__device__ __forceinline__ void xcd_barrier_complete(unsigned* bar, unsigned x, unsigned& nloc, unsigned& nx) {
    const unsigned G = gridDim.x; unsigned sum, cnt, mine, sp = 0u;
    for (;;) { sum = 0u; cnt = 0u; mine = 0u;
#pragma unroll
        for (unsigned j = 0; j < 16; ++j) { const unsigned c = xb_ld(&bar[XB_XCNT(j)]); sum += c; cnt += (c > 0u) ? 1u : 0u; mine = (j == x) ? c : mine; }
        if (sum == G) break;
        __builtin_amdgcn_s_sleep(1);
        if ((++sp & 255u) == 0u) { if (xb_ld(&bar[XB_TMO])) break; if (sp > XB_SPIN_CAP) { atomicAdd(&bar[XB_TMO], 1u); break; } } }
    nloc = mine > 0u ? mine : 1u; nx = cnt > 0u ? cnt : 1u;
}
__device__ __forceinline__ void grid_barrier(unsigned* bar, volatile LAS unsigned* st) {
    asm volatile("s_waitcnt vmcnt(0) lgkmcnt(0)" ::: "memory");
    __syncthreads();
    if (threadIdx.x == 0) {
        const unsigned x = xb_xcc_id();
        unsigned nloc = st[0], nx = st[1];
        if (nloc == 0u) { xcd_barrier_complete(bar, x, nloc, nx); st[0] = nloc; st[1] = nx; }
        const unsigned old = xb_add(&bar[XB_XSUB(x)], 1u);
        const unsigned gen = old / nloc;
        if (old + 1u == (gen + 1u) * nloc) {
            __builtin_amdgcn_fence(__ATOMIC_RELEASE, "agent");
            asm volatile("s_waitcnt vmcnt(0)" ::: "memory");
            const unsigned og = xb_add(&bar[XB_TOP], 1u);
            const unsigned tg = og / nx;
            if (og + 1u == (tg + 1u) * nx) xb_add(&bar[XB_TOPGEN], 1u);
            else XB_SPIN(xb_ld(&bar[XB_TOPGEN]) == tg, bar);
            __builtin_amdgcn_fence(__ATOMIC_ACQUIRE, "agent");
            xb_add(&bar[XB_XGEN(x)], 1u);
            asm volatile("s_waitcnt vmcnt(0)" ::: "memory");
        } else {
            XB_SPIN(xb_ld(&bar[XB_XGEN(x)]) == gen, bar);
            __builtin_amdgcn_fence(__ATOMIC_ACQUIRE, "agent");
            asm volatile("s_waitcnt vmcnt(0)" ::: "memory");
        }
    }
    __syncthreads();
}

namespace pg8 {
constexpr int BM = 256, BK = 64, HALF = 128, HTB = HALF * BK * 2, NXCD = 8, WGM = 8;
__host__ __device__ __forceinline__ int lds_byte(int r, int c) { const int st = (r >> 4) * 2 + (c >> 5), rr = r & 15, cc = c & 31, ob = rr * 64 + cc * 2; return st * 1024 + (ob ^ (((ob >> 9) & 1) << 5)); }
__host__ __device__ __forceinline__ void stage_rc(int b, int& R, int& C) { const int st = b / 1024, sb = b % 1024, swz = sb ^ (((sb >> 9) & 1) << 5); R = (st >> 1) * 16 + swz / 64; C = (st & 1) * 32 + (swz % 64) / 2; }
__host__ __device__ __forceinline__ int perm32(int rho) { const int n = rho >> 4, i = rho & 15; return 8 * (i >> 2) + 4 * n + (i & 3); }
struct Unit { int pm, pn, kind; };

__device__ __forceinline__ void map_unit(int L, int nM, int nN, Unit& u) {
    const int nwg = nM * nN; int wgid = L;
    { const int q = nwg / NXCD, r = nwg % NXCD, xcd = wgid % NXCD, off = wgid / NXCD; wgid = (xcd < r ? xcd * (q + 1) : r * (q + 1) + (xcd - r) * q) + off; }
    const int nig = WGM * nN, gid = wgid / nig, fm = gid * WGM, gsz = (nM - fm) < WGM ? (nM - fm) : WGM;
    u.pm = fm + ((wgid % nig) % gsz); u.pn = (wgid % nig) / gsz;
}
struct Sched1 {
    int nM, nN, G, c; const char* A; const char* Bt; size_t tstep;
    __device__ __forceinline__ bool next(int i, Unit& u) const { const long L = (long)i * G + c; if (L >= (long)nM * nN) return false; map_unit((int)L, nM, nN, u); u.kind = 0; return true; }
    __device__ __forceinline__ const char* aptr(const Unit& u) const { return A + (size_t)u.pm * tstep; }
    __device__ __forceinline__ const char* bptr(const Unit& u) const { return Bt + (size_t)u.pn * tstep; }
};
struct Sched2 {
    int nM, nN, G, c; const char* A0; const char* A1; const char* B0; const char* B1; size_t tstep;
    __device__ __forceinline__ bool next(int i, Unit& u) const { const long L = (long)(i >> 1) * G + c; if (L >= (long)nM * nN) return false; map_unit((int)L, nM, nN, u); u.kind = i & 1; return true; }
    __device__ __forceinline__ const char* aptr(const Unit& u) const { return (u.kind ? A1 : A0) + (size_t)u.pm * tstep; }
    __device__ __forceinline__ const char* bptr(const Unit& u) const { return (u.kind ? B1 : B0) + (size_t)u.pn * tstep; }
};

template <class Epi, class Sched>
__device__ __forceinline__ void gemm_phase(LAS unsigned char* lds, const int K, const Sched& S, const Epi& E) {
    const int tid = tid_opaque(), wid = __builtin_amdgcn_readfirstlane(tid >> 6), lane = tid & 63, wr = wid >> 2, wc = wid & 3, fr = lane & 15, fq = lane >> 4;
    const int nt = K / BK;
    unsigned voffA[2], voffB[2];
#pragma unroll
    for (int i = 0; i < 2; ++i) { int R, C; stage_rc(tid * 16 + i * 8192, R, C); const int Rb = Epi::PERM ? ((R & ~31) + perm32(R & 31)) : R;
        voffA[i] = (unsigned)(R * K + C) * 2u; voffB[i] = (unsigned)(Rb * K + C) * 2u; }
    const size_t kstep = (size_t)(BK * 2);
    const size_t hstep = (size_t)HALF * K * 2;
    const unsigned ldsw = (unsigned)wid * 1024u;
    const int aoff = lds_byte(wr * 64 + fr, fq * 8), boff = lds_byte(wc * 32 + fr, fq * 8);
#define PG8_SA(b, h) (((b) * 2 + (h)) * HTB)
#define PG8_SB(b, h) ((4 + (b) * 2 + (h)) * HTB)
#define PG8_STAGE(bufoff, gbase, voff) do { _Pragma("unroll") for (int _i = 0; _i < 2; ++_i) \
        __builtin_amdgcn_global_load_lds((const unsigned*)((const char*)(gbase) + (voff)[_i]), (LAS unsigned*)(lds + (bufoff) + ldsw + _i * 8192), 16, 0, 0); } while (0)
#define PG8_LDA(dst, b, h) do { _Pragma("unroll") for (int m = 0; m < 4; ++m) _Pragma("unroll") for (int k = 0; k < 2; ++k) dst[m][k] = *(const LAS bf16x8*)(lds + PG8_SA(b, h) + aoff + m * 2048 + k * 1024); } while (0)
#define PG8_LDB(dst, b, h) do { _Pragma("unroll") for (int n = 0; n < 2; ++n) _Pragma("unroll") for (int k = 0; k < 2; ++k) dst[n][k] = *(const LAS bf16x8*)(lds + PG8_SB(b, h) + boff + n * 2048 + k * 1024); } while (0)
#define PG8_MMA(ai, bj, At, Bt) do { __builtin_amdgcn_s_setprio(1); _Pragma("unroll") for (int m = 0; m < 4; ++m) _Pragma("unroll") for (int n = 0; n < 2; ++n) _Pragma("unroll") for (int k = 0; k < 2; ++k) \
        acc[ai][bj][m][n] = __builtin_amdgcn_mfma_f32_16x16x32_bf16(Bt[n][k], At[m][k], acc[ai][bj][m][n], 0, 0, 0); __builtin_amdgcn_s_setprio(0); } while (0)
#define PG8_WAIT_V(n) asm volatile("s_waitcnt vmcnt(" #n ")" ::: "memory")
#define PG8_WAIT_L(n) asm volatile("s_waitcnt lgkmcnt(" #n ")" ::: "memory")
#define PG8_BAR __builtin_amdgcn_s_barrier()
#define PG8_SCHED __builtin_amdgcn_sched_barrier(0)
    Unit cur, nxt; int ui = 0;
    if (!S.next(0, cur)) return;
    f32x4 acc[2][2][4][2];
#pragma unroll
    for (int a = 0; a < 2; ++a)
#pragma unroll
        for (int b = 0; b < 2; ++b)
#pragma unroll
            for (int m = 0; m < 4; ++m)
#pragma unroll
                for (int n = 0; n < 2; ++n) acc[a][b][m][n] = (f32x4){0.f, 0.f, 0.f, 0.f};
    bf16x8 At[4][2], B0[2][2], B1[2][2];
    const char* cA = S.aptr(cur); const char* cB = S.bptr(cur);
    PG8_STAGE(PG8_SB(0, 0), cB, voffB); PG8_STAGE(PG8_SA(0, 0), cA, voffA); PG8_STAGE(PG8_SB(0, 1), cB + hstep, voffB); PG8_STAGE(PG8_SA(0, 1), cA + hstep, voffA);
    if (wr == 1) PG8_BAR;
    PG8_WAIT_V(4); PG8_BAR;
    PG8_STAGE(PG8_SB(1, 0), cB + kstep, voffB); PG8_STAGE(PG8_SA(1, 0), cA + kstep, voffA); PG8_STAGE(PG8_SB(1, 1), cB + hstep + kstep, voffB);
    PG8_WAIT_V(6); PG8_BAR;
    for (;;) {
        const bool has_next = S.next(ui + 1, nxt);
        const char* nA = has_next ? S.aptr(nxt) : cA; const char* nB = has_next ? S.bptr(nxt) : cB;
        for (int t = 0; t < nt; t += 2) {
            const bool last = (t == nt - 2);
            const char* a1 = cA + (size_t)(t + 1) * kstep;
            const char* a2 = last ? nA : cA + (size_t)(t + 2) * kstep; const char* b2 = last ? nB : cB + (size_t)(t + 2) * kstep;
            const char* a3 = a2 + kstep; const char* b3 = b2 + kstep;
            PG8_LDB(B0, 0, 0); PG8_SCHED; PG8_LDA(At, 0, 0); PG8_STAGE(PG8_SA(1, 1), a1 + hstep, voffA);
            PG8_WAIT_L(8); PG8_BAR; PG8_WAIT_L(0); PG8_MMA(0, 0, At, B0); PG8_BAR; PG8_SCHED;
            PG8_LDB(B1, 0, 1); PG8_STAGE(PG8_SB(0, 0), b2, voffB);
            PG8_BAR; PG8_WAIT_L(0); PG8_MMA(0, 1, At, B1); PG8_BAR;
            PG8_LDA(At, 0, 1); PG8_STAGE(PG8_SA(0, 0), a2, voffA);
            PG8_BAR; PG8_WAIT_L(0); PG8_MMA(1, 0, At, B0); PG8_BAR; PG8_SCHED;
            PG8_STAGE(PG8_SB(0, 1), b2 + hstep, voffB);
            PG8_WAIT_V(6); PG8_BAR; PG8_MMA(1, 1, At, B1); PG8_BAR;
            PG8_LDB(B0, 1, 0); PG8_SCHED; PG8_LDA(At, 1, 0); PG8_STAGE(PG8_SA(0, 1), a2 + hstep, voffA);
            PG8_WAIT_L(8); PG8_BAR; PG8_WAIT_L(0); PG8_MMA(0, 0, At, B0); PG8_BAR; PG8_SCHED;
            PG8_LDB(B1, 1, 1); PG8_STAGE(PG8_SB(1, 0), b3, voffB);
            PG8_BAR; PG8_WAIT_L(0); PG8_MMA(0, 1, At, B1); PG8_BAR;
            PG8_LDA(At, 1, 1); PG8_STAGE(PG8_SA(1, 0), a3, voffA);
            PG8_BAR; PG8_WAIT_L(0); PG8_MMA(1, 0, At, B0); PG8_BAR; PG8_SCHED;
            PG8_STAGE(PG8_SB(1, 1), b3 + hstep, voffB);
            PG8_WAIT_V(6); PG8_BAR; PG8_MMA(1, 1, At, B1); PG8_BAR;
        }
        E(acc, cur, wr, wc, fr, fq);
        if (!has_next) break;
        if (!E.keep(cur)) {
#pragma unroll
        for (int a = 0; a < 2; ++a)
#pragma unroll
            for (int b = 0; b < 2; ++b)
#pragma unroll
                for (int m = 0; m < 4; ++m)
#pragma unroll
                    for (int n = 0; n < 2; ++n) acc[a][b][m][n] = (f32x4){0.f, 0.f, 0.f, 0.f};
        }
        cur = nxt; cA = nA; cB = nB; ++ui;
    }
    PG8_WAIT_V(0);
    if (wr == 0) PG8_BAR;
    PG8_BAR;
#undef PG8_SA
#undef PG8_SB
#undef PG8_STAGE
#undef PG8_LDA
#undef PG8_LDB
#undef PG8_MMA
#undef PG8_WAIT_V
#undef PG8_WAIT_L
#undef PG8_BAR
#undef PG8_SCHED
}
}
using pg8::Unit;

template <int ACT> __device__ __forceinline__ float actf(float v) { return ACT == 1 ? v * sigm(v) : (ACT == 2 ? sigm(v) : v); }
template <int ACT> __device__ __forceinline__ void store_tile_bf16(const f32x4 (&acc)[2][2][4][2], bf16_t* base  , int ld) {
#pragma unroll
    for (int ai = 0; ai < 2; ++ai)
#pragma unroll
        for (int m = 0; m < 4; ++m) { bf16_t* rowp = base + (size_t)(ai * 128 + m * 16) * ld;
#pragma unroll
            for (int bj = 0; bj < 2; ++bj) { const f32x4 v0 = acc[ai][bj][m][0], v1 = acc[ai][bj][m][1]; u32x4 w;
                w.x = cvt_pk_bf16(actf<ACT>(v0[0]), actf<ACT>(v0[1])); w.y = cvt_pk_bf16(actf<ACT>(v0[2]), actf<ACT>(v0[3]));
                w.z = cvt_pk_bf16(actf<ACT>(v1[0]), actf<ACT>(v1[1])); w.w = cvt_pk_bf16(actf<ACT>(v1[2]), actf<ACT>(v1[3]));
                *(u32x4*)(rowp + bj * 128) = w; } }
}
struct EpiG1 {
    static constexpr bool PERM = true;
    __device__ __forceinline__ bool keep(const Unit&) const { return false; }
    unsigned char *ws, *outb;
    __device__ __forceinline__ void operator()(const f32x4 (&acc)[2][2][4][2], const Unit& u, int wr, int wc, int fr, int fq) const {
        unsigned char* w = uniform_ptr(ws); unsigned char* ob = uniform_ptr(outb); asm volatile("" : "+s"(w), "+s"(ob));
        const int row0 = u.pm * 256 + wr * 64 + fr, pn = u.pn, cw = wc * 32 + 8 * fq;
        if (pn < 8) {
            bf16_t* base = (bf16_t*)(w + OFF_U) + (size_t)row0 * 1024 + pn * 128 + cw;
#pragma unroll
            for (int ai = 0; ai < 2; ++ai)
#pragma unroll
                for (int m = 0; m < 4; ++m) { const f32x4 a0 = acc[ai][0][m][0], a1 = acc[ai][0][m][1], g0 = acc[ai][1][m][0], g1 = acc[ai][1][m][1]; u32x4 wv;
                    wv.x = cvt_pk_bf16(a0[0] * sigm(g0[0]), a0[1] * sigm(g0[1])); wv.y = cvt_pk_bf16(a0[2] * sigm(g0[2]), a0[3] * sigm(g0[3]));
                    wv.z = cvt_pk_bf16(a1[0] * sigm(g1[0]), a1[1] * sigm(g1[1])); wv.w = cvt_pk_bf16(a1[2] * sigm(g1[2]), a1[3] * sigm(g1[3]));
                    *(u32x4*)(base + (size_t)(ai * 128 + m * 16) * 1024) = wv; }
        } else if (pn < 12) store_tile_bf16<1>(acc, (bf16_t*)(w + OFF_OGC) + (size_t)row0 * 1024 + (pn - 8) * 256 + cw, 1024);
        else if (pn < 25) store_tile_bf16<0>(acc, (bf16_t*)(w + OFF_RKVL) + (size_t)row0 * LDR + (pn - 12) * 256 + cw, LDR);
        else if (pn < 29) store_tile_bf16<1>(acc, (bf16_t*)(w + OFF_OGR) + (size_t)row0 * 1024 + (pn - 25) * 256 + cw, 1024);
        else if (pn < 33) store_tile_bf16<2>(acc, (bf16_t*)(w + OFF_GC) + (size_t)row0 * 1024 + (pn - 29) * 256 + cw, 1024);
        else store_tile_bf16<2>(acc, (bf16_t*)(ob + 64 * MiB) + (size_t)row0 * 1024 + (pn - 33) * 256 + cw, 1024);
    }
};
struct EpiLora {
    static constexpr bool PERM = true;
    __device__ __forceinline__ bool keep(const Unit&) const { return false; }
    bf16_t *DW, *AP;
    __device__ __forceinline__ void operator()(const f32x4 (&acc)[2][2][4][2], const Unit& u, int wr, int wc, int fr, int fq) const {
        const int row0 = u.pm * 256 + wr * 64 + fr, cw = wc * 32 + 8 * fq;
        bf16_t* base = (u.pn < 4 ? DW + (size_t)u.pn * 256 : AP + (size_t)(u.pn - 4) * 256) + (size_t)row0 * 1024 + cw;
        store_tile_bf16<0>(acc, base, 1024);
    }
};
struct EpiG2 {
    static constexpr bool PERM = true;
    const bf16_t *GC, *GR; bf16_t* M;
    __device__ __forceinline__ bool keep(const Unit& u) const { return u.kind == 0; }
    __device__ __forceinline__ void operator()(f32x4 (&acc)[2][2][4][2], const Unit& u, int wr, int wc, int fr, int fq) const {
        const size_t off0 = (size_t)(u.pm * 256 + wr * 64 + fr) * 1024 + u.pn * 256 + wc * 32 + 8 * fq;
#pragma unroll
        for (int ai = 0; ai < 2; ++ai)
#pragma unroll
            for (int m = 0; m < 4; ++m)
#pragma unroll
                for (int bj = 0; bj < 2; ++bj) { const size_t off = off0 + (size_t)(ai * 128 + m * 16) * 1024 + bj * 128;
                    const u32x4 gr = *(const u32x4*)(GR + off); f32x4& v0 = acc[ai][bj][m][0]; f32x4& v1 = acc[ai][bj][m][1];
                    const f32x4 r0 = {bflo(gr.x), bfhi(gr.x), bflo(gr.y), bfhi(gr.y)}, r1 = {bflo(gr.z), bfhi(gr.z), bflo(gr.w), bfhi(gr.w)};
                    if (u.kind == 0) { const u32x4 gc = *(const u32x4*)(GC + off);
                        const f32x4 c0 = {bflo(gc.x), bfhi(gc.x), bflo(gc.y), bfhi(gc.y)}, c1 = {bflo(gc.z), bfhi(gc.z), bflo(gc.w), bfhi(gc.w)};
#pragma unroll
                        for (int j = 0; j < 4; ++j) { v0[j] *= c0[j] * __builtin_amdgcn_rcpf(fmaxf(r0[j], 1e-30f)); v1[j] *= c1[j] * __builtin_amdgcn_rcpf(fmaxf(r1[j], 1e-30f)); }
                    } else { const f32x4 m0 = v0 * r0, m1 = v1 * r1; u32x4 w;
                        w.x = cvt_pk_bf16(m0[0], m0[1]); w.y = cvt_pk_bf16(m0[2], m0[3]); w.z = cvt_pk_bf16(m1[0], m1[1]); w.w = cvt_pk_bf16(m1[2], m1[3]);
                        *(u32x4*)(M + off) = w; } }
    }
};
struct EpiG3 {
    static constexpr bool PERM = false;
    const float *x, *mod, *fg; float* out; float* rowss; unsigned* pcnt;
    __device__ __forceinline__ bool keep(const Unit&) const { return false; }
    __device__ __forceinline__ void operator()(f32x4 (&acc)[2][2][4][2], const Unit& u, int wr, int wc, int fr, int fq) const {
        const int col0 = u.pn * 256 + wc * 32 + 4 * fq, row0 = u.pm * 256 + wr * 64 + fr; const size_t off0 = (size_t)row0 * 1024 + col0;
        const float* gp = mod + (size_t)(u.pm >> 3) * 3072 + 2048 + col0;
        { f32x4 gv[2][2];
#pragma unroll
        for (int bj = 0; bj < 2; ++bj)
#pragma unroll
            for (int n = 0; n < 2; ++n) gv[bj][n] = *(const f32x4*)(gp + bj * 128 + n * 16);
#pragma unroll
        for (int ai = 0; ai < 2; ++ai)
#pragma unroll
            for (int m = 0; m < 4; ++m) { float ps = 0.f;
#pragma unroll
                for (int bj = 0; bj < 2; ++bj)
#pragma unroll
                    for (int n = 0; n < 2; ++n) { const size_t off = off0 + (size_t)(ai * 128 + m * 16) * 1024 + bj * 128 + n * 16;
                        const f32x4 v = *(const f32x4*)(x + off) + gv[bj][n] * acc[ai][bj][m][n]; acc[ai][bj][m][n] = v; ps += v[0] * v[0] + v[1] * v[1] + v[2] * v[2] + v[3] * v[3]; }
                ps += __shfl_xor(ps, 16); ps += __shfl_xor(ps, 32);
                if (fq == 0) __hip_atomic_fetch_add(rowss + row0 + ai * 128 + m * 16, ps, __ATOMIC_RELAXED, __HIP_MEMORY_SCOPE_AGENT); } }
        asm volatile("s_waitcnt vmcnt(0)" ::: "memory");
        unsigned* pc = pcnt + u.pm * 2 + wr;
        if (fr == 0 && fq == 0) __hip_atomic_fetch_add(pc, 1u, __ATOMIC_RELAXED, __HIP_MEMORY_SCOPE_AGENT);
        { unsigned sp = 0; while (__hip_atomic_load(pc, __ATOMIC_RELAXED, __HIP_MEMORY_SCOPE_AGENT) < 16u && ++sp < (1u << 22)) __builtin_amdgcn_s_sleep(1); }
#pragma unroll
        for (int ai = 0; ai < 2; ++ai)
#pragma unroll
            for (int m = 0; m < 4; ++m) { const float ss = __hip_atomic_load(rowss + row0 + ai * 128 + m * 16, __ATOMIC_RELAXED, __HIP_MEMORY_SCOPE_AGENT);
                const float rstd = __builtin_amdgcn_rsqf(ss * (1.f / 1024.f) + 1e-6f);
#pragma unroll
                for (int bj = 0; bj < 2; ++bj)
#pragma unroll
                    for (int n = 0; n < 2; ++n) { const size_t off = off0 + (size_t)(ai * 128 + m * 16) * 1024 + bj * 128 + n * 16;
                        *(f32x4*)(out + off) = acc[ai][bj][m][n] * rstd * *(const f32x4*)(fg + col0 + bj * 128 + n * 16); } }
    }
};

__device__ void phase_mod(const Params& p, unsigned char* smem) {
    if (blockIdx.x >= 48) return;
    float* sc = (float*)smem;
    float* red = sc + 16384;
    const int tid = tid_opaque(), w = tid >> 6, lane = tid & 63;
    for (int i = tid; i < 16384; i += 512) { const int b = i >> 10, d = i & 1023; const float cv = p.c[i]; sc[d * 16 + b] = cv * sigm(cv); }
    __syncthreads();
    const int e = blockIdx.x * 64 + lane;
    float acc[16];
#pragma unroll
    for (int b = 0; b < 16; ++b) acc[b] = 0.f;
    for (int d0 = w * 128; d0 < w * 128 + 128; d0 += 16) {
        float wvs[16];
#pragma unroll
        for (int u = 0; u < 16; ++u) wvs[u] = p.ada_w[(size_t)(d0 + u) * 3072 + e];
#pragma unroll
        for (int u = 0; u < 16; ++u) { const int d = d0 + u; const float wv = wvs[u];
        const f32x4* s4 = (const f32x4*)(sc + d * 16);
#pragma unroll
        for (int q = 0; q < 4; ++q) { const f32x4 s = s4[q]; acc[4 * q] += s[0] * wv; acc[4 * q + 1] += s[1] * wv; acc[4 * q + 2] += s[2] * wv; acc[4 * q + 3] += s[3] * wv; }
        }
    }
#pragma unroll
    for (int b = 0; b < 16; ++b) red[(w * 16 + b) * 64 + lane] = acc[b];
    __syncthreads();
    float* mod = (float*)(p.ws + OFF_MOD);
    for (int i = tid; i < 1024; i += 512) { const int b = i >> 6, l = i & 63; float s = 0.f;
#pragma unroll
        for (int ww = 0; ww < 8; ++ww) s += red[(ww * 16 + b) * 64 + l];
        mod[b * 3072 + blockIdx.x * 64 + l] = s + p.ada_b[blockIdx.x * 64 + l]; }
    __syncthreads();
}
__device__ __forceinline__ void transpose_tile(const float* src, int ld, int n_src0, int k0, bf16_t* dst, int n_dst0, float* tile) {
    const int tid = tid_opaque();
#pragma unroll
    for (int r = 0; r < 2; ++r) { const int i = (tid >> 4) + 32 * r, j4 = (tid & 15) * 4;
        f32x4 v = {0.f, 0.f, 0.f, 0.f}; if (n_src0 >= 0) v = *(const f32x4*)(src + (size_t)(k0 + i) * ld + n_src0 + j4);
        tile[i * 65 + j4] = v[0]; tile[i * 65 + j4 + 1] = v[1]; tile[i * 65 + j4 + 2] = v[2]; tile[i * 65 + j4 + 3] = v[3]; }
    __syncthreads();
    const int j = tid >> 3, i8 = (tid & 7) * 8; u32x4 w;
    w.x = cvt_pk_bf16(tile[(i8 + 0) * 65 + j], tile[(i8 + 1) * 65 + j]); w.y = cvt_pk_bf16(tile[(i8 + 2) * 65 + j], tile[(i8 + 3) * 65 + j]);
    w.z = cvt_pk_bf16(tile[(i8 + 4) * 65 + j], tile[(i8 + 5) * 65 + j]); w.w = cvt_pk_bf16(tile[(i8 + 6) * 65 + j], tile[(i8 + 7) * 65 + j]);
    *(u32x4*)(dst + (size_t)(n_dst0 + j) * 1024 + k0 + i8) = w;
    __syncthreads();
}
__device__ void phase_weights(const Params& p, unsigned char* smem) {
    float* tile = (float*)smem;
    for (int i = blockIdx.x * 512 + threadIdx.x; i < T + 256; i += gridDim.x * 512) ((unsigned*)(p.ws + OFF_ROWSS))[i] = 0u;
    bf16_t* WinT = (bf16_t*)(p.ws + OFF_WINT); bf16_t* W2T = (bf16_t*)(p.ws + OFF_W2T); bf16_t* WoT = (bf16_t*)(p.ws + OFF_WOT); bf16_t* LBt = (bf16_t*)(p.ws + OFF_LBT);
    constexpr int NT1 = (N1 / 64) * 16;
    const bool bal = (gridDim.x == 256); const int nb = blockIdx.x;
    const int first = bal ? (nb >= 48 ? nb - 48 : 2704 + nb) : nb, stride = bal ? (nb >= 48 ? 208 : 48) : (int)gridDim.x, last = bal ? (nb >= 48 ? 2704 : 3136) : NT1 + 768;
    for (int idx = first; idx < last; idx += stride) {
        if (idx < NT1) { const int a = idx >> 4, kt = idx & 15, n0 = a * 64; int src;
            if (n0 < 2048) { const int j = n0 >> 8, wi = n0 & 255; src = wi < 128 ? 128 * j + wi : 1024 + 128 * j + wi - 128; }
            else if (n0 < 6272) src = n0; else if (n0 < 6400) src = -1; else src = n0 - 128;
            transpose_tile(p.w_in, 9344, src, kt * 64, WinT, n0, tile);
        } else { const int r = idx - NT1, which = r >> 8, a = (r >> 4) & 15, kt = r & 15;
            const float* src = which == 0 ? p.w_conv_out : (which == 1 ? p.w_rwkv_out : p.w_out);
            bf16_t* dst = which == 0 ? W2T : (which == 1 ? W2T + (size_t)1024 * 1024 : WoT);
            transpose_tile(src, 1024, a * 64, kt * 64, dst, a * 64, tile); }
    }
    for (int idx = blockIdx.x * 512 + tid_opaque(); idx < 2048 * 128; idx += gridDim.x * 512) { const int n = idx >> 7, k = idx & 127; float v = 0.f;
        if (n < 1024) { if (k < 64) v = p.rwkv_w2[k * 1024 + n]; } else { if (k >= 64) v = p.rwkv_a2[(k - 64) * 1024 + n - 1024]; }
        LBt[idx] = f2bf(v); }
}
__device__ void phase_h(const Params& p) {
    const int tid = tid_opaque(), w = tid >> 6, lane = tid & 63;
    const float* mod = (const float*)(p.ws + OFF_MOD); bf16_t* Hh = (bf16_t*)p.out;
    for (int tok = blockIdx.x * 8 + w; tok < T; tok += gridDim.x * 8) {
        const int b = tok >> 11; const float* xr = p.x + (size_t)tok * 1024; f32x4 v[4]; float ss = 0.f;
#pragma unroll
        for (int q = 0; q < 4; ++q) { v[q] = *(const f32x4*)(xr + q * 256 + lane * 4); ss += v[q][0] * v[q][0] + v[q][1] * v[q][1] + v[q][2] * v[q][2] + v[q][3] * v[q][3]; }
        ss = wave_sum(ss); const float rstd = rsqrtf(ss * (1.f / 1024.f) + 1e-6f);
#pragma unroll
        for (int q = 0; q < 4; ++q) { const int col = q * 256 + lane * 4; const f32x4 g = *(const f32x4*)(p.norm_g + col), sh = *(const f32x4*)(mod + b * 3072 + col), sc = *(const f32x4*)(mod + b * 3072 + 1024 + col);
            const f32x4 y = v[q] * rstd * g * (sc + 1.f) + sh; u32x2 o; o.x = cvt_pk_bf16(y[0], y[1]); o.y = cvt_pk_bf16(y[2], y[3]);
            *(u32x2*)(Hh + (size_t)tok * 1024 + col) = o; }
    }
}
__device__ void phase_conv(const Params& p, unsigned char* smem) {
    const int tid = tid_opaque(), w = tid >> 6, lane = tid & 63, c0 = tid * 2;
    const bf16_t* U = (const bf16_t*)(p.ws + OFF_U); bf16_t* OGC = (bf16_t*)(p.ws + OFF_OGC);
    float* part = (float*)smem;
    float* stat = part + 32 * 512;
    f32x2 wk[31];
#pragma unroll
    for (int j = 0; j < 31; ++j) wk[j] = *(const f32x2*)(p.conv_k + j * 1024 + c0);
    const f32x2 cb = *(const f32x2*)(p.conv_b + c0), lg = *(const f32x2*)(p.conv_ln_g + c0), lb = *(const f32x2*)(p.conv_ln_b + c0);
    for (int tile = blockIdx.x; tile < T / 16; tile += gridDim.x) {
        const int b = tile >> 7, t0 = (tile & 127) * 16; const size_t row0 = (size_t)b * SEQ + t0;
        f32x2 u[46];
#pragma unroll
        for (int i = 0; i < 46; ++i) { const int t = t0 - 30 + i; unsigned v = 0u; if (t >= 0) v = *(const unsigned*)(U + ((size_t)b * SEQ + t) * 1024 + c0); u[i] = (f32x2){bflo(v), bfhi(v)}; }
        f32x2 o[16];
#pragma unroll
        for (int i = 0; i < 16; ++i) { f32x2 a = cb;
#pragma unroll
            for (int j = 0; j < 31; ++j) a = wk[j] * u[i + j] + a;
            o[i] = a; }
#pragma unroll
        for (int i = 0; i < 16; ++i) { part[i * 512 + tid] = o[i].x + o[i].y; part[(16 + i) * 512 + tid] = o[i].x * o[i].x + o[i].y * o[i].y; }
        __syncthreads();
#pragma unroll
        for (int q = 0; q < 4; ++q) { const int v = 4 * w + q; float s = 0.f;
#pragma unroll
            for (int r = 0; r < 8; ++r) s += part[v * 512 + lane + 64 * r];
            s = wave_sum(s); if (lane == 0) stat[v] = s; }
        __syncthreads();
#pragma unroll
        for (int i = 0; i < 16; ++i) { const float mean = stat[i] * (1.f / 1024.f), var = stat[16 + i] * (1.f / 1024.f) - mean * mean, rstd = __builtin_amdgcn_rsqf(var + 1e-5f);
            float y0 = (o[i].x - mean) * rstd * lg.x + lb.x, y1 = (o[i].y - mean) * rstd * lg.y + lb.y; y0 *= sigm(y0); y1 *= sigm(y1);
            bf16_t* gp = OGC + (row0 + i) * 1024 + c0; const unsigned og = *(const unsigned*)gp;
            *(unsigned*)gp = cvt_pk_bf16(y0 * bflo(og), y1 * bfhi(og)); }
    }
    const bf16_t* RK = (const bf16_t*)(p.ws + OFF_RKVL); bf16_t* AL = (bf16_t*)(p.ws + OFF_ALORA);
    for (int idx = blockIdx.x * 512 + tid; idx < T * 128; idx += gridDim.x * 512) { const int t = idx >> 7, j = idx & 127;
        const float z = bf2f(RK[(size_t)t * LDR + 3072 + j]), pv = (t & (SEQ - 1)) ? bf2f(RK[(size_t)(t - 1) * LDR + 3072 + j]) : 0.f;
        const float s = z + p.rwkv_mu[3072 + j] * (pv - z); const float val = j < 64 ? tanhf(s) : s;
        AL[(size_t)t * 128 + j] = f2bf(val); }
}
constexpr int SCH = 32, SNCH = SEQ / SCH, SREC = 272;
struct ScanRaw { unsigned v[8], wa[8]; };
struct ScanOps { f32x4 a[8], b[4], k[4]; };
struct ScanC { float mu_r, mu_k, mu_v, w0c, a0c, kkc, kac, rkc, gng, gnb; };
__device__ __forceinline__ void scan_load_raw(ScanRaw& R, f32x2 (&S)[8], const bf16_t* RK, const bf16_t* DW, const bf16_t* AP, int b, int c, int pw, int ch) {
#pragma unroll
    for (int i = 0; i < 8; ++i) { const int t = c * SCH + 8 * pw + i; const size_t row = (size_t)b * SEQ + t; const bf16_t* rp = RK + row * LDR + ch;
        const bf16_t* rq = t > 0 ? rp - LDR : rp;
        S[i >> 1][i & 1] = __uint_as_float((unsigned)rp[0] | ((unsigned)rq[0] << 16)); S[4 + (i >> 1)][i & 1] = __uint_as_float((unsigned)rp[1024] | ((unsigned)rq[1024] << 16));
        R.v[i] = (unsigned)rp[2048] | ((unsigned)rq[2048] << 16); R.wa[i] = (unsigned)DW[row * 1024 + ch] | ((unsigned)AP[row * 1024 + ch] << 16); }
}
__device__ __forceinline__ void scan_prep(const ScanRaw& R, const f32x2 (&S)[8], const ScanC& C, int c, int pw, int lane, unsigned seq, float* rec, float* vbuf, f32x4* scl, float* wtot, float* ptot, volatile unsigned* flag) {
    float kkA[8], rA[8], nbA[8], kpA[8], LA[8]; float L = 1.f;
#pragma unroll
    for (int i = 0; i < 8; ++i) { const int tt = 8 * pw + i, t = c * SCH + tt;
        const unsigned Rr = __float_as_uint(S[i >> 1][i & 1]), Rk = __float_as_uint(S[4 + (i >> 1)][i & 1]);
        float r = bflo(Rr), k = bflo(Rk), v = bflo(R.v[i]); const float pm = t > 0 ? 1.f : 0.f;
        const float r1 = pm * bfhi(Rr), k1 = pm * bfhi(Rk), v1 = pm * bfhi(R.v[i]);
        r += C.mu_r * (r1 - r); k += C.mu_k * (k1 - k); v += C.mu_v * (v1 - v);
        const float wpre = C.w0c + bflo(R.wa[i]), apre = C.a0c + bfhi(R.wa[i]);
        const float decay = __expf(-0.60653066f * sigm(wpre)), a = sigm(apre);
        const float kkv = k * C.kkc, n2 = wave_sum(kkv * kkv), kk = kkv * __builtin_amdgcn_rsqf(fmaxf(n2, 1e-24f));
        const float kp = k * (1.f + (a - 1.f) * C.kac), bv = kk * a;
        const float br = wave_sum(bv * r), kr = wave_sum(kp * r), bonus = wave_sum(r * kp * C.rkc);
        L *= decay; kkA[i] = kk; rA[i] = r; nbA[i] = -bv; kpA[i] = kp; LA[i] = L;
        vbuf[tt * 64 + lane] = v;
        if (lane == 0) scl[tt] = (f32x4){-br, kr, bonus, 0.f};
        if (i & 1) __builtin_amdgcn_sched_barrier(0);
    }
    wtot[pw * 64 + lane] = L;
    asm volatile("s_waitcnt lgkmcnt(0)" ::: "memory");
    if (lane == 0) flag[pw] = seq;
    float Pw = 1.f;
    for (int ww = 0; ww < pw; ++ww) { while (flag[ww] != seq) __builtin_amdgcn_s_sleep(1);
        asm volatile("" ::: "memory"); Pw *= wtot[ww * 64 + lane]; }
    if (pw == 3) ptot[lane] = Pw * L;
    float Pprev = Pw;
#pragma unroll
    for (int i = 0; i < 8; ++i) { const int tt = 8 * pw + i; const float Pt = Pw * LA[i], ip = __builtin_amdgcn_rcpf(Pt);
        float* rc = rec + tt * SREC + (lane >> 4) * 68; const int e = lane & 15;
        *(f32x2*)(rc + 2 * e) = (f32x2){Pprev * kkA[i], Pt * rA[i]}; rc[32 + e] = nbA[i] * ip; rc[48 + e] = kpA[i] * ip;
        Pprev = Pt; }
}
__device__ __forceinline__ void scan_post(const bf16_t (&og)[8], bf16_t* dst0, const ScanC& C, int pw, int lane, const float* obuf, const float* vbuf, const f32x4* scl) {
#pragma unroll
    for (int i = 0; i < 8; ++i) { const int tt = pw + 4 * i;
        const float o = obuf[tt * 64 + lane], mean = wave_sum(o) * (1.f / 64.f), d = o - mean, var = wave_sum(d * d) * (1.f / 64.f);
        float y = d * __builtin_amdgcn_rsqf(var + 64e-5f) * C.gng + C.gnb; y += scl[tt].z * vbuf[tt * 64 + lane];
        dst0[(size_t)i * 4096] = f2bf(y * bf2f(og[i])); }
}
__device__ __forceinline__ void scan_load_ops(ScanOps& o, const f32x4* rq) {
#pragma unroll
    for (int j = 0; j < 8; ++j) o.a[j] = rq[j];
#pragma unroll
    for (int j = 0; j < 4; ++j) { o.b[j] = rq[8 + j]; o.k[j] = rq[12 + j]; }
}
__device__ __forceinline__ void scan_step(f32x2 (&S)[8], ScanOps& q, const f32x4* rn, const float v, const bool lead, const f32x2 sc, float* obuf, float* dump, int tt, int srow) {
    f32x2 vv = {v, v}; asm volatile("" : "+v"(vv));
    f32x2 d0 = S[0].x * (f32x2){q.a[0][0], q.a[0][1]}, d1 = S[0].y * (f32x2){q.a[0][2], q.a[0][3]}, d2 = S[1].x * (f32x2){q.a[1][0], q.a[1][1]}, d3 = S[1].y * (f32x2){q.a[1][2], q.a[1][3]};
#pragma unroll
    for (int j = 2; j < 8; j += 2) { d0 += S[j].x * (f32x2){q.a[j][0], q.a[j][1]}; d1 += S[j].y * (f32x2){q.a[j][2], q.a[j][3]};
        d2 += S[j + 1].x * (f32x2){q.a[j + 1][0], q.a[j + 1][1]}; d3 += S[j + 1].y * (f32x2){q.a[j + 1][2], q.a[j + 1][3]}; }
#pragma unroll
    for (int j = 0; j < 8; ++j) q.a[j] = rn[j];
    const f32x2 d = (d0 + d1) + (d2 + d3);
    float sk = d.x, o = d.y;
    sk = dpp_add<0xB1>(sk); o = dpp_add<0xB1>(o); sk = dpp_add<0x4E>(sk); o = dpp_add<0x4E>(o);
#pragma unroll
    for (int j = 0; j < 4; ++j) { S[2 * j] += sk * (f32x2){q.b[j][0], q.b[j][1]}; S[2 * j + 1] += sk * (f32x2){q.b[j][2], q.b[j][3]}; }
#pragma unroll
    for (int j = 0; j < 4; ++j) { S[2 * j] += vv * (f32x2){q.k[j][0], q.k[j][1]}; S[2 * j + 1] += vv * (f32x2){q.k[j][2], q.k[j][3]}; }
#pragma unroll
    for (int j = 0; j < 4; ++j) { q.b[j] = rn[8 + j]; q.k[j] = rn[12 + j]; }
    float* op = lead ? obuf + tt * 64 + srow : dump; *op = o + sk * sc.x + v * sc.y;
}
__device__ void phase_scan(const Params& p, unsigned char* smem) {
    const int tid = tid_opaque(), w = tid >> 6, lane = tid & 63, g = lane & 3, srow = (w & 3) * 16 + (lane >> 2), pw = w & 3;
    const bool cons = w < 4, lead = (g == 0);
    float* recb = (float*)smem;
    float* vbufb = recb + 2 * SCH * SREC;
    float* obufb = vbufb + 3 * SCH * 64;
    f32x4* sclb = (f32x4*)(obufb + 2 * SCH * 64);
    float* wtot = (float*)(sclb + 3 * SCH);
    float* ptotb = wtot + 256;
    volatile unsigned* flag = (volatile unsigned*)(ptotb + 128);
    float* dump = (float*)(ptotb + 128) + 8;
    const bf16_t* RK = (const bf16_t*)(p.ws + OFF_RKVL); const bf16_t* DW = (const bf16_t*)(p.ws + OFF_DW); const bf16_t* AP = (const bf16_t*)p.out;
    bf16_t* OGR = (bf16_t*)(p.ws + OFF_OGR);
    unsigned seq = 0;
    for (int bh = blockIdx.x; bh < 256; bh += gridDim.x) {
        const int b = bh >> 4, h = bh & 15, ch = h * 64 + lane;
        const ScanC C{p.rwkv_mu[ch], p.rwkv_mu[1024 + ch], p.rwkv_mu[2048 + ch], p.rwkv_w0[ch], p.rwkv_a0[ch], p.rwkv_k_k[ch], p.rwkv_k_a[ch], p.rwkv_r_k[ch], p.rwkv_gn_g[ch], p.rwkv_gn_b[ch]};
        f32x2 S[8];
#pragma unroll
        for (int i = 0; i < 8; ++i) S[i] = (f32x2){0.f, 0.f};
        ScanRaw R;
        if (tid < 4) flag[tid] = 0u;
        __syncthreads();
        ++seq;
        if (!cons) { scan_load_raw(R, S, RK, DW, AP, b, 0, pw, ch); scan_prep(R, S, C, 0, pw, lane, seq, recb, vbufb, sclb, wtot, ptotb, flag); scan_load_raw(R, S, RK, DW, AP, b, 1, pw, ch); }
        __syncthreads();
        for (int c = 0; c < SNCH; ++c) {
            const int cb = c & 1, c3 = c % 3, n3 = (c + 1) % 3, p3 = (c + 2) % 3;
            ++seq;
            if (cons) {
                const float* vb = vbufb + c3 * (SCH * 64); const f32x2* sc2 = (const f32x2*)(sclb + c3 * SCH); float* ob = obufb + cb * (SCH * 64);
                const f32x4* rq = (const f32x4*)(recb + cb * (SCH * SREC) + g * 68);
                ScanOps A; scan_load_ops(A, rq);
                float v0 = vb[srow]; f32x2 s0 = sc2[0];
                for (int tt = 0; tt < SCH; ++tt) {
                    const int tn = tt + 1 < SCH ? tt + 1 : SCH - 1;
                    const float nv0 = vb[tn * 64 + srow]; const f32x2 ns0 = sc2[2 * tn];
                    scan_step(S, A, rq + tn * (SREC / 4), v0, lead, s0, ob, dump, tt, srow);
                    v0 = nv0; s0 = ns0;
                }
                { const f32x4* pq = (const f32x4*)(ptotb + cb * 64 + g * 16);
#pragma unroll
                    for (int j = 0; j < 4; ++j) { const f32x4 pp = pq[j]; S[2 * j] *= (f32x2){pp[0], pp[1]}; S[2 * j + 1] *= (f32x2){pp[2], pp[3]}; } }
            } else {
                bf16_t og[8]; bf16_t* dst0 = OGR + ((size_t)b * SEQ + (c > 0 ? c - 1 : 0) * SCH + pw) * 1024 + ch;
#pragma unroll
                for (int i = 0; i < 8; ++i) og[i] = dst0[(size_t)i * 4096];
                if (c + 1 < SNCH) { scan_prep(R, S, C, c + 1, pw, lane, seq, recb + (cb ^ 1) * (SCH * SREC), vbufb + n3 * (SCH * 64), sclb + n3 * SCH, wtot, ptotb + (cb ^ 1) * 64, flag);
                    if (c + 2 < SNCH) scan_load_raw(R, S, RK, DW, AP, b, c + 2, pw, ch); }
                if (c > 0) scan_post(og, dst0, C, pw, lane, obufb + (cb ^ 1) * (SCH * 64), vbufb + p3 * (SCH * 64), sclb + p3 * SCH);
            }
            __syncthreads();
        }
        if (!cons) { const int cl = SNCH - 1; bf16_t og[8]; bf16_t* dst0 = OGR + ((size_t)b * SEQ + cl * SCH + pw) * 1024 + ch;
#pragma unroll
            for (int i = 0; i < 8; ++i) og[i] = dst0[(size_t)i * 4096];
            scan_post(og, dst0, C, pw, lane, obufb + (cl & 1) * (SCH * 64), vbufb + (cl % 3) * (SCH * 64), sclb + (cl % 3) * SCH); }
        __syncthreads();
    }
}
__device__ void phase_final(const Params& p) {
    const int tid = tid_opaque(), w = tid >> 6, lane = tid & 63;
    for (int tok = blockIdx.x * 8 + w; tok < T; tok += gridDim.x * 8) {
        float* xr = p.out + (size_t)tok * 1024; f32x4 v[4]; float ss = 0.f;
#pragma unroll
        for (int q = 0; q < 4; ++q) { v[q] = *(const f32x4*)(xr + q * 256 + lane * 4); ss += v[q][0] * v[q][0] + v[q][1] * v[q][1] + v[q][2] * v[q][2] + v[q][3] * v[q][3]; }
        ss = wave_sum(ss); const float rstd = rsqrtf(ss * (1.f / 1024.f) + 1e-6f);
#pragma unroll
        for (int q = 0; q < 4; ++q) { const int col = q * 256 + lane * 4; *(f32x4*)(xr + col) = v[q] * rstd * *(const f32x4*)(p.final_g + col); }
    }
}

template <int FIRST, int LAST> __global__ __launch_bounds__(512, 2) void mega(Params p) {
    extern __shared__ __attribute__((aligned(16))) unsigned char smem[];
    LAS unsigned char* lds = (LAS unsigned char*)smem;
    cg::grid_group grid = cg::this_grid();
    unsigned* bar = (unsigned*)(uniform_ptr(p.ws) + OFF_BAR);
    volatile LAS unsigned* st = (volatile LAS unsigned*)(lds + LDS_BYTES);
    if (threadIdx.x == 0) { st[0] = 0u; st[1] = 0u; (void)xb_add(&bar[XB_XCNT(xb_xcc_id())], 1u); }
    __syncthreads();
    if (p.ws == nullptr) grid.sync();
    unsigned char* ws = p.ws;
    const int G = gridDim.x, c = blockIdx.x;
    if (FIRST <= 0 && 0 < LAST) { phase_mod(p, smem); phase_weights(p, smem); }
    if (FIRST <= 1 && 1 < LAST) { if (FIRST < 1) grid_barrier(bar, st); phase_h(p); }
    if (FIRST <= 2 && 2 < LAST) { if (FIRST < 2) grid_barrier(bar, st);
        pg8::Sched1 S{T / 256, N1 / 256, G, c, (const char*)p.out, (const char*)(ws + OFF_WINT), (size_t)256 * 1024 * 2};
        EpiG1 E{ws, (unsigned char*)p.out};
        pg8::gemm_phase(lds, 1024, S, E); }
    if (FIRST <= 3 && 3 < LAST) { if (FIRST < 3) grid_barrier(bar, st); phase_conv(p, smem); }
    if (FIRST <= 4 && 4 < LAST) { if (FIRST < 4) grid_barrier(bar, st);
        pg8::Sched1 S{T / 256, 2048 / 256, G, c, (const char*)(ws + OFF_ALORA), (const char*)(ws + OFF_LBT), (size_t)256 * 128 * 2};
        EpiLora E{(bf16_t*)(ws + OFF_DW), (bf16_t*)p.out};
        pg8::gemm_phase(lds, 128, S, E); }
    if (FIRST <= 5 && 5 < LAST) { if (FIRST < 5) grid_barrier(bar, st); phase_scan(p, smem); }
    if (FIRST <= 6 && 6 < LAST) { if (FIRST < 6) grid_barrier(bar, st);
        pg8::Sched2 S{T / 256, 4, G, c, (const char*)(ws + OFF_OGC), (const char*)(ws + OFF_OGR), (const char*)(ws + OFF_W2T), (const char*)(ws + OFF_W2T + 2 * MiB), (size_t)256 * 1024 * 2};
        EpiG2 E{(const bf16_t*)(ws + OFF_GC), (const bf16_t*)((unsigned char*)p.out + 64 * MiB), (bf16_t*)(ws + OFF_M)};
        pg8::gemm_phase(lds, 1024, S, E); }
    if (FIRST <= 7 && 7 < LAST) { if (FIRST < 7) grid_barrier(bar, st);
        pg8::Sched1 S{T / 256, 4, G, c, (const char*)(ws + OFF_M), (const char*)(ws + OFF_WOT), (size_t)256 * 1024 * 2};
        EpiG3 E{p.x, (const float*)(ws + OFF_MOD), p.final_g, p.out, (float*)(ws + OFF_ROWSS), (unsigned*)(ws + OFF_PCNT)};
        pg8::gemm_phase(lds, 1024, S, E); }
}

template <int PH> static void launch_one(const Params& p, hipStream_t stream) {
    hipFuncSetAttribute((const void*)mega<PH, PH + 1>, hipFuncAttributeMaxDynamicSharedMemorySize, LDS_BYTES);
    mega<PH, PH + 1><<<256, 512, LDS_BYTES, stream>>>(p);
}

extern "C" void kernel_launch(void* const* d_in, const int* in_sizes, int n_in, void* d_out, int out_size, void* d_ws, size_t ws_size, hipStream_t stream) {
    Params p{};
    const float** f = (const float**)&p;
    for (int i = 0; i < 24; ++i) f[i] = (const float*)d_in[i];
    p.out = (float*)d_out; p.ws = (unsigned char*)d_ws;
    if (ws_size < WS_END) { fprintf(stderr, "workspace too small: %zu < %zu\n", ws_size, (size_t)WS_END); return; }
#if SINGLE_LAUNCH
    static int grid_blocks = 0;
    if (!grid_blocks) {
        int dev = 0, cus = 0, per_cu = 0;
        hipGetDevice(&dev);
        hipDeviceGetAttribute(&cus, hipDeviceAttributeMultiprocessorCount, dev);
        hipFuncSetAttribute((const void*)mega<0, NPHASE>, hipFuncAttributeMaxDynamicSharedMemorySize, LDS_BYTES + 16);
        hipOccupancyMaxActiveBlocksPerMultiprocessor(&per_cu, mega<0, NPHASE>, 512, LDS_BYTES + 16);
        grid_blocks = cus * (per_cu > 1 ? 1 : per_cu);
        if (grid_blocks > 256) grid_blocks = 256;
    }
    hipMemsetAsync((unsigned char*)d_ws + OFF_BAR, 0, 3456 * 4, stream);
    void* args[] = {(void*)&p};
    hipError_t e = hipLaunchCooperativeKernel((const void*)mega<0, NPHASE>, dim3(grid_blocks), dim3(512), args, LDS_BYTES + 16, stream);
    if (e != hipSuccess) fprintf(stderr, "cooperative launch failed: %s (grid %d)\n", hipGetErrorString(e), grid_blocks);
#else
    launch_one<0>(p, stream); launch_one<1>(p, stream); launch_one<2>(p, stream); launch_one<3>(p, stream); launch_one<4>(p, stream);
    launch_one<5>(p, stream); launch_one<6>(p, stream); launch_one<7>(p, stream); launch_one<8>(p, stream);
#endif
}
```

```cpp
#include <hip/hip_runtime.h>
#include <hip/hip_cooperative_groups.h>
#include <cstdio>
namespace cg = cooperative_groups;

#ifndef SINGLE_LAUNCH
#define SINGLE_LAUNCH 1
#endif

#define LAS __attribute__((address_space(3)))
typedef unsigned short bf16_t;
typedef short bf16x8 __attribute__((ext_vector_type(8)));
typedef float f32x8 __attribute__((ext_vector_type(8)));
typedef float f32x4 __attribute__((ext_vector_type(4)));
typedef float f32x2 __attribute__((ext_vector_type(2)));
typedef unsigned u32x4 __attribute__((ext_vector_type(4)));
typedef unsigned u32x2 __attribute__((ext_vector_type(2)));

constexpr int T = 32768, DM = 1024, SEQ = 2048, NB_ = 16;
constexpr int N1 = 9472;
constexpr int LDR = 3328;
constexpr int LDS_BYTES = 131072;
constexpr int NPHASE = 9;

constexpr size_t MiB = 1u << 20;
constexpr size_t OFF_U = 0, OFF_OGC = 64 * MiB, OFF_RKVL = 128 * MiB, OFF_OGR = 336 * MiB, OFF_GC = 400 * MiB, OFF_WINT = 464 * MiB;
constexpr size_t OFF_ALORA = OFF_WINT + (size_t)N1 * 1024 * 2;
constexpr size_t OFF_W2T = OFF_ALORA + 16 * MiB, OFF_WOT = OFF_W2T + 4 * MiB, OFF_LBT = OFF_WOT + 2 * MiB, OFF_MOD = OFF_LBT + 1 * MiB;
constexpr size_t OFF_BAR = OFF_MOD + 16 * 3072 * 4;
constexpr size_t OFF_ROWSS = OFF_BAR + 3456 * 4 + 128;
constexpr size_t OFF_PCNT = OFF_ROWSS + (size_t)T * 4;
constexpr size_t WS_END = OFF_PCNT + 256 * 4;
constexpr size_t OFF_MP = OFF_RKVL, OFF_M = OFF_RKVL + 128 * MiB, OFF_DW = OFF_U;

struct Params {
    const float *x, *c, *ada_w, *ada_b, *norm_g, *w_in, *conv_k, *conv_b, *conv_ln_g, *conv_ln_b, *w_conv_out, *rwkv_mu, *rwkv_w0, *rwkv_w2, *rwkv_a0, *rwkv_a2,
        *rwkv_k_k, *rwkv_k_a, *rwkv_r_k, *rwkv_gn_g, *rwkv_gn_b, *w_rwkv_out, *w_out, *final_g;
    float* out;
    unsigned char* ws;
};

typedef __bf16 bf16x2_t __attribute__((ext_vector_type(2)));
__device__ __forceinline__ unsigned cvt_pk_bf16(float lo, float hi) { const bf16x2_t r = __builtin_convertvector((f32x2){lo, hi}, bf16x2_t); return __builtin_bit_cast(unsigned, r); }
__device__ __forceinline__ bf16_t f2bf(float f) { return (bf16_t)(cvt_pk_bf16(f, 0.f) & 0xffffu); }
__device__ __forceinline__ float bf2f(bf16_t b) { return __uint_as_float(((unsigned)b) << 16); }
__device__ __forceinline__ float bflo(unsigned v) { return __uint_as_float(v << 16); }
__device__ __forceinline__ float bfhi(unsigned v) { return __uint_as_float(v & 0xffff0000u); }
__device__ __forceinline__ float sigm(float x) { return __builtin_amdgcn_rcpf(1.f + __expf(-x)); }
__device__ __forceinline__ int tid_opaque() { int t = threadIdx.x; asm volatile("" : "+v"(t)); return t; }
__device__ __forceinline__ unsigned char* uniform_ptr(unsigned char* p) { const size_t v = (size_t)p; const unsigned lo = __builtin_amdgcn_readfirstlane((unsigned)v), hi = __builtin_amdgcn_readfirstlane((unsigned)(v >> 32)); return (unsigned char*)(((size_t)hi << 32) | lo); }
template <int CTRL> __device__ __forceinline__ float dpp_add(float v) { return v + __int_as_float(__builtin_amdgcn_update_dpp(0, __float_as_int(v), CTRL, 0xF, 0xF, true)); }
__device__ __forceinline__ float wave_sum(float v) {
    v = dpp_add<0xB1>(v); v = dpp_add<0x4E>(v); v = dpp_add<0x141>(v); v = dpp_add<0x140>(v);
    const int iv = __float_as_int(v);
    return (__int_as_float(__builtin_amdgcn_readlane(iv, 0)) + __int_as_float(__builtin_amdgcn_readlane(iv, 16))) + (__int_as_float(__builtin_amdgcn_readlane(iv, 32)) + __int_as_float(__builtin_amdgcn_readlane(iv, 48)));
}

#define XB_TMO      128
#define XB_XCNT(j)  (256  + 64 * (j))
#define XB_XSUB(j)  (1280 + 64 * (j))
#define XB_XGEN(j)  (2304 + 64 * (j))
#define XB_TOP      3328
#define XB_TOPGEN   3392
#define XB_WORDS    3456
#define XB_SPIN_CAP (1u << 22)
__device__ __forceinline__ unsigned xb_ld(unsigned* p)              { return __hip_atomic_load(p, __ATOMIC_RELAXED, __HIP_MEMORY_SCOPE_AGENT); }
__device__ __forceinline__ unsigned xb_add(unsigned* p, unsigned v) { return __hip_atomic_fetch_add(p, v, __ATOMIC_RELAXED, __HIP_MEMORY_SCOPE_AGENT); }
__device__ __forceinline__ unsigned xb_xcc_id() { return (unsigned)__builtin_amdgcn_s_getreg((3 << 11) | 20) & 0xFu; }
#define XB_SPIN(cond, bar) do { unsigned _sp = 0; while (cond) { __builtin_amdgcn_s_sleep(1); \
    if ((++_sp & 255u) == 0u) { if (xb_ld(&(bar)[XB_TMO])) break; if (_sp > XB_SPIN_CAP) { atomicAdd(&(bar)[XB_TMO], 1u); break; } } } } while (0)
__device__ __forceinline__ void xcd_barrier_complete(unsigned* bar, unsigned x, unsigned& nloc, unsigned& nx) {
    const unsigned G = gridDim.x; unsigned sum, cnt, mine, sp = 0u;
    for (;;) { sum = 0u; cnt = 0u; mine = 0u;
#pragma unroll
        for (unsigned j = 0; j < 16; ++j) { const unsigned c = xb_ld(&bar[XB_XCNT(j)]); sum += c; cnt += (c > 0u) ? 1u : 0u; mine = (j == x) ? c : mine; }
        if (sum == G) break;
        __builtin_amdgcn_s_sleep(1);
        if ((++sp & 255u) == 0u) { if (xb_ld(&bar[XB_TMO])) break; if (sp > XB_SPIN_CAP) { atomicAdd(&bar[XB_TMO], 1u); break; } } }
    nloc = mine > 0u ? mine : 1u; nx = cnt > 0u ? cnt : 1u;
}
__device__ __forceinline__ void grid_barrier(unsigned* bar, volatile LAS unsigned* st) {
    asm volatile("s_waitcnt vmcnt(0) lgkmcnt(0)" ::: "memory");
    __syncthreads();
    if (threadIdx.x == 0) {
        const unsigned x = xb_xcc_id();
        unsigned nloc = st[0], nx = st[1];
        if (nloc == 0u) { xcd_barrier_complete(bar, x, nloc, nx); st[0] = nloc; st[1] = nx; }
        const unsigned old = xb_add(&bar[XB_XSUB(x)], 1u);
        const unsigned gen = old / nloc;
        if (old + 1u == (gen + 1u) * nloc) {
            __builtin_amdgcn_fence(__ATOMIC_RELEASE, "agent");
            asm volatile("s_waitcnt vmcnt(0)" ::: "memory");
            const unsigned og = xb_add(&bar[XB_TOP], 1u);
            const unsigned tg = og / nx;
            if (og + 1u == (tg + 1u) * nx) xb_add(&bar[XB_TOPGEN], 1u);
            else XB_SPIN(xb_ld(&bar[XB_TOPGEN]) == tg, bar);
            __builtin_amdgcn_fence(__ATOMIC_ACQUIRE, "agent");
            xb_add(&bar[XB_XGEN(x)], 1u);
            asm volatile("s_waitcnt vmcnt(0)" ::: "memory");
        } else {
            XB_SPIN(xb_ld(&bar[XB_XGEN(x)]) == gen, bar);
            __builtin_amdgcn_fence(__ATOMIC_ACQUIRE, "agent");
            asm volatile("s_waitcnt vmcnt(0)" ::: "memory");
        }
    }
    __syncthreads();
}

namespace pg8 {
constexpr int BM = 256, BK = 64, HALF = 128, HTB = HALF * BK * 2, NXCD = 8, WGM = 8;
__host__ __device__ __forceinline__ int lds_byte(int r, int c) { const int st = (r >> 4) * 2 + (c >> 5), rr = r & 15, cc = c & 31, ob = rr * 64 + cc * 2; return st * 1024 + (ob ^ (((ob >> 9) & 1) << 5)); }
__host__ __device__ __forceinline__ void stage_rc(int b, int& R, int& C) { const int st = b / 1024, sb = b % 1024, swz = sb ^ (((sb >> 9) & 1) << 5); R = (st >> 1) * 16 + swz / 64; C = (st & 1) * 32 + (swz % 64) / 2; }
__host__ __device__ __forceinline__ int perm32(int rho) { const int n = rho >> 4, i = rho & 15; return 8 * (i >> 2) + 4 * n + (i & 3); }
struct Unit { int pm, pn, kind; };

__device__ __forceinline__ void map_unit(int L, int nM, int nN, Unit& u) {
    const int nwg = nM * nN; int wgid = L;
    { const int q = nwg / NXCD, r = nwg % NXCD, xcd = wgid % NXCD, off = wgid / NXCD; wgid = (xcd < r ? xcd * (q + 1) : r * (q + 1) + (xcd - r) * q) + off; }
    const int nig = WGM * nN, gid = wgid / nig, fm = gid * WGM, gsz = (nM - fm) < WGM ? (nM - fm) : WGM;
    u.pm = fm + ((wgid % nig) % gsz); u.pn = (wgid % nig) / gsz;
}
struct Sched1 {
    int nM, nN, G, c; const char* A; const char* Bt; size_t tstep;
    __device__ __forceinline__ bool next(int i, Unit& u) const { const long L = (long)i * G + c; if (L >= (long)nM * nN) return false; map_unit((int)L, nM, nN, u); u.kind = 0; return true; }
    __device__ __forceinline__ const char* aptr(const Unit& u) const { return A + (size_t)u.pm * tstep; }
    __device__ __forceinline__ const char* bptr(const Unit& u) const { return Bt + (size_t)u.pn * tstep; }
};
struct Sched2 {
    int nM, nN, G, c; const char* A0; const char* A1; const char* B0; const char* B1; size_t tstep;
    __device__ __forceinline__ bool next(int i, Unit& u) const { const long L = (long)(i >> 1) * G + c; if (L >= (long)nM * nN) return false; map_unit((int)L, nM, nN, u); u.kind = i & 1; return true; }
    __device__ __forceinline__ const char* aptr(const Unit& u) const { return (u.kind ? A1 : A0) + (size_t)u.pm * tstep; }
    __device__ __forceinline__ const char* bptr(const Unit& u) const { return (u.kind ? B1 : B0) + (size_t)u.pn * tstep; }
};

template <class Epi, class Sched>
__device__ __forceinline__ void gemm_phase(LAS unsigned char* lds, const int K, const Sched& S, const Epi& E) {
    const int tid = tid_opaque(), wid = __builtin_amdgcn_readfirstlane(tid >> 6), lane = tid & 63, wr = wid >> 2, wc = wid & 3, fr = lane & 15, fq = lane >> 4;
    const int nt = K / BK;
    unsigned voffA[2], voffB[2];
#pragma unroll
    for (int i = 0; i < 2; ++i) { int R, C; stage_rc(tid * 16 + i * 8192, R, C); const int Rb = Epi::PERM ? ((R & ~31) + perm32(R & 31)) : R;
        voffA[i] = (unsigned)(R * K + C) * 2u; voffB[i] = (unsigned)(Rb * K + C) * 2u; }
    const size_t kstep = (size_t)(BK * 2);
    const size_t hstep = (size_t)HALF * K * 2;
    const unsigned ldsw = (unsigned)wid * 1024u;
    const int aoff = lds_byte(wr * 64 + fr, fq * 8), boff = lds_byte(wc * 32 + fr, fq * 8);
#define PG8_SA(b, h) (((b) * 2 + (h)) * HTB)
#define PG8_SB(b, h) ((4 + (b) * 2 + (h)) * HTB)
#define PG8_STAGE(bufoff, gbase, voff) do { _Pragma("unroll") for (int _i = 0; _i < 2; ++_i) \
        __builtin_amdgcn_global_load_lds((const unsigned*)((const char*)(gbase) + (voff)[_i]), (LAS unsigned*)(lds + (bufoff) + ldsw + _i * 8192), 16, 0, 0); } while (0)
#define PG8_LDA(dst, b, h) do { _Pragma("unroll") for (int m = 0; m < 4; ++m) _Pragma("unroll") for (int k = 0; k < 2; ++k) dst[m][k] = *(const LAS bf16x8*)(lds + PG8_SA(b, h) + aoff + m * 2048 + k * 1024); } while (0)
#define PG8_LDB(dst, b, h) do { _Pragma("unroll") for (int n = 0; n < 2; ++n) _Pragma("unroll") for (int k = 0; k < 2; ++k) dst[n][k] = *(const LAS bf16x8*)(lds + PG8_SB(b, h) + boff + n * 2048 + k * 1024); } while (0)
#define PG8_MMA(ai, bj, At, Bt) do { __builtin_amdgcn_s_setprio(1); _Pragma("unroll") for (int m = 0; m < 4; ++m) _Pragma("unroll") for (int n = 0; n < 2; ++n) _Pragma("unroll") for (int k = 0; k < 2; ++k) \
        acc[ai][bj][m][n] = __builtin_amdgcn_mfma_f32_16x16x32_bf16(Bt[n][k], At[m][k], acc[ai][bj][m][n], 0, 0, 0); __builtin_amdgcn_s_setprio(0); } while (0)
#define PG8_WAIT_V(n) asm volatile("s_waitcnt vmcnt(" #n ")" ::: "memory")
#define PG8_WAIT_L(n) asm volatile("s_waitcnt lgkmcnt(" #n ")" ::: "memory")
#define PG8_BAR __builtin_amdgcn_s_barrier()
#define PG8_SCHED __builtin_amdgcn_sched_barrier(0)
    Unit cur, nxt; int ui = 0;
    if (!S.next(0, cur)) return;
    f32x4 acc[2][2][4][2];
#pragma unroll
    for (int a = 0; a < 2; ++a)
#pragma unroll
        for (int b = 0; b < 2; ++b)
#pragma unroll
            for (int m = 0; m < 4; ++m)
#pragma unroll
                for (int n = 0; n < 2; ++n) acc[a][b][m][n] = (f32x4){0.f, 0.f, 0.f, 0.f};
    bf16x8 At[4][2], B0[2][2], B1[2][2];
    const char* cA = S.aptr(cur); const char* cB = S.bptr(cur);
    PG8_STAGE(PG8_SB(0, 0), cB, voffB); PG8_STAGE(PG8_SA(0, 0), cA, voffA); PG8_STAGE(PG8_SB(0, 1), cB + hstep, voffB); PG8_STAGE(PG8_SA(0, 1), cA + hstep, voffA);
    if (wr == 1) PG8_BAR;
    PG8_WAIT_V(4); PG8_BAR;
    PG8_STAGE(PG8_SB(1, 0), cB + kstep, voffB); PG8_STAGE(PG8_SA(1, 0), cA + kstep, voffA); PG8_STAGE(PG8_SB(1, 1), cB + hstep + kstep, voffB);
    PG8_WAIT_V(6); PG8_BAR;
    for (;;) {
        const bool has_next = S.next(ui + 1, nxt);
        const char* nA = has_next ? S.aptr(nxt) : cA; const char* nB = has_next ? S.bptr(nxt) : cB;
        for (int t = 0; t < nt; t += 2) {
            const bool last = (t == nt - 2);
            const char* a1 = cA + (size_t)(t + 1) * kstep;
            const char* a2 = last ? nA : cA + (size_t)(t + 2) * kstep; const char* b2 = last ? nB : cB + (size_t)(t + 2) * kstep;
            const char* a3 = a2 + kstep; const char* b3 = b2 + kstep;
            PG8_LDB(B0, 0, 0); PG8_SCHED; PG8_LDA(At, 0, 0); PG8_STAGE(PG8_SA(1, 1), a1 + hstep, voffA);
            PG8_WAIT_L(8); PG8_BAR; PG8_WAIT_L(0); PG8_MMA(0, 0, At, B0); PG8_BAR; PG8_SCHED;
            PG8_LDB(B1, 0, 1); PG8_STAGE(PG8_SB(0, 0), b2, voffB);
            PG8_BAR; PG8_WAIT_L(0); PG8_MMA(0, 1, At, B1); PG8_BAR;
            PG8_LDA(At, 0, 1); PG8_STAGE(PG8_SA(0, 0), a2, voffA);
            PG8_BAR; PG8_WAIT_L(0); PG8_MMA(1, 0, At, B0); PG8_BAR; PG8_SCHED;
            PG8_STAGE(PG8_SB(0, 1), b2 + hstep, voffB);
            PG8_WAIT_V(6); PG8_BAR; PG8_MMA(1, 1, At, B1); PG8_BAR;
            PG8_LDB(B0, 1, 0); PG8_SCHED; PG8_LDA(At, 1, 0); PG8_STAGE(PG8_SA(0, 1), a2 + hstep, voffA);
            PG8_WAIT_L(8); PG8_BAR; PG8_WAIT_L(0); PG8_MMA(0, 0, At, B0); PG8_BAR; PG8_SCHED;
            PG8_LDB(B1, 1, 1); PG8_STAGE(PG8_SB(1, 0), b3, voffB);
            PG8_BAR; PG8_WAIT_L(0); PG8_MMA(0, 1, At, B1); PG8_BAR;
            PG8_LDA(At, 1, 1); PG8_STAGE(PG8_SA(1, 0), a3, voffA);
            PG8_BAR; PG8_WAIT_L(0); PG8_MMA(1, 0, At, B0); PG8_BAR; PG8_SCHED;
            PG8_STAGE(PG8_SB(1, 1), b3 + hstep, voffB);
            PG8_WAIT_V(6); PG8_BAR; PG8_MMA(1, 1, At, B1); PG8_BAR;
        }
        E(acc, cur, wr, wc, fr, fq);
        if (!has_next) break;
        if (!E.keep(cur)) {
#pragma unroll
        for (int a = 0; a < 2; ++a)
#pragma unroll
            for (int b = 0; b < 2; ++b)
#pragma unroll
                for (int m = 0; m < 4; ++m)
#pragma unroll
                    for (int n = 0; n < 2; ++n) acc[a][b][m][n] = (f32x4){0.f, 0.f, 0.f, 0.f};
        }
        cur = nxt; cA = nA; cB = nB; ++ui;
    }
    PG8_WAIT_V(0);
    if (wr == 0) PG8_BAR;
    PG8_BAR;
#undef PG8_SA
#undef PG8_SB
#undef PG8_STAGE
#undef PG8_LDA
#undef PG8_LDB
#undef PG8_MMA
#undef PG8_WAIT_V
#undef PG8_WAIT_L
#undef PG8_BAR
#undef PG8_SCHED
}
}
using pg8::Unit;

template <int ACT> __device__ __forceinline__ float actf(float v) { return ACT == 1 ? v * sigm(v) : (ACT == 2 ? sigm(v) : v); }
template <int ACT> __device__ __forceinline__ void store_tile_bf16(const f32x4 (&acc)[2][2][4][2], bf16_t* base  , int ld) {
#pragma unroll
    for (int ai = 0; ai < 2; ++ai)
#pragma unroll
        for (int m = 0; m < 4; ++m) { bf16_t* rowp = base + (size_t)(ai * 128 + m * 16) * ld;
#pragma unroll
            for (int bj = 0; bj < 2; ++bj) { const f32x4 v0 = acc[ai][bj][m][0], v1 = acc[ai][bj][m][1]; u32x4 w;
                w.x = cvt_pk_bf16(actf<ACT>(v0[0]), actf<ACT>(v0[1])); w.y = cvt_pk_bf16(actf<ACT>(v0[2]), actf<ACT>(v0[3]));
                w.z = cvt_pk_bf16(actf<ACT>(v1[0]), actf<ACT>(v1[1])); w.w = cvt_pk_bf16(actf<ACT>(v1[2]), actf<ACT>(v1[3]));
                *(u32x4*)(rowp + bj * 128) = w; } }
}
struct EpiG1 {
    static constexpr bool PERM = true;
    __device__ __forceinline__ bool keep(const Unit&) const { return false; }
    unsigned char *ws, *outb;
    __device__ __forceinline__ void operator()(const f32x4 (&acc)[2][2][4][2], const Unit& u, int wr, int wc, int fr, int fq) const {
        unsigned char* w = uniform_ptr(ws); unsigned char* ob = uniform_ptr(outb); asm volatile("" : "+s"(w), "+s"(ob));
        const int row0 = u.pm * 256 + wr * 64 + fr, pn = u.pn, cw = wc * 32 + 8 * fq;
        if (pn < 8) {
            bf16_t* base = (bf16_t*)(w + OFF_U) + (size_t)row0 * 1024 + pn * 128 + cw;
#pragma unroll
            for (int ai = 0; ai < 2; ++ai)
#pragma unroll
                for (int m = 0; m < 4; ++m) { const f32x4 a0 = acc[ai][0][m][0], a1 = acc[ai][0][m][1], g0 = acc[ai][1][m][0], g1 = acc[ai][1][m][1]; u32x4 wv;
                    wv.x = cvt_pk_bf16(a0[0] * sigm(g0[0]), a0[1] * sigm(g0[1])); wv.y = cvt_pk_bf16(a0[2] * sigm(g0[2]), a0[3] * sigm(g0[3]));
                    wv.z = cvt_pk_bf16(a1[0] * sigm(g1[0]), a1[1] * sigm(g1[1])); wv.w = cvt_pk_bf16(a1[2] * sigm(g1[2]), a1[3] * sigm(g1[3]));
                    *(u32x4*)(base + (size_t)(ai * 128 + m * 16) * 1024) = wv; }
        } else if (pn < 12) store_tile_bf16<1>(acc, (bf16_t*)(w + OFF_OGC) + (size_t)row0 * 1024 + (pn - 8) * 256 + cw, 1024);
        else if (pn < 25) store_tile_bf16<0>(acc, (bf16_t*)(w + OFF_RKVL) + (size_t)row0 * LDR + (pn - 12) * 256 + cw, LDR);
        else if (pn < 29) store_tile_bf16<1>(acc, (bf16_t*)(w + OFF_OGR) + (size_t)row0 * 1024 + (pn - 25) * 256 + cw, 1024);
        else if (pn < 33) store_tile_bf16<2>(acc, (bf16_t*)(w + OFF_GC) + (size_t)row0 * 1024 + (pn - 29) * 256 + cw, 1024);
        else store_tile_bf16<2>(acc, (bf16_t*)(ob + 64 * MiB) + (size_t)row0 * 1024 + (pn - 33) * 256 + cw, 1024);
    }
};
struct EpiLora {
    static constexpr bool PERM = true;
    __device__ __forceinline__ bool keep(const Unit&) const { return false; }
    bf16_t *DW, *AP;
    __device__ __forceinline__ void operator()(const f32x4 (&acc)[2][2][4][2], const Unit& u, int wr, int wc, int fr, int fq) const {
        const int row0 = u.pm * 256 + wr * 64 + fr, cw = wc * 32 + 8 * fq;
        bf16_t* base = (u.pn < 4 ? DW + (size_t)u.pn * 256 : AP + (size_t)(u.pn - 4) * 256) + (size_t)row0 * 1024 + cw;
        store_tile_bf16<0>(acc, base, 1024);
    }
};
struct EpiG2 {
    static constexpr bool PERM = true;
    const bf16_t *GC, *GR; bf16_t* M;
    __device__ __forceinline__ bool keep(const Unit& u) const { return u.kind == 0; }
    __device__ __forceinline__ void operator()(f32x4 (&acc)[2][2][4][2], const Unit& u, int wr, int wc, int fr, int fq) const {
        const size_t off0 = (size_t)(u.pm * 256 + wr * 64 + fr) * 1024 + u.pn * 256 + wc * 32 + 8 * fq;
#pragma unroll
        for (int ai = 0; ai < 2; ++ai)
#pragma unroll
            for (int m = 0; m < 4; ++m)
#pragma unroll
                for (int bj = 0; bj < 2; ++bj) { const size_t off = off0 + (size_t)(ai * 128 + m * 16) * 1024 + bj * 128;
                    const u32x4 gr = *(const u32x4*)(GR + off); f32x4& v0 = acc[ai][bj][m][0]; f32x4& v1 = acc[ai][bj][m][1];
                    const f32x4 r0 = {bflo(gr.x), bfhi(gr.x), bflo(gr.y), bfhi(gr.y)}, r1 = {bflo(gr.z), bfhi(gr.z), bflo(gr.w), bfhi(gr.w)};
                    if (u.kind == 0) { const u32x4 gc = *(const u32x4*)(GC + off);
                        const f32x4 c0 = {bflo(gc.x), bfhi(gc.x), bflo(gc.y), bfhi(gc.y)}, c1 = {bflo(gc.z), bfhi(gc.z), bflo(gc.w), bfhi(gc.w)};
#pragma unroll
                        for (int j = 0; j < 4; ++j) { v0[j] *= c0[j] * __builtin_amdgcn_rcpf(fmaxf(r0[j], 1e-30f)); v1[j] *= c1[j] * __builtin_amdgcn_rcpf(fmaxf(r1[j], 1e-30f)); }
                    } else { const f32x4 m0 = v0 * r0, m1 = v1 * r1; u32x4 w;
                        w.x = cvt_pk_bf16(m0[0], m0[1]); w.y = cvt_pk_bf16(m0[2], m0[3]); w.z = cvt_pk_bf16(m1[0], m1[1]); w.w = cvt_pk_bf16(m1[2], m1[3]);
                        *(u32x4*)(M + off) = w; } }
    }
};
struct EpiG3 {
    static constexpr bool PERM = false;
    const float *x, *mod, *fg; float* out; float* rowss; unsigned* pcnt;
    __device__ __forceinline__ bool keep(const Unit&) const { return false; }
    __device__ __forceinline__ void operator()(f32x4 (&acc)[2][2][4][2], const Unit& u, int wr, int wc, int fr, int fq) const {
        const int col0 = u.pn * 256 + wc * 32 + 4 * fq, row0 = u.pm * 256 + wr * 64 + fr; const size_t off0 = (size_t)row0 * 1024 + col0;
        const float* gp = mod + (size_t)(u.pm >> 3) * 3072 + 2048 + col0;
        { f32x4 gv[2][2];
#pragma unroll
        for (int bj = 0; bj < 2; ++bj)
#pragma unroll
            for (int n = 0; n < 2; ++n) gv[bj][n] = *(const f32x4*)(gp + bj * 128 + n * 16);
#pragma unroll
        for (int ai = 0; ai < 2; ++ai)
#pragma unroll
            for (int m = 0; m < 4; ++m) { float ps = 0.f;
#pragma unroll
                for (int bj = 0; bj < 2; ++bj)
#pragma unroll
                    for (int n = 0; n < 2; ++n) { const size_t off = off0 + (size_t)(ai * 128 + m * 16) * 1024 + bj * 128 + n * 16;
                        const f32x4 v = *(const f32x4*)(x + off) + gv[bj][n] * acc[ai][bj][m][n]; acc[ai][bj][m][n] = v; ps += v[0] * v[0] + v[1] * v[1] + v[2] * v[2] + v[3] * v[3]; }
                ps += __shfl_xor(ps, 16); ps += __shfl_xor(ps, 32);
                if (fq == 0) __hip_atomic_fetch_add(rowss + row0 + ai * 128 + m * 16, ps, __ATOMIC_RELAXED, __HIP_MEMORY_SCOPE_AGENT); } }
        asm volatile("s_waitcnt vmcnt(0)" ::: "memory");
        unsigned* pc = pcnt + u.pm * 2 + wr;
        if (fr == 0 && fq == 0) __hip_atomic_fetch_add(pc, 1u, __ATOMIC_RELAXED, __HIP_MEMORY_SCOPE_AGENT);
        { unsigned sp = 0; while (__hip_atomic_load(pc, __ATOMIC_RELAXED, __HIP_MEMORY_SCOPE_AGENT) < 16u && ++sp < (1u << 22)) __builtin_amdgcn_s_sleep(1); }
#pragma unroll
        for (int ai = 0; ai < 2; ++ai)
#pragma unroll
            for (int m = 0; m < 4; ++m) { const float ss = __hip_atomic_load(rowss + row0 + ai * 128 + m * 16, __ATOMIC_RELAXED, __HIP_MEMORY_SCOPE_AGENT);
                const float rstd = __builtin_amdgcn_rsqf(ss * (1.f / 1024.f) + 1e-6f);
#pragma unroll
                for (int bj = 0; bj < 2; ++bj)
#pragma unroll
                    for (int n = 0; n < 2; ++n) { const size_t off = off0 + (size_t)(ai * 128 + m * 16) * 1024 + bj * 128 + n * 16;
                        *(f32x4*)(out + off) = acc[ai][bj][m][n] * rstd * *(const f32x4*)(fg + col0 + bj * 128 + n * 16); } }
    }
};

__device__ void phase_mod(const Params& p, unsigned char* smem) {
    if (blockIdx.x >= 48) return;
    float* sc = (float*)smem;
    float* red = sc + 16384;
    const int tid = tid_opaque(), w = tid >> 6, lane = tid & 63;
    for (int i = tid; i < 16384; i += 512) { const int b = i >> 10, d = i & 1023; const float cv = p.c[i]; sc[d * 16 + b] = cv * sigm(cv); }
    __syncthreads();
    const int e = blockIdx.x * 64 + lane;
    float acc[16];
#pragma unroll
    for (int b = 0; b < 16; ++b) acc[b] = 0.f;
    for (int d0 = w * 128; d0 < w * 128 + 128; d0 += 16) {
        float wvs[16];
#pragma unroll
        for (int u = 0; u < 16; ++u) wvs[u] = p.ada_w[(size_t)(d0 + u) * 3072 + e];
#pragma unroll
        for (int u = 0; u < 16; ++u) { const int d = d0 + u; const float wv = wvs[u];
        const f32x4* s4 = (const f32x4*)(sc + d * 16);
#pragma unroll
        for (int q = 0; q < 4; ++q) { const f32x4 s = s4[q]; acc[4 * q] += s[0] * wv; acc[4 * q + 1] += s[1] * wv; acc[4 * q + 2] += s[2] * wv; acc[4 * q + 3] += s[3] * wv; }
        }
    }
#pragma unroll
    for (int b = 0; b < 16; ++b) red[(w * 16 + b) * 64 + lane] = acc[b];
    __syncthreads();
    float* mod = (float*)(p.ws + OFF_MOD);
    for (int i = tid; i < 1024; i += 512) { const int b = i >> 6, l = i & 63; float s = 0.f;
#pragma unroll
        for (int ww = 0; ww < 8; ++ww) s += red[(ww * 16 + b) * 64 + l];
        mod[b * 3072 + blockIdx.x * 64 + l] = s + p.ada_b[blockIdx.x * 64 + l]; }
    __syncthreads();
}
__device__ __forceinline__ void transpose_tile(const float* src, int ld, int n_src0, int k0, bf16_t* dst, int n_dst0, float* tile) {
    const int tid = tid_opaque();
#pragma unroll
    for (int r = 0; r < 2; ++r) { const int i = (tid >> 4) + 32 * r, j4 = (tid & 15) * 4;
        f32x4 v = {0.f, 0.f, 0.f, 0.f}; if (n_src0 >= 0) v = *(const f32x4*)(src + (size_t)(k0 + i) * ld + n_src0 + j4);
        tile[i * 65 + j4] = v[0]; tile[i * 65 + j4 + 1] = v[1]; tile[i * 65 + j4 + 2] = v[2]; tile[i * 65 + j4 + 3] = v[3]; }
    __syncthreads();
    const int j = tid >> 3, i8 = (tid & 7) * 8; u32x4 w;
    w.x = cvt_pk_bf16(tile[(i8 + 0) * 65 + j], tile[(i8 + 1) * 65 + j]); w.y = cvt_pk_bf16(tile[(i8 + 2) * 65 + j], tile[(i8 + 3) * 65 + j]);
    w.z = cvt_pk_bf16(tile[(i8 + 4) * 65 + j], tile[(i8 + 5) * 65 + j]); w.w = cvt_pk_bf16(tile[(i8 + 6) * 65 + j], tile[(i8 + 7) * 65 + j]);
    *(u32x4*)(dst + (size_t)(n_dst0 + j) * 1024 + k0 + i8) = w;
    __syncthreads();
}
__device__ void phase_weights(const Params& p, unsigned char* smem) {
    float* tile = (float*)smem;
    for (int i = blockIdx.x * 512 + threadIdx.x; i < T + 256; i += gridDim.x * 512) ((unsigned*)(p.ws + OFF_ROWSS))[i] = 0u;
    bf16_t* WinT = (bf16_t*)(p.ws + OFF_WINT); bf16_t* W2T = (bf16_t*)(p.ws + OFF_W2T); bf16_t* WoT = (bf16_t*)(p.ws + OFF_WOT); bf16_t* LBt = (bf16_t*)(p.ws + OFF_LBT);
    constexpr int NT1 = (N1 / 64) * 16;
    const bool bal = (gridDim.x == 256); const int nb = blockIdx.x;
    const int first = bal ? (nb >= 48 ? nb - 48 : 2704 + nb) : nb, stride = bal ? (nb >= 48 ? 208 : 48) : (int)gridDim.x, last = bal ? (nb >= 48 ? 2704 : 3136) : NT1 + 768;
    for (int idx = first; idx < last; idx += stride) {
        if (idx < NT1) { const int a = idx >> 4, kt = idx & 15, n0 = a * 64; int src;
            if (n0 < 2048) { const int j = n0 >> 8, wi = n0 & 255; src = wi < 128 ? 128 * j + wi : 1024 + 128 * j + wi - 128; }
            else if (n0 < 6272) src = n0; else if (n0 < 6400) src = -1; else src = n0 - 128;
            transpose_tile(p.w_in, 9344, src, kt * 64, WinT, n0, tile);
        } else { const int r = idx - NT1, which = r >> 8, a = (r >> 4) & 15, kt = r & 15;
            const float* src = which == 0 ? p.w_conv_out : (which == 1 ? p.w_rwkv_out : p.w_out);
            bf16_t* dst = which == 0 ? W2T : (which == 1 ? W2T + (size_t)1024 * 1024 : WoT);
            transpose_tile(src, 1024, a * 64, kt * 64, dst, a * 64, tile); }
    }
    for (int idx = blockIdx.x * 512 + tid_opaque(); idx < 2048 * 128; idx += gridDim.x * 512) { const int n = idx >> 7, k = idx & 127; float v = 0.f;
        if (n < 1024) { if (k < 64) v = p.rwkv_w2[k * 1024 + n]; } else { if (k >= 64) v = p.rwkv_a2[(k - 64) * 1024 + n - 1024]; }
        LBt[idx] = f2bf(v); }
}
__device__ void phase_h(const Params& p) {
    const int tid = tid_opaque(), w = tid >> 6, lane = tid & 63;
    const float* mod = (const float*)(p.ws + OFF_MOD); bf16_t* Hh = (bf16_t*)p.out;
    for (int tok = blockIdx.x * 8 + w; tok < T; tok += gridDim.x * 8) {
        const int b = tok >> 11; const float* xr = p.x + (size_t)tok * 1024; f32x4 v[4]; float ss = 0.f;
#pragma unroll
        for (int q = 0; q < 4; ++q) { v[q] = *(const f32x4*)(xr + q * 256 + lane * 4); ss += v[q][0] * v[q][0] + v[q][1] * v[q][1] + v[q][2] * v[q][2] + v[q][3] * v[q][3]; }
        ss = wave_sum(ss); const float rstd = rsqrtf(ss * (1.f / 1024.f) + 1e-6f);
#pragma unroll
        for (int q = 0; q < 4; ++q) { const int col = q * 256 + lane * 4; const f32x4 g = *(const f32x4*)(p.norm_g + col), sh = *(const f32x4*)(mod + b * 3072 + col), sc = *(const f32x4*)(mod + b * 3072 + 1024 + col);
            const f32x4 y = v[q] * rstd * g * (sc + 1.f) + sh; u32x2 o; o.x = cvt_pk_bf16(y[0], y[1]); o.y = cvt_pk_bf16(y[2], y[3]);
            *(u32x2*)(Hh + (size_t)tok * 1024 + col) = o; }
    }
}
__device__ void phase_conv(const Params& p, unsigned char* smem) {
    const int tid = tid_opaque(), w = tid >> 6, lane = tid & 63, c0 = tid * 2;
    const bf16_t* U = (const bf16_t*)(p.ws + OFF_U); bf16_t* OGC = (bf16_t*)(p.ws + OFF_OGC);
    float* part = (float*)smem;
    float* stat = part + 32 * 512;
    f32x2 wk[31];
#pragma unroll
    for (int j = 0; j < 31; ++j) wk[j] = *(const f32x2*)(p.conv_k + j * 1024 + c0);
    const f32x2 cb = *(const f32x2*)(p.conv_b + c0), lg = *(const f32x2*)(p.conv_ln_g + c0), lb = *(const f32x2*)(p.conv_ln_b + c0);
    for (int tile = blockIdx.x; tile < T / 16; tile += gridDim.x) {
        const int b = tile >> 7, t0 = (tile & 127) * 16; const size_t row0 = (size_t)b * SEQ + t0;
        f32x2 u[46];
#pragma unroll
        for (int i = 0; i < 46; ++i) { const int t = t0 - 30 + i; unsigned v = 0u; if (t >= 0) v = *(const unsigned*)(U + ((size_t)b * SEQ + t) * 1024 + c0); u[i] = (f32x2){bflo(v), bfhi(v)}; }
        f32x2 o[16];
#pragma unroll
        for (int i = 0; i < 16; ++i) { f32x2 a = cb;
#pragma unroll
            for (int j = 0; j < 31; ++j) a = wk[j] * u[i + j] + a;
            o[i] = a; }
#pragma unroll
        for (int i = 0; i < 16; ++i) { part[i * 512 + tid] = o[i].x + o[i].y; part[(16 + i) * 512 + tid] = o[i].x * o[i].x + o[i].y * o[i].y; }
        __syncthreads();
#pragma unroll
        for (int q = 0; q < 4; ++q) { const int v = 4 * w + q; float s = 0.f;
#pragma unroll
            for (int r = 0; r < 8; ++r) s += part[v * 512 + lane + 64 * r];
            s = wave_sum(s); if (lane == 0) stat[v] = s; }
        __syncthreads();
#pragma unroll
        for (int i = 0; i < 16; ++i) { const float mean = stat[i] * (1.f / 1024.f), var = stat[16 + i] * (1.f / 1024.f) - mean * mean, rstd = __builtin_amdgcn_rsqf(var + 1e-5f);
            float y0 = (o[i].x - mean) * rstd * lg.x + lb.x, y1 = (o[i].y - mean) * rstd * lg.y + lb.y; y0 *= sigm(y0); y1 *= sigm(y1);
            bf16_t* gp = OGC + (row0 + i) * 1024 + c0; const unsigned og = *(const unsigned*)gp;
            *(unsigned*)gp = cvt_pk_bf16(y0 * bflo(og), y1 * bfhi(og)); }
    }
    const bf16_t* RK = (const bf16_t*)(p.ws + OFF_RKVL); bf16_t* AL = (bf16_t*)(p.ws + OFF_ALORA);
    for (int idx = blockIdx.x * 512 + tid; idx < T * 128; idx += gridDim.x * 512) { const int t = idx >> 7, j = idx & 127;
        const float z = bf2f(RK[(size_t)t * LDR + 3072 + j]), pv = (t & (SEQ - 1)) ? bf2f(RK[(size_t)(t - 1) * LDR + 3072 + j]) : 0.f;
        const float s = z + p.rwkv_mu[3072 + j] * (pv - z); const float val = j < 64 ? tanhf(s) : s;
        AL[(size_t)t * 128 + j] = f2bf(val); }
}
constexpr int SCH = 32, SNCH = SEQ / SCH, SREC = 272;
struct ScanRaw { unsigned v[8], wa[8]; };
struct ScanOps { f32x4 a[8], b[4], k[4]; };
struct ScanC { float mu_r, mu_k, mu_v, w0c, a0c, kkc, kac, rkc, gng, gnb; };
__device__ __forceinline__ void scan_load_raw(ScanRaw& R, f32x2 (&S)[8], const bf16_t* RK, const bf16_t* DW, const bf16_t* AP, int b, int c, int pw, int ch) {
#pragma unroll
    for (int i = 0; i < 8; ++i) { const int t = c * SCH + 8 * pw + i; const size_t row = (size_t)b * SEQ + t; const bf16_t* rp = RK + row * LDR + ch;
        const bf16_t* rq = t > 0 ? rp - LDR : rp;
        S[i >> 1][i & 1] = __uint_as_float((unsigned)rp[0] | ((unsigned)rq[0] << 16)); S[4 + (i >> 1)][i & 1] = __uint_as_float((unsigned)rp[1024] | ((unsigned)rq[1024] << 16));
        R.v[i] = (unsigned)rp[2048] | ((unsigned)rq[2048] << 16); R.wa[i] = (unsigned)DW[row * 1024 + ch] | ((unsigned)AP[row * 1024 + ch] << 16); }
}
__device__ __forceinline__ void scan_prep(const ScanRaw& R, const f32x2 (&S)[8], const ScanC& C, int c, int pw, int lane, unsigned seq, float* rec, float* vbuf, f32x4* scl, float* wtot, float* ptot, volatile unsigned* flag) {
    float kkA[8], rA[8], nbA[8], kpA[8], LA[8]; float L = 1.f;
#pragma unroll
    for (int i = 0; i < 8; ++i) { const int tt = 8 * pw + i, t = c * SCH + tt;
        const unsigned Rr = __float_as_uint(S[i >> 1][i & 1]), Rk = __float_as_uint(S[4 + (i >> 1)][i & 1]);
        float r = bflo(Rr), k = bflo(Rk), v = bflo(R.v[i]); const float pm = t > 0 ? 1.f : 0.f;
        const float r1 = pm * bfhi(Rr), k1 = pm * bfhi(Rk), v1 = pm * bfhi(R.v[i]);
        r += C.mu_r * (r1 - r); k += C.mu_k * (k1 - k); v += C.mu_v * (v1 - v);
        const float wpre = C.w0c + bflo(R.wa[i]), apre = C.a0c + bfhi(R.wa[i]);
        const float decay = __expf(-0.60653066f * sigm(wpre)), a = sigm(apre);
        const float kkv = k * C.kkc, n2 = wave_sum(kkv * kkv), kk = kkv * __builtin_amdgcn_rsqf(fmaxf(n2, 1e-24f));
        const float kp = k * (1.f + (a - 1.f) * C.kac), bv = kk * a;
        const float br = wave_sum(bv * r), kr = wave_sum(kp * r), bonus = wave_sum(r * kp * C.rkc);
        L *= decay; kkA[i] = kk; rA[i] = r; nbA[i] = -bv; kpA[i] = kp; LA[i] = L;
        vbuf[tt * 64 + lane] = v;
        if (lane == 0) scl[tt] = (f32x4){-br, kr, bonus, 0.f};
        if (i & 1) __builtin_amdgcn_sched_barrier(0);
    }
    wtot[pw * 64 + lane] = L;
    asm volatile("s_waitcnt lgkmcnt(0)" ::: "memory");
    if (lane == 0) flag[pw] = seq;
    float Pw = 1.f;
    for (int ww = 0; ww < pw; ++ww) { while (flag[ww] != seq) __builtin_amdgcn_s_sleep(1);
        asm volatile("" ::: "memory"); Pw *= wtot[ww * 64 + lane]; }
    if (pw == 3) ptot[lane] = Pw * L;
    float Pprev = Pw;
#pragma unroll
    for (int i = 0; i < 8; ++i) { const int tt = 8 * pw + i; const float Pt = Pw * LA[i], ip = __builtin_amdgcn_rcpf(Pt);
        float* rc = rec + tt * SREC + (lane >> 4) * 68; const int e = lane & 15;
        *(f32x2*)(rc + 2 * e) = (f32x2){Pprev * kkA[i], Pt * rA[i]}; rc[32 + e] = nbA[i] * ip; rc[48 + e] = kpA[i] * ip;
        Pprev = Pt; }
}
__device__ __forceinline__ void scan_post(const bf16_t (&og)[8], bf16_t* dst0, const ScanC& C, int pw, int lane, const float* obuf, const float* vbuf, const f32x4* scl) {
#pragma unroll
    for (int i = 0; i < 8; ++i) { const int tt = pw + 4 * i;
        const float o = obuf[tt * 64 + lane], mean = wave_sum(o) * (1.f / 64.f), d = o - mean, var = wave_sum(d * d) * (1.f / 64.f);
        float y = d * __builtin_amdgcn_rsqf(var + 64e-5f) * C.gng + C.gnb; y += scl[tt].z * vbuf[tt * 64 + lane];
        dst0[(size_t)i * 4096] = f2bf(y * bf2f(og[i])); }
}
__device__ __forceinline__ void scan_load_ops(ScanOps& o, const f32x4* rq) {
#pragma unroll
    for (int j = 0; j < 8; ++j) o.a[j] = rq[j];
#pragma unroll
    for (int j = 0; j < 4; ++j) { o.b[j] = rq[8 + j]; o.k[j] = rq[12 + j]; }
}
__device__ __forceinline__ void scan_step(f32x2 (&S)[8], ScanOps& q, const f32x4* rn, const float v, const bool lead, const f32x2 sc, float* obuf, float* dump, int tt, int srow) {
    f32x2 vv = {v, v}; asm volatile("" : "+v"(vv));
    f32x2 d0 = S[0].x * (f32x2){q.a[0][0], q.a[0][1]}, d1 = S[0].y * (f32x2){q.a[0][2], q.a[0][3]}, d2 = S[1].x * (f32x2){q.a[1][0], q.a[1][1]}, d3 = S[1].y * (f32x2){q.a[1][2], q.a[1][3]};
#pragma unroll
    for (int j = 2; j < 8; j += 2) { d0 += S[j].x * (f32x2){q.a[j][0], q.a[j][1]}; d1 += S[j].y * (f32x2){q.a[j][2], q.a[j][3]};
        d2 += S[j + 1].x * (f32x2){q.a[j + 1][0], q.a[j + 1][1]}; d3 += S[j + 1].y * (f32x2){q.a[j + 1][2], q.a[j + 1][3]}; }
#pragma unroll
    for (int j = 0; j < 8; ++j) q.a[j] = rn[j];
    const f32x2 d = (d0 + d1) + (d2 + d3);
    float sk = d.x, o = d.y;
    sk = dpp_add<0xB1>(sk); o = dpp_add<0xB1>(o); sk = dpp_add<0x4E>(sk); o = dpp_add<0x4E>(o);
#pragma unroll
    for (int j = 0; j < 4; ++j) { S[2 * j] += sk * (f32x2){q.b[j][0], q.b[j][1]}; S[2 * j + 1] += sk * (f32x2){q.b[j][2], q.b[j][3]}; }
#pragma unroll
    for (int j = 0; j < 4; ++j) { S[2 * j] += vv * (f32x2){q.k[j][0], q.k[j][1]}; S[2 * j + 1] += vv * (f32x2){q.k[j][2], q.k[j][3]}; }
#pragma unroll
    for (int j = 0; j < 4; ++j) { q.b[j] = rn[8 + j]; q.k[j] = rn[12 + j]; }
    float* op = lead ? obuf + tt * 64 + srow : dump; *op = o + sk * sc.x + v * sc.y;
}
__device__ void phase_scan(const Params& p, unsigned char* smem) {
    const int tid = tid_opaque(), w = tid >> 6, lane = tid & 63, g = lane & 3, srow = (w & 3) * 16 + (lane >> 2), pw = w & 3;
    const bool cons = w < 4, lead = (g == 0);
    float* recb = (float*)smem;
    float* vbufb = recb + 2 * SCH * SREC;
    float* obufb = vbufb + 3 * SCH * 64;
    f32x4* sclb = (f32x4*)(obufb + 2 * SCH * 64);
    float* wtot = (float*)(sclb + 3 * SCH);
    float* ptotb = wtot + 256;
    volatile unsigned* flag = (volatile unsigned*)(ptotb + 128);
    float* dump = (float*)(ptotb + 128) + 8;
    const bf16_t* RK = (const bf16_t*)(p.ws + OFF_RKVL); const bf16_t* DW = (const bf16_t*)(p.ws + OFF_DW); const bf16_t* AP = (const bf16_t*)p.out;
    bf16_t* OGR = (bf16_t*)(p.ws + OFF_OGR);
    unsigned seq = 0;
    for (int bh = blockIdx.x; bh < 256; bh += gridDim.x) {
        const int b = bh >> 4, h = bh & 15, ch = h * 64 + lane;
        const ScanC C{p.rwkv_mu[ch], p.rwkv_mu[1024 + ch], p.rwkv_mu[2048 + ch], p.rwkv_w0[ch], p.rwkv_a0[ch], p.rwkv_k_k[ch], p.rwkv_k_a[ch], p.rwkv_r_k[ch], p.rwkv_gn_g[ch], p.rwkv_gn_b[ch]};
        f32x2 S[8];
#pragma unroll
        for (int i = 0; i < 8; ++i) S[i] = (f32x2){0.f, 0.f};
        ScanRaw R;
        if (tid < 4) flag[tid] = 0u;
        __syncthreads();
        ++seq;
        if (!cons) { scan_load_raw(R, S, RK, DW, AP, b, 0, pw, ch); scan_prep(R, S, C, 0, pw, lane, seq, recb, vbufb, sclb, wtot, ptotb, flag); scan_load_raw(R, S, RK, DW, AP, b, 1, pw, ch); }
        __syncthreads();
        for (int c = 0; c < SNCH; ++c) {
            const int cb = c & 1, c3 = c % 3, n3 = (c + 1) % 3, p3 = (c + 2) % 3;
            ++seq;
            if (cons) {
                const float* vb = vbufb + c3 * (SCH * 64); const f32x2* sc2 = (const f32x2*)(sclb + c3 * SCH); float* ob = obufb + cb * (SCH * 64);
                const f32x4* rq = (const f32x4*)(recb + cb * (SCH * SREC) + g * 68);
                ScanOps A; scan_load_ops(A, rq);
                float v0 = vb[srow]; f32x2 s0 = sc2[0];
                __builtin_amdgcn_s_setprio(3);
                for (int tt = 0; tt < SCH; ++tt) {
                    const int tn = tt + 1 < SCH ? tt + 1 : SCH - 1;
                    const float nv0 = vb[tn * 64 + srow]; const f32x2 ns0 = sc2[2 * tn];
                    scan_step(S, A, rq + tn * (SREC / 4), v0, lead, s0, ob, dump, tt, srow);
                    v0 = nv0; s0 = ns0;
                }
                __builtin_amdgcn_s_setprio(0);
                { const f32x4* pq = (const f32x4*)(ptotb + cb * 64 + g * 16);
#pragma unroll
                    for (int j = 0; j < 4; ++j) { const f32x4 pp = pq[j]; S[2 * j] *= (f32x2){pp[0], pp[1]}; S[2 * j + 1] *= (f32x2){pp[2], pp[3]}; } }
            } else {
                bf16_t og[8]; bf16_t* dst0 = OGR + ((size_t)b * SEQ + (c > 0 ? c - 1 : 0) * SCH + pw) * 1024 + ch;
#pragma unroll
                for (int i = 0; i < 8; ++i) og[i] = dst0[(size_t)i * 4096];
                if (c + 1 < SNCH) { scan_prep(R, S, C, c + 1, pw, lane, seq, recb + (cb ^ 1) * (SCH * SREC), vbufb + n3 * (SCH * 64), sclb + n3 * SCH, wtot, ptotb + (cb ^ 1) * 64, flag);
                    if (c + 2 < SNCH) scan_load_raw(R, S, RK, DW, AP, b, c + 2, pw, ch); }
                if (c > 0) scan_post(og, dst0, C, pw, lane, obufb + (cb ^ 1) * (SCH * 64), vbufb + p3 * (SCH * 64), sclb + p3 * SCH);
            }
            __syncthreads();
        }
        if (!cons) { const int cl = SNCH - 1; bf16_t og[8]; bf16_t* dst0 = OGR + ((size_t)b * SEQ + cl * SCH + pw) * 1024 + ch;
#pragma unroll
            for (int i = 0; i < 8; ++i) og[i] = dst0[(size_t)i * 4096];
            scan_post(og, dst0, C, pw, lane, obufb + (cl & 1) * (SCH * 64), vbufb + (cl % 3) * (SCH * 64), sclb + (cl % 3) * SCH); }
        __syncthreads();
    }
}
__device__ void phase_final(const Params& p) {
    const int tid = tid_opaque(), w = tid >> 6, lane = tid & 63;
    for (int tok = blockIdx.x * 8 + w; tok < T; tok += gridDim.x * 8) {
        float* xr = p.out + (size_t)tok * 1024; f32x4 v[4]; float ss = 0.f;
#pragma unroll
        for (int q = 0; q < 4; ++q) { v[q] = *(const f32x4*)(xr + q * 256 + lane * 4); ss += v[q][0] * v[q][0] + v[q][1] * v[q][1] + v[q][2] * v[q][2] + v[q][3] * v[q][3]; }
        ss = wave_sum(ss); const float rstd = rsqrtf(ss * (1.f / 1024.f) + 1e-6f);
#pragma unroll
        for (int q = 0; q < 4; ++q) { const int col = q * 256 + lane * 4; *(f32x4*)(xr + col) = v[q] * rstd * *(const f32x4*)(p.final_g + col); }
    }
}

template <int FIRST, int LAST> __global__ __launch_bounds__(512, 2) void mega(Params p) {
    extern __shared__ __attribute__((aligned(16))) unsigned char smem[];
    LAS unsigned char* lds = (LAS unsigned char*)smem;
    cg::grid_group grid = cg::this_grid();
    unsigned* bar = (unsigned*)(uniform_ptr(p.ws) + OFF_BAR);
    volatile LAS unsigned* st = (volatile LAS unsigned*)(lds + LDS_BYTES);
    if (threadIdx.x == 0) { st[0] = 0u; st[1] = 0u; (void)xb_add(&bar[XB_XCNT(xb_xcc_id())], 1u); }
    __syncthreads();
    if (p.ws == nullptr) grid.sync();
    unsigned char* ws = p.ws;
    const int G = gridDim.x, c = blockIdx.x;
    if (FIRST <= 0 && 0 < LAST) { phase_mod(p, smem); phase_weights(p, smem); }
    if (FIRST <= 1 && 1 < LAST) { if (FIRST < 1) grid_barrier(bar, st); phase_h(p); }
    if (FIRST <= 2 && 2 < LAST) { if (FIRST < 2) grid_barrier(bar, st);
        pg8::Sched1 S{T / 256, N1 / 256, G, c, (const char*)p.out, (const char*)(ws + OFF_WINT), (size_t)256 * 1024 * 2};
        EpiG1 E{ws, (unsigned char*)p.out};
        pg8::gemm_phase(lds, 1024, S, E); }
    if (FIRST <= 3 && 3 < LAST) { if (FIRST < 3) grid_barrier(bar, st); phase_conv(p, smem); }
    if (FIRST <= 4 && 4 < LAST) { if (FIRST < 4) grid_barrier(bar, st);
        pg8::Sched1 S{T / 256, 2048 / 256, G, c, (const char*)(ws + OFF_ALORA), (const char*)(ws + OFF_LBT), (size_t)256 * 128 * 2};
        EpiLora E{(bf16_t*)(ws + OFF_DW), (bf16_t*)p.out};
        pg8::gemm_phase(lds, 128, S, E); }
    if (FIRST <= 5 && 5 < LAST) { if (FIRST < 5) grid_barrier(bar, st); phase_scan(p, smem); }
    if (FIRST <= 6 && 6 < LAST) { if (FIRST < 6) grid_barrier(bar, st);
        pg8::Sched2 S{T / 256, 4, G, c, (const char*)(ws + OFF_OGC), (const char*)(ws + OFF_OGR), (const char*)(ws + OFF_W2T), (const char*)(ws + OFF_W2T + 2 * MiB), (size_t)256 * 1024 * 2};
        EpiG2 E{(const bf16_t*)(ws + OFF_GC), (const bf16_t*)((unsigned char*)p.out + 64 * MiB), (bf16_t*)(ws + OFF_M)};
        pg8::gemm_phase(lds, 1024, S, E); }
    if (FIRST <= 7 && 7 < LAST) { if (FIRST < 7) grid_barrier(bar, st);
        pg8::Sched1 S{T / 256, 4, G, c, (const char*)(ws + OFF_M), (const char*)(ws + OFF_WOT), (size_t)256 * 1024 * 2};
        EpiG3 E{p.x, (const float*)(ws + OFF_MOD), p.final_g, p.out, (float*)(ws + OFF_ROWSS), (unsigned*)(ws + OFF_PCNT)};
        pg8::gemm_phase(lds, 1024, S, E); }
}

template <int PH> static void launch_one(const Params& p, hipStream_t stream) {
    hipFuncSetAttribute((const void*)mega<PH, PH + 1>, hipFuncAttributeMaxDynamicSharedMemorySize, LDS_BYTES);
    mega<PH, PH + 1><<<256, 512, LDS_BYTES, stream>>>(p);
}

extern "C" void kernel_launch(void* const* d_in, const int* in_sizes, int n_in, void* d_out, int out_size, void* d_ws, size_t ws_size, hipStream_t stream) {
    Params p{};
    const float** f = (const float**)&p;
    for (int i = 0; i < 24; ++i) f[i] = (const float*)d_in[i];
    p.out = (float*)d_out; p.ws = (unsigned char*)d_ws;
    if (ws_size < WS_END) { fprintf(stderr, "workspace too small: %zu < %zu\n", ws_size, (size_t)WS_END); return; }
#if SINGLE_LAUNCH
    static int grid_blocks = 0;
    if (!grid_blocks) {
        int dev = 0, cus = 0, per_cu = 0;
        hipGetDevice(&dev);
        hipDeviceGetAttribute(&cus, hipDeviceAttributeMultiprocessorCount, dev);
        hipFuncSetAttribute((const void*)mega<0, NPHASE>, hipFuncAttributeMaxDynamicSharedMemorySize, LDS_BYTES + 16);
        hipOccupancyMaxActiveBlocksPerMultiprocessor(&per_cu, mega<0, NPHASE>, 512, LDS_BYTES + 16);
        grid_blocks = cus * (per_cu > 1 ? 1 : per_cu);
        if (grid_blocks > 256) grid_blocks = 256;
    }
    hipMemsetAsync((unsigned char*)d_ws + OFF_BAR, 0, 3456 * 4, stream);
    void* args[] = {(void*)&p};
    hipError_t e = hipLaunchCooperativeKernel((const void*)mega<0, NPHASE>, dim3(grid_blocks), dim3(512), args, LDS_BYTES + 16, stream);
    if (e != hipSuccess) fprintf(stderr, "cooperative launch failed: %s (grid %d)\n", hipGetErrorString(e), grid_blocks);
#else
    launch_one<0>(p, stream); launch_one<1>(p, stream); launch_one<2>(p, stream); launch_one<3>(p, stream); launch_one<4>(p, stream);
    launch_one<5>(p, stream); launch_one<6>(p, stream); launch_one<7>(p, stream); launch_one<8>(p, stream);
#endif
}
```

```cpp
#include <hip/hip_runtime.h>
#include <hip/hip_cooperative_groups.h>
#include <cstdio>
namespace cg = cooperative_groups;

#ifndef SINGLE_LAUNCH
#define SINGLE_LAUNCH 1
#endif

#define LAS __attribute__((address_space(3)))
#define GAS __attribute__((address_space(1)))
typedef unsigned short bf16_t;
typedef short bf16x8 __attribute__((ext_vector_type(8)));
typedef float f32x8 __attribute__((ext_vector_type(8)));
typedef float f32x4 __attribute__((ext_vector_type(4)));
typedef float f32x2 __attribute__((ext_vector_type(2)));
typedef unsigned u32x4 __attribute__((ext_vector_type(4)));
typedef unsigned u32x2 __attribute__((ext_vector_type(2)));

constexpr int T = 32768, DM = 1024, SEQ = 2048, NB_ = 16;
constexpr int N1 = 9472;
constexpr int LDR = 3328;
constexpr int LDS_BYTES = 131072;
constexpr int NPHASE = 9;

constexpr size_t MiB = 1u << 20;
constexpr size_t OFF_U = 0, OFF_OGC = 64 * MiB, OFF_RKVL = 128 * MiB, OFF_OGR = 336 * MiB, OFF_GC = 400 * MiB, OFF_WINT = 464 * MiB;
constexpr size_t OFF_ALORA = OFF_WINT + (size_t)N1 * 1024 * 2;
constexpr size_t OFF_W2T = OFF_ALORA + 16 * MiB, OFF_WOT = OFF_W2T + 4 * MiB, OFF_LBT = OFF_WOT + 2 * MiB, OFF_MOD = OFF_LBT + 1 * MiB;
constexpr size_t OFF_BAR = OFF_MOD + 16 * 3072 * 4;
constexpr size_t OFF_ROWSS = OFF_BAR + 3456 * 4 + 128;
constexpr size_t OFF_PCNT = OFF_ROWSS + (size_t)T * 4;
constexpr size_t WS_END = OFF_PCNT + 256 * 4;
constexpr size_t OFF_MP = OFF_RKVL, OFF_M = OFF_RKVL + 128 * MiB, OFF_DW = OFF_U;

struct Params {
    const float *x, *c, *ada_w, *ada_b, *norm_g, *w_in, *conv_k, *conv_b, *conv_ln_g, *conv_ln_b, *w_conv_out, *rwkv_mu, *rwkv_w0, *rwkv_w2, *rwkv_a0, *rwkv_a2,
        *rwkv_k_k, *rwkv_k_a, *rwkv_r_k, *rwkv_gn_g, *rwkv_gn_b, *w_rwkv_out, *w_out, *final_g;
    float* out;
    unsigned char* ws;
};

typedef __bf16 bf16x2_t __attribute__((ext_vector_type(2)));
__device__ __forceinline__ unsigned cvt_pk_bf16(float lo, float hi) { const bf16x2_t r = __builtin_convertvector((f32x2){lo, hi}, bf16x2_t); return __builtin_bit_cast(unsigned, r); }
__device__ __forceinline__ bf16_t f2bf(float f) { return (bf16_t)(cvt_pk_bf16(f, 0.f) & 0xffffu); }
__device__ __forceinline__ float bf2f(bf16_t b) { return __uint_as_float(((unsigned)b) << 16); }
__device__ __forceinline__ float bflo(unsigned v) { return __uint_as_float(v << 16); }
__device__ __forceinline__ float bfhi(unsigned v) { return __uint_as_float(v & 0xffff0000u); }
__device__ __forceinline__ float sigm(float x) { return __builtin_amdgcn_rcpf(1.f + __expf(-x)); }
__device__ __forceinline__ int tid_opaque() { int t = threadIdx.x; asm volatile("" : "+v"(t)); return t; }
__device__ __forceinline__ unsigned char* uniform_ptr(unsigned char* p) { const size_t v = (size_t)p; const unsigned lo = __builtin_amdgcn_readfirstlane((unsigned)v), hi = __builtin_amdgcn_readfirstlane((unsigned)(v >> 32)); return (unsigned char*)(((size_t)hi << 32) | lo); }
template <int CTRL> __device__ __forceinline__ float dpp_add(float v) { return v + __int_as_float(__builtin_amdgcn_update_dpp(0, __float_as_int(v), CTRL, 0xF, 0xF, true)); }
__device__ __forceinline__ float wave_sum(float v) {
    v = dpp_add<0xB1>(v); v = dpp_add<0x4E>(v); v = dpp_add<0x141>(v); v = dpp_add<0x140>(v);
    const int iv = __float_as_int(v);
    return (__int_as_float(__builtin_amdgcn_readlane(iv, 0)) + __int_as_float(__builtin_amdgcn_readlane(iv, 16))) + (__int_as_float(__builtin_amdgcn_readlane(iv, 32)) + __int_as_float(__builtin_amdgcn_readlane(iv, 48)));
}

#define XB_TMO      128
#define XB_XCNT(j)  (256  + 64 * (j))
#define XB_XSUB(j)  (1280 + 64 * (j))
#define XB_XGEN(j)  (2304 + 64 * (j))
#define XB_TOP      3328
#define XB_TOPGEN   3392
#define XB_WORDS    3456
#define XB_SPIN_CAP (1u << 22)
__device__ __forceinline__ unsigned xb_ld(unsigned* p)              { return __hip_atomic_load(p, __ATOMIC_RELAXED, __HIP_MEMORY_SCOPE_AGENT); }
__device__ __forceinline__ unsigned xb_add(unsigned* p, unsigned v) { return __hip_atomic_fetch_add(p, v, __ATOMIC_RELAXED, __HIP_MEMORY_SCOPE_AGENT); }
__device__ __forceinline__ unsigned xb_xcc_id() { return (unsigned)__builtin_amdgcn_s_getreg((3 << 11) | 20) & 0xFu; }
#define XB_SPIN(cond, bar) do { unsigned _sp = 0; while (cond) { __builtin_amdgcn_s_sleep(1); \
    if ((++_sp & 255u) == 0u) { if (xb_ld(&(bar)[XB_TMO])) break; if (_sp > XB_SPIN_CAP) { atomicAdd(&(bar)[XB_TMO], 1u); break; } } } } while (0)
__device__ __forceinline__ void xcd_barrier_complete(unsigned* bar, unsigned x, unsigned& nloc, unsigned& nx) {
    const unsigned G = gridDim.x; unsigned sum, cnt, mine, sp = 0u;
    for (;;) { sum = 0u; cnt = 0u; mine = 0u;
#pragma unroll
        for (unsigned j = 0; j < 16; ++j) { const unsigned c = xb_ld(&bar[XB_XCNT(j)]); sum += c; cnt += (c > 0u) ? 1u : 0u; mine = (j == x) ? c : mine; }
        if (sum == G) break;
        __builtin_amdgcn_s_sleep(1);
        if ((++sp & 255u) == 0u) { if (xb_ld(&bar[XB_TMO])) break; if (sp > XB_SPIN_CAP) { atomicAdd(&bar[XB_TMO], 1u); break; } } }
    nloc = mine > 0u ? mine : 1u; nx = cnt > 0u ? cnt : 1u;
}
__device__ __forceinline__ void grid_barrier(unsigned* bar, volatile LAS unsigned* st) {
    asm volatile("s_waitcnt vmcnt(0) lgkmcnt(0)" ::: "memory");
    __syncthreads();
    if (threadIdx.x == 0) {
        const unsigned x = xb_xcc_id();
        unsigned nloc = st[0], nx = st[1];
        if (nloc == 0u) { xcd_barrier_complete(bar, x, nloc, nx); st[0] = nloc; st[1] = nx; }
        const unsigned old = xb_add(&bar[XB_XSUB(x)], 1u);
        const unsigned gen = old / nloc;
        if (old + 1u == (gen + 1u) * nloc) {
            __builtin_amdgcn_fence(__ATOMIC_RELEASE, "agent");
            asm volatile("s_waitcnt vmcnt(0)" ::: "memory");
            const unsigned og = xb_add(&bar[XB_TOP], 1u);
            const unsigned tg = og / nx;
            if (og + 1u == (tg + 1u) * nx) xb_add(&bar[XB_TOPGEN], 1u);
            else XB_SPIN(xb_ld(&bar[XB_TOPGEN]) == tg, bar);
            __builtin_amdgcn_fence(__ATOMIC_ACQUIRE, "agent");
            xb_add(&bar[XB_XGEN(x)], 1u);
            asm volatile("s_waitcnt vmcnt(0)" ::: "memory");
        } else {
            XB_SPIN(xb_ld(&bar[XB_XGEN(x)]) == gen, bar);
            __builtin_amdgcn_fence(__ATOMIC_ACQUIRE, "agent");
            asm volatile("s_waitcnt vmcnt(0)" ::: "memory");
        }
    }
    __syncthreads();
}

namespace pg8 {
constexpr int BM = 256, BK = 64, HALF = 128, HTB = HALF * BK * 2, NXCD = 8, WGM = 8;
__host__ __device__ __forceinline__ int lds_byte(int r, int c) { const int st = (r >> 4) * 2 + (c >> 5), rr = r & 15, cc = c & 31, ob = rr * 64 + cc * 2; return st * 1024 + (ob ^ (((ob >> 9) & 1) << 5)); }
__host__ __device__ __forceinline__ void stage_rc(int b, int& R, int& C) { const int st = b / 1024, sb = b % 1024, swz = sb ^ (((sb >> 9) & 1) << 5); R = (st >> 1) * 16 + swz / 64; C = (st & 1) * 32 + (swz % 64) / 2; }
__host__ __device__ __forceinline__ int perm32(int rho) { const int n = rho >> 4, i = rho & 15; return 8 * (i >> 2) + 4 * n + (i & 3); }
struct Unit { int pm, pn, kind; };

__device__ __forceinline__ void map_unit(int L, int nM, int nN, Unit& u) {
    const int nwg = nM * nN; int wgid = L;
    { const int q = nwg / NXCD, r = nwg % NXCD, xcd = wgid % NXCD, off = wgid / NXCD; wgid = (xcd < r ? xcd * (q + 1) : r * (q + 1) + (xcd - r) * q) + off; }
    const int nig = WGM * nN, gid = wgid / nig, fm = gid * WGM, gsz = (nM - fm) < WGM ? (nM - fm) : WGM;
    u.pm = fm + ((wgid % nig) % gsz); u.pn = (wgid % nig) / gsz;
}
struct Sched1 {
    int nM, nN, G, c; const char* A; const char* Bt; size_t tstep;
    __device__ __forceinline__ bool next(int i, Unit& u) const { const long L = (long)i * G + c; if (L >= (long)nM * nN) return false; map_unit((int)L, nM, nN, u); u.kind = 0; return true; }
    __device__ __forceinline__ const char* aptr(const Unit& u) const { return A + (size_t)u.pm * tstep; }
    __device__ __forceinline__ const char* bptr(const Unit& u) const { return Bt + (size_t)u.pn * tstep; }
};
struct Sched2 {
    int nM, nN, G, c; const char* A0; const char* A1; const char* B0; const char* B1; size_t tstep;
    __device__ __forceinline__ bool next(int i, Unit& u) const { const long L = (long)(i >> 1) * G + c; if (L >= (long)nM * nN) return false; map_unit((int)L, nM, nN, u); u.kind = i & 1; return true; }
    __device__ __forceinline__ const char* aptr(const Unit& u) const { return (u.kind ? A1 : A0) + (size_t)u.pm * tstep; }
    __device__ __forceinline__ const char* bptr(const Unit& u) const { return (u.kind ? B1 : B0) + (size_t)u.pn * tstep; }
};

template <class Epi, class Sched>
__device__ __forceinline__ void gemm_phase(LAS unsigned char* lds, const int K, const Sched& S, const Epi& E) {
    const int tid = tid_opaque(), wid = __builtin_amdgcn_readfirstlane(tid >> 6), lane = tid & 63, wr = wid >> 2, wc = wid & 3, fr = lane & 15, fq = lane >> 4;
    const int nt = K / BK;
    unsigned voffA[2], voffB[2];
#pragma unroll
    for (int i = 0; i < 2; ++i) { int R, C; stage_rc(tid * 16 + i * 8192, R, C); const int Rb = Epi::PERM ? ((R & ~31) + perm32(R & 31)) : R;
        voffA[i] = (unsigned)(R * K + C) * 2u; voffB[i] = (unsigned)(Rb * K + C) * 2u; }
    const size_t kstep = (size_t)(BK * 2);
    const size_t hstep = (size_t)HALF * K * 2;
    const unsigned ldsw = (unsigned)wid * 1024u;
    const int aoff = lds_byte(wr * 64 + fr, fq * 8), boff = lds_byte(wc * 32 + fr, fq * 8);
#define PG8_SA(b, h) (((b) * 2 + (h)) * HTB)
#define PG8_SB(b, h) ((4 + (b) * 2 + (h)) * HTB)
#define PG8_STAGE(bufoff, gbase, voff) do { _Pragma("unroll") for (int _i = 0; _i < 2; ++_i) \
        __builtin_amdgcn_global_load_lds((const unsigned*)((const char*)(gbase) + (voff)[_i]), (LAS unsigned*)(lds + (bufoff) + ldsw + _i * 8192), 16, 0, 0); } while (0)
#define PG8_LDA(dst, b, h) do { _Pragma("unroll") for (int m = 0; m < 4; ++m) _Pragma("unroll") for (int k = 0; k < 2; ++k) dst[m][k] = *(const LAS bf16x8*)(lds + PG8_SA(b, h) + aoff + m * 2048 + k * 1024); } while (0)
#define PG8_LDB(dst, b, h) do { _Pragma("unroll") for (int n = 0; n < 2; ++n) _Pragma("unroll") for (int k = 0; k < 2; ++k) dst[n][k] = *(const LAS bf16x8*)(lds + PG8_SB(b, h) + boff + n * 2048 + k * 1024); } while (0)
#define PG8_MMA(ai, bj, At, Bt) do { __builtin_amdgcn_s_setprio(1); _Pragma("unroll") for (int m = 0; m < 4; ++m) _Pragma("unroll") for (int n = 0; n < 2; ++n) _Pragma("unroll") for (int k = 0; k < 2; ++k) \
        acc[ai][bj][m][n] = __builtin_amdgcn_mfma_f32_16x16x32_bf16(Bt[n][k], At[m][k], acc[ai][bj][m][n], 0, 0, 0); __builtin_amdgcn_s_setprio(0); } while (0)
#define PG8_WAIT_V(n) asm volatile("s_waitcnt vmcnt(" #n ")" ::: "memory")
#define PG8_WAIT_L(n) asm volatile("s_waitcnt lgkmcnt(" #n ")" ::: "memory")
#define PG8_BAR __builtin_amdgcn_s_barrier()
#define PG8_SCHED __builtin_amdgcn_sched_barrier(0)
    Unit cur, nxt; int ui = 0;
    if (!S.next(0, cur)) return;
    f32x4 acc[2][2][4][2];
#pragma unroll
    for (int a = 0; a < 2; ++a)
#pragma unroll
        for (int b = 0; b < 2; ++b)
#pragma unroll
            for (int m = 0; m < 4; ++m)
#pragma unroll
                for (int n = 0; n < 2; ++n) acc[a][b][m][n] = (f32x4){0.f, 0.f, 0.f, 0.f};
    bf16x8 At[4][2], B0[2][2], B1[2][2];
    const char* cA = S.aptr(cur); const char* cB = S.bptr(cur);
    PG8_STAGE(PG8_SB(0, 0), cB, voffB); PG8_STAGE(PG8_SA(0, 0), cA, voffA); PG8_STAGE(PG8_SB(0, 1), cB + hstep, voffB); PG8_STAGE(PG8_SA(0, 1), cA + hstep, voffA);
    if (wr == 1) PG8_BAR;
    PG8_WAIT_V(4); PG8_BAR;
    PG8_STAGE(PG8_SB(1, 0), cB + kstep, voffB); PG8_STAGE(PG8_SA(1, 0), cA + kstep, voffA); PG8_STAGE(PG8_SB(1, 1), cB + hstep + kstep, voffB);
    PG8_WAIT_V(6); PG8_BAR;
    for (;;) {
        const bool has_next = S.next(ui + 1, nxt);
        const char* nA = has_next ? S.aptr(nxt) : cA; const char* nB = has_next ? S.bptr(nxt) : cB;
        for (int t = 0; t < nt; t += 2) {
            const bool last = (t == nt - 2);
            const char* a1 = cA + (size_t)(t + 1) * kstep;
            const char* a2 = last ? nA : cA + (size_t)(t + 2) * kstep; const char* b2 = last ? nB : cB + (size_t)(t + 2) * kstep;
            const char* a3 = a2 + kstep; const char* b3 = b2 + kstep;
            PG8_LDB(B0, 0, 0); PG8_SCHED; PG8_LDA(At, 0, 0); PG8_STAGE(PG8_SA(1, 1), a1 + hstep, voffA);
            PG8_WAIT_L(8); PG8_BAR; PG8_WAIT_L(0); PG8_MMA(0, 0, At, B0); PG8_BAR; PG8_SCHED;
            PG8_LDB(B1, 0, 1); PG8_STAGE(PG8_SB(0, 0), b2, voffB);
            PG8_BAR; PG8_WAIT_L(0); PG8_MMA(0, 1, At, B1); PG8_BAR;
            PG8_LDA(At, 0, 1); PG8_STAGE(PG8_SA(0, 0), a2, voffA);
            PG8_BAR; PG8_WAIT_L(0); PG8_MMA(1, 0, At, B0); PG8_BAR; PG8_SCHED;
            PG8_STAGE(PG8_SB(0, 1), b2 + hstep, voffB);
            PG8_WAIT_V(6); PG8_BAR; PG8_MMA(1, 1, At, B1); PG8_BAR;
            PG8_LDB(B0, 1, 0); PG8_SCHED; PG8_LDA(At, 1, 0); PG8_STAGE(PG8_SA(0, 1), a2 + hstep, voffA);
            PG8_WAIT_L(8); PG8_BAR; PG8_WAIT_L(0); PG8_MMA(0, 0, At, B0); PG8_BAR; PG8_SCHED;
            PG8_LDB(B1, 1, 1); PG8_STAGE(PG8_SB(1, 0), b3, voffB);
            PG8_BAR; PG8_WAIT_L(0); PG8_MMA(0, 1, At, B1); PG8_BAR;
            PG8_LDA(At, 1, 1); PG8_STAGE(PG8_SA(1, 0), a3, voffA);
            PG8_BAR; PG8_WAIT_L(0); PG8_MMA(1, 0, At, B0); PG8_BAR; PG8_SCHED;
            PG8_STAGE(PG8_SB(1, 1), b3 + hstep, voffB);
            PG8_WAIT_V(6); PG8_BAR; PG8_MMA(1, 1, At, B1); PG8_BAR;
        }
        E(acc, cur, wr, wc, fr, fq);
        if (!has_next) break;
        if (!E.keep(cur)) {
#pragma unroll
        for (int a = 0; a < 2; ++a)
#pragma unroll
            for (int b = 0; b < 2; ++b)
#pragma unroll
                for (int m = 0; m < 4; ++m)
#pragma unroll
                    for (int n = 0; n < 2; ++n) acc[a][b][m][n] = (f32x4){0.f, 0.f, 0.f, 0.f};
        }
        cur = nxt; cA = nA; cB = nB; ++ui;
    }
    PG8_WAIT_V(0);
    if (wr == 0) PG8_BAR;
    PG8_BAR;
#undef PG8_SA
#undef PG8_SB
#undef PG8_STAGE
#undef PG8_LDA
#undef PG8_LDB
#undef PG8_MMA
#undef PG8_WAIT_V
#undef PG8_WAIT_L
#undef PG8_BAR
#undef PG8_SCHED
}
}
using pg8::Unit;

template <int ACT> __device__ __forceinline__ float actf(float v) { return ACT == 1 ? v * sigm(v) : (ACT == 2 ? sigm(v) : v); }
template <int ACT> __device__ __forceinline__ void store_tile_bf16(const f32x4 (&acc)[2][2][4][2], bf16_t* base  , int ld) {
#pragma unroll
    for (int ai = 0; ai < 2; ++ai)
#pragma unroll
        for (int m = 0; m < 4; ++m) { bf16_t* rowp = base + (size_t)(ai * 128 + m * 16) * ld;
#pragma unroll
            for (int bj = 0; bj < 2; ++bj) { const f32x4 v0 = acc[ai][bj][m][0], v1 = acc[ai][bj][m][1]; u32x4 w;
                w.x = cvt_pk_bf16(actf<ACT>(v0[0]), actf<ACT>(v0[1])); w.y = cvt_pk_bf16(actf<ACT>(v0[2]), actf<ACT>(v0[3]));
                w.z = cvt_pk_bf16(actf<ACT>(v1[0]), actf<ACT>(v1[1])); w.w = cvt_pk_bf16(actf<ACT>(v1[2]), actf<ACT>(v1[3]));
                *(GAS u32x4*)(rowp + bj * 128) = w; } }
}
struct EpiG1 {
    static constexpr bool PERM = true;
    __device__ __forceinline__ bool keep(const Unit&) const { return false; }
    unsigned char *ws, *outb;
    __device__ __forceinline__ void operator()(const f32x4 (&acc)[2][2][4][2], const Unit& u, int wr, int wc, int fr, int fq) const {
        unsigned char* w = uniform_ptr(ws); unsigned char* ob = uniform_ptr(outb); asm volatile("" : "+s"(w), "+s"(ob));
        const int row0 = u.pm * 256 + wr * 64 + fr, pn = u.pn, cw = wc * 32 + 8 * fq;
        if (pn < 8) {
            bf16_t* base = (bf16_t*)(w + OFF_U) + (size_t)row0 * 1024 + pn * 128 + cw;
#pragma unroll
            for (int ai = 0; ai < 2; ++ai)
#pragma unroll
                for (int m = 0; m < 4; ++m) { const f32x4 a0 = acc[ai][0][m][0], a1 = acc[ai][0][m][1], g0 = acc[ai][1][m][0], g1 = acc[ai][1][m][1]; u32x4 wv;
                    wv.x = cvt_pk_bf16(a0[0] * sigm(g0[0]), a0[1] * sigm(g0[1])); wv.y = cvt_pk_bf16(a0[2] * sigm(g0[2]), a0[3] * sigm(g0[3]));
                    wv.z = cvt_pk_bf16(a1[0] * sigm(g1[0]), a1[1] * sigm(g1[1])); wv.w = cvt_pk_bf16(a1[2] * sigm(g1[2]), a1[3] * sigm(g1[3]));
                    *(GAS u32x4*)(base + (size_t)(ai * 128 + m * 16) * 1024) = wv; }
        } else if (pn < 12) store_tile_bf16<1>(acc, (bf16_t*)(w + OFF_OGC) + (size_t)row0 * 1024 + (pn - 8) * 256 + cw, 1024);
        else if (pn < 25) store_tile_bf16<0>(acc, (bf16_t*)(w + OFF_RKVL) + (size_t)row0 * LDR + (pn - 12) * 256 + cw, LDR);
        else if (pn < 29) store_tile_bf16<1>(acc, (bf16_t*)(w + OFF_OGR) + (size_t)row0 * 1024 + (pn - 25) * 256 + cw, 1024);
        else if (pn < 33) store_tile_bf16<2>(acc, (bf16_t*)(w + OFF_GC) + (size_t)row0 * 1024 + (pn - 29) * 256 + cw, 1024);
        else store_tile_bf16<2>(acc, (bf16_t*)(ob + 64 * MiB) + (size_t)row0 * 1024 + (pn - 33) * 256 + cw, 1024);
    }
};
struct EpiLora {
    static constexpr bool PERM = true;
    __device__ __forceinline__ bool keep(const Unit&) const { return false; }
    bf16_t *DW, *AP;
    __device__ __forceinline__ void operator()(const f32x4 (&acc)[2][2][4][2], const Unit& u, int wr, int wc, int fr, int fq) const {
        const int row0 = u.pm * 256 + wr * 64 + fr, cw = wc * 32 + 8 * fq;
        bf16_t* base = (u.pn < 4 ? DW + (size_t)u.pn * 256 : AP + (size_t)(u.pn - 4) * 256) + (size_t)row0 * 1024 + cw;
        store_tile_bf16<0>(acc, base, 1024);
    }
};
struct EpiG2 {
    static constexpr bool PERM = true;
    const bf16_t *GC, *GR; bf16_t* M;
    __device__ __forceinline__ bool keep(const Unit& u) const { return u.kind == 0; }
    __device__ __forceinline__ void operator()(f32x4 (&acc)[2][2][4][2], const Unit& u, int wr, int wc, int fr, int fq) const {
        const size_t off0 = (size_t)(u.pm * 256 + wr * 64 + fr) * 1024 + u.pn * 256 + wc * 32 + 8 * fq;
#pragma unroll
        for (int ai = 0; ai < 2; ++ai)
#pragma unroll
            for (int m = 0; m < 4; ++m)
#pragma unroll
                for (int bj = 0; bj < 2; ++bj) { const size_t off = off0 + (size_t)(ai * 128 + m * 16) * 1024 + bj * 128;
                    const u32x4 gr = *(const GAS u32x4*)(GR + off); f32x4& v0 = acc[ai][bj][m][0]; f32x4& v1 = acc[ai][bj][m][1];
                    const f32x4 r0 = {bflo(gr.x), bfhi(gr.x), bflo(gr.y), bfhi(gr.y)}, r1 = {bflo(gr.z), bfhi(gr.z), bflo(gr.w), bfhi(gr.w)};
                    if (u.kind == 0) { const u32x4 gc = *(const GAS u32x4*)(GC + off);
                        const f32x4 c0 = {bflo(gc.x), bfhi(gc.x), bflo(gc.y), bfhi(gc.y)}, c1 = {bflo(gc.z), bfhi(gc.z), bflo(gc.w), bfhi(gc.w)};
#pragma unroll
                        for (int j = 0; j < 4; ++j) { v0[j] *= c0[j] * __builtin_amdgcn_rcpf(fmaxf(r0[j], 1e-30f)); v1[j] *= c1[j] * __builtin_amdgcn_rcpf(fmaxf(r1[j], 1e-30f)); }
                    } else { const f32x4 m0 = v0 * r0, m1 = v1 * r1; u32x4 w;
                        w.x = cvt_pk_bf16(m0[0], m0[1]); w.y = cvt_pk_bf16(m0[2], m0[3]); w.z = cvt_pk_bf16(m1[0], m1[1]); w.w = cvt_pk_bf16(m1[2], m1[3]);
                        *(GAS u32x4*)(M + off) = w; } }
    }
};
struct EpiG3 {
    static constexpr bool PERM = false;
    const float *x, *mod, *fg; float* out; float* rowss; unsigned* pcnt;
    __device__ __forceinline__ bool keep(const Unit&) const { return false; }
    __device__ __forceinline__ void operator()(f32x4 (&acc)[2][2][4][2], const Unit& u, int wr, int wc, int fr, int fq) const {
        const int col0 = u.pn * 256 + wc * 32 + 4 * fq, row0 = u.pm * 256 + wr * 64 + fr; const size_t off0 = (size_t)row0 * 1024 + col0;
        const float* gp = mod + (size_t)(u.pm >> 3) * 3072 + 2048 + col0;
        { f32x4 gv[2][2];
#pragma unroll
        for (int bj = 0; bj < 2; ++bj)
#pragma unroll
            for (int n = 0; n < 2; ++n) gv[bj][n] = *(const GAS f32x4*)(gp + bj * 128 + n * 16);
#pragma unroll
        for (int ai = 0; ai < 2; ++ai)
#pragma unroll
            for (int m = 0; m < 4; ++m) { float ps = 0.f;
#pragma unroll
                for (int bj = 0; bj < 2; ++bj)
#pragma unroll
                    for (int n = 0; n < 2; ++n) { const size_t off = off0 + (size_t)(ai * 128 + m * 16) * 1024 + bj * 128 + n * 16;
                        const f32x4 v = *(const GAS f32x4*)(x + off) + gv[bj][n] * acc[ai][bj][m][n]; acc[ai][bj][m][n] = v; ps += v[0] * v[0] + v[1] * v[1] + v[2] * v[2] + v[3] * v[3]; }
                ps += __shfl_xor(ps, 16); ps += __shfl_xor(ps, 32);
                if (fq == 0) __hip_atomic_fetch_add(rowss + row0 + ai * 128 + m * 16, ps, __ATOMIC_RELAXED, __HIP_MEMORY_SCOPE_AGENT); } }
        asm volatile("s_waitcnt vmcnt(0)" ::: "memory");
        unsigned* pc = pcnt + u.pm * 2 + wr;
        if (fr == 0 && fq == 0) __hip_atomic_fetch_add(pc, 1u, __ATOMIC_RELAXED, __HIP_MEMORY_SCOPE_AGENT);
        { unsigned sp = 0; while (__hip_atomic_load(pc, __ATOMIC_RELAXED, __HIP_MEMORY_SCOPE_AGENT) < 16u && ++sp < (1u << 22)) __builtin_amdgcn_s_sleep(1); }
#pragma unroll
        for (int ai = 0; ai < 2; ++ai)
#pragma unroll
            for (int m = 0; m < 4; ++m) { const float ss = __hip_atomic_load(rowss + row0 + ai * 128 + m * 16, __ATOMIC_RELAXED, __HIP_MEMORY_SCOPE_AGENT);
                const float rstd = __builtin_amdgcn_rsqf(ss * (1.f / 1024.f) + 1e-6f);
#pragma unroll
                for (int bj = 0; bj < 2; ++bj)
#pragma unroll
                    for (int n = 0; n < 2; ++n) { const size_t off = off0 + (size_t)(ai * 128 + m * 16) * 1024 + bj * 128 + n * 16;
                        *(GAS f32x4*)(out + off) = acc[ai][bj][m][n] * rstd * *(const GAS f32x4*)(fg + col0 + bj * 128 + n * 16); } }
    }
};

__device__ void phase_mod(const Params& p, unsigned char* smem) {
    if (blockIdx.x >= 48) return;
    float* sc = (float*)smem;
    float* red = sc + 16384;
    const int tid = tid_opaque(), w = tid >> 6, lane = tid & 63;
    for (int i = tid; i < 16384; i += 512) { const int b = i >> 10, d = i & 1023; const float cv = p.c[i]; sc[d * 16 + b] = cv * sigm(cv); }
    __syncthreads();
    const int e = blockIdx.x * 64 + lane;
    float acc[16];
#pragma unroll
    for (int b = 0; b < 16; ++b) acc[b] = 0.f;
    for (int d0 = w * 128; d0 < w * 128 + 128; d0 += 16) {
        float wvs[16];
#pragma unroll
        for (int u = 0; u < 16; ++u) wvs[u] = p.ada_w[(size_t)(d0 + u) * 3072 + e];
#pragma unroll
        for (int u = 0; u < 16; ++u) { const int d = d0 + u; const float wv = wvs[u];
        const f32x4* s4 = (const f32x4*)(sc + d * 16);
#pragma unroll
        for (int q = 0; q < 4; ++q) { const f32x4 s = s4[q]; acc[4 * q] += s[0] * wv; acc[4 * q + 1] += s[1] * wv; acc[4 * q + 2] += s[2] * wv; acc[4 * q + 3] += s[3] * wv; }
        }
    }
#pragma unroll
    for (int b = 0; b < 16; ++b) red[(w * 16 + b) * 64 + lane] = acc[b];
    __syncthreads();
    float* mod = (float*)(p.ws + OFF_MOD);
    for (int i = tid; i < 1024; i += 512) { const int b = i >> 6, l = i & 63; float s = 0.f;
#pragma unroll
        for (int ww = 0; ww < 8; ++ww) s += red[(ww * 16 + b) * 64 + l];
        mod[b * 3072 + blockIdx.x * 64 + l] = s + p.ada_b[blockIdx.x * 64 + l]; }
    __syncthreads();
}
__device__ __forceinline__ void transpose_tile(const float* src, int ld, int n_src0, int k0, bf16_t* dst, int n_dst0, float* tile) {
    const int tid = tid_opaque();
#pragma unroll
    for (int r = 0; r < 2; ++r) { const int i = (tid >> 4) + 32 * r, j4 = (tid & 15) * 4;
        f32x4 v = {0.f, 0.f, 0.f, 0.f}; if (n_src0 >= 0) v = *(const f32x4*)(src + (size_t)(k0 + i) * ld + n_src0 + j4);
        tile[i * 65 + j4] = v[0]; tile[i * 65 + j4 + 1] = v[1]; tile[i * 65 + j4 + 2] = v[2]; tile[i * 65 + j4 + 3] = v[3]; }
    __syncthreads();
    const int j = tid >> 3, i8 = (tid & 7) * 8; u32x4 w;
    w.x = cvt_pk_bf16(tile[(i8 + 0) * 65 + j], tile[(i8 + 1) * 65 + j]); w.y = cvt_pk_bf16(tile[(i8 + 2) * 65 + j], tile[(i8 + 3) * 65 + j]);
    w.z = cvt_pk_bf16(tile[(i8 + 4) * 65 + j], tile[(i8 + 5) * 65 + j]); w.w = cvt_pk_bf16(tile[(i8 + 6) * 65 + j], tile[(i8 + 7) * 65 + j]);
    *(u32x4*)(dst + (size_t)(n_dst0 + j) * 1024 + k0 + i8) = w;
    __syncthreads();
}
__device__ void phase_weights(const Params& p, unsigned char* smem) {
    float* tile = (float*)smem;
    for (int i = blockIdx.x * 512 + threadIdx.x; i < T + 256; i += gridDim.x * 512) ((unsigned*)(p.ws + OFF_ROWSS))[i] = 0u;
    bf16_t* WinT = (bf16_t*)(p.ws + OFF_WINT); bf16_t* W2T = (bf16_t*)(p.ws + OFF_W2T); bf16_t* WoT = (bf16_t*)(p.ws + OFF_WOT); bf16_t* LBt = (bf16_t*)(p.ws + OFF_LBT);
    constexpr int NT1 = (N1 / 64) * 16;
    const bool bal = (gridDim.x == 256); const int nb = blockIdx.x;
    const int first = bal ? (nb >= 48 ? nb - 48 : 2704 + nb) : nb, stride = bal ? (nb >= 48 ? 208 : 48) : (int)gridDim.x, last = bal ? (nb >= 48 ? 2704 : 3136) : NT1 + 768;
    for (int idx = first; idx < last; idx += stride) {
        if (idx < NT1) { const int a = idx >> 4, kt = idx & 15, n0 = a * 64; int src;
            if (n0 < 2048) { const int j = n0 >> 8, wi = n0 & 255; src = wi < 128 ? 128 * j + wi : 1024 + 128 * j + wi - 128; }
            else if (n0 < 6272) src = n0; else if (n0 < 6400) src = -1; else src = n0 - 128;
            transpose_tile(p.w_in, 9344, src, kt * 64, WinT, n0, tile);
        } else { const int r = idx - NT1, which = r >> 8, a = (r >> 4) & 15, kt = r & 15;
            const float* src = which == 0 ? p.w_conv_out : (which == 1 ? p.w_rwkv_out : p.w_out);
            bf16_t* dst = which == 0 ? W2T : (which == 1 ? W2T + (size_t)1024 * 1024 : WoT);
            transpose_tile(src, 1024, a * 64, kt * 64, dst, a * 64, tile); }
    }
    for (int idx = blockIdx.x * 512 + tid_opaque(); idx < 2048 * 128; idx += gridDim.x * 512) { const int n = idx >> 7, k = idx & 127; float v = 0.f;
        if (n < 1024) { if (k < 64) v = p.rwkv_w2[k * 1024 + n]; } else { if (k >= 64) v = p.rwkv_a2[(k - 64) * 1024 + n - 1024]; }
        LBt[idx] = f2bf(v); }
}
__device__ void phase_h(const Params& p) {
    const int tid = tid_opaque(), w = tid >> 6, lane = tid & 63;
    const float* mod = (const float*)(p.ws + OFF_MOD); bf16_t* Hh = (bf16_t*)p.out;
    for (int tok = blockIdx.x * 8 + w; tok < T; tok += gridDim.x * 8) {
        const int b = tok >> 11; const float* xr = p.x + (size_t)tok * 1024; f32x4 v[4]; float ss = 0.f;
#pragma unroll
        for (int q = 0; q < 4; ++q) { v[q] = *(const f32x4*)(xr + q * 256 + lane * 4); ss += v[q][0] * v[q][0] + v[q][1] * v[q][1] + v[q][2] * v[q][2] + v[q][3] * v[q][3]; }
        ss = wave_sum(ss); const float rstd = rsqrtf(ss * (1.f / 1024.f) + 1e-6f);
#pragma unroll
        for (int q = 0; q < 4; ++q) { const int col = q * 256 + lane * 4; const f32x4 g = *(const f32x4*)(p.norm_g + col), sh = *(const f32x4*)(mod + b * 3072 + col), sc = *(const f32x4*)(mod + b * 3072 + 1024 + col);
            const f32x4 y = v[q] * rstd * g * (sc + 1.f) + sh; u32x2 o; o.x = cvt_pk_bf16(y[0], y[1]); o.y = cvt_pk_bf16(y[2], y[3]);
            *(u32x2*)(Hh + (size_t)tok * 1024 + col) = o; }
    }
}
__device__ void phase_conv(const Params& p, unsigned char* smem) {
    const int tid = tid_opaque(), w = tid >> 6, lane = tid & 63, c0 = tid * 2;
    const bf16_t* U = (const bf16_t*)(p.ws + OFF_U); bf16_t* OGC = (bf16_t*)(p.ws + OFF_OGC);
    float* part = (float*)smem;
    float* stat = part + 32 * 512;
    f32x2 wk[31];
#pragma unroll
    for (int j = 0; j < 31; ++j) wk[j] = *(const f32x2*)(p.conv_k + j * 1024 + c0);
    const f32x2 cb = *(const f32x2*)(p.conv_b + c0), lg = *(const f32x2*)(p.conv_ln_g + c0), lb = *(const f32x2*)(p.conv_ln_b + c0);
    for (int tile = blockIdx.x; tile < T / 16; tile += gridDim.x) {
        const int b = tile >> 7, t0 = (tile & 127) * 16; const size_t row0 = (size_t)b * SEQ + t0;
        f32x2 u[46];
#pragma unroll
        for (int i = 0; i < 46; ++i) { const int t = t0 - 30 + i; unsigned v = 0u; if (t >= 0) v = *(const unsigned*)(U + ((size_t)b * SEQ + t) * 1024 + c0); u[i] = (f32x2){bflo(v), bfhi(v)}; }
        f32x2 o[16];
#pragma unroll
        for (int i = 0; i < 16; ++i) { f32x2 a = cb;
#pragma unroll
            for (int j = 0; j < 31; ++j) a = wk[j] * u[i + j] + a;
            o[i] = a; }
#pragma unroll
        for (int i = 0; i < 16; ++i) { part[i * 512 + tid] = o[i].x + o[i].y; part[(16 + i) * 512 + tid] = o[i].x * o[i].x + o[i].y * o[i].y; }
        __syncthreads();
#pragma unroll
        for (int q = 0; q < 4; ++q) { const int v = 4 * w + q; float s = 0.f;
#pragma unroll
            for (int r = 0; r < 8; ++r) s += part[v * 512 + lane + 64 * r];
            s = wave_sum(s); if (lane == 0) stat[v] = s; }
        __syncthreads();
#pragma unroll
        for (int i = 0; i < 16; ++i) { const float mean = stat[i] * (1.f / 1024.f), var = stat[16 + i] * (1.f / 1024.f) - mean * mean, rstd = __builtin_amdgcn_rsqf(var + 1e-5f);
            float y0 = (o[i].x - mean) * rstd * lg.x + lb.x, y1 = (o[i].y - mean) * rstd * lg.y + lb.y; y0 *= sigm(y0); y1 *= sigm(y1);
            bf16_t* gp = OGC + (row0 + i) * 1024 + c0; const unsigned og = *(const unsigned*)gp;
            *(unsigned*)gp = cvt_pk_bf16(y0 * bflo(og), y1 * bfhi(og)); }
    }
    const bf16_t* RK = (const bf16_t*)(p.ws + OFF_RKVL); bf16_t* AL = (bf16_t*)(p.ws + OFF_ALORA);
    for (int idx = blockIdx.x * 512 + tid; idx < T * 128; idx += gridDim.x * 512) { const int t = idx >> 7, j = idx & 127;
        const float z = bf2f(RK[(size_t)t * LDR + 3072 + j]), pv = (t & (SEQ - 1)) ? bf2f(RK[(size_t)(t - 1) * LDR + 3072 + j]) : 0.f;
        const float s = z + p.rwkv_mu[3072 + j] * (pv - z); const float val = j < 64 ? tanhf(s) : s;
        AL[(size_t)t * 128 + j] = f2bf(val); }
}
constexpr int SCH = 32, SNCH = SEQ / SCH, SREC = 272;
struct ScanRaw { unsigned v[8], wa[8]; };
struct ScanOps { f32x4 a[8], b[4], k[4]; };
struct ScanC { float mu_r, mu_k, mu_v, w0c, a0c, kkc, kac, rkc, gng, gnb; };
__device__ __forceinline__ void scan_load_raw(ScanRaw& R, f32x2 (&S)[8], const bf16_t* RK, const bf16_t* DW, const bf16_t* AP, int b, int c, int pw, int ch) {
#pragma unroll
    for (int i = 0; i < 8; ++i) { const int t = c * SCH + 8 * pw + i; const size_t row = (size_t)b * SEQ + t; const bf16_t* rp = RK + row * LDR + ch;
        const bf16_t* rq = t > 0 ? rp - LDR : rp;
        S[i >> 1][i & 1] = __uint_as_float((unsigned)rp[0] | ((unsigned)rq[0] << 16)); S[4 + (i >> 1)][i & 1] = __uint_as_float((unsigned)rp[1024] | ((unsigned)rq[1024] << 16));
        R.v[i] = (unsigned)rp[2048] | ((unsigned)rq[2048] << 16); R.wa[i] = (unsigned)DW[row * 1024 + ch] | ((unsigned)AP[row * 1024 + ch] << 16); }
}
__device__ __forceinline__ void scan_prep(const ScanRaw& R, const f32x2 (&S)[8], const ScanC& C, int c, int pw, int lane, unsigned seq, float* rec, float* vbuf, f32x4* scl, float* wtot, float* ptot, volatile unsigned* flag) {
    float kkA[8], rA[8], nbA[8], kpA[8], LA[8]; float L = 1.f;
#pragma unroll
    for (int i = 0; i < 8; ++i) { const int tt = 8 * pw + i, t = c * SCH + tt;
        const unsigned Rr = __float_as_uint(S[i >> 1][i & 1]), Rk = __float_as_uint(S[4 + (i >> 1)][i & 1]);
        float r = bflo(Rr), k = bflo(Rk), v = bflo(R.v[i]); const float pm = t > 0 ? 1.f : 0.f;
        const float r1 = pm * bfhi(Rr), k1 = pm * bfhi(Rk), v1 = pm * bfhi(R.v[i]);
        r += C.mu_r * (r1 - r); k += C.mu_k * (k1 - k); v += C.mu_v * (v1 - v);
        const float wpre = C.w0c + bflo(R.wa[i]), apre = C.a0c + bfhi(R.wa[i]);
        const float decay = __expf(-0.60653066f * sigm(wpre)), a = sigm(apre);
        const float kkv = k * C.kkc, n2 = wave_sum(kkv * kkv), kk = kkv * __builtin_amdgcn_rsqf(fmaxf(n2, 1e-24f));
        const float kp = k * (1.f + (a - 1.f) * C.kac), bv = kk * a;
        const float br = wave_sum(bv * r), kr = wave_sum(kp * r), bonus = wave_sum(r * kp * C.rkc);
        L *= decay; kkA[i] = kk; rA[i] = r; nbA[i] = -bv; kpA[i] = kp; LA[i] = L;
        vbuf[tt * 64 + lane] = v;
        if (lane == 0) scl[tt] = (f32x4){-br, kr, bonus, 0.f};
        if (i & 1) __builtin_amdgcn_sched_barrier(0);
    }
    wtot[pw * 64 + lane] = L;
    asm volatile("s_waitcnt lgkmcnt(0)" ::: "memory");
    if (lane == 0) flag[pw] = seq;
    float Pw = 1.f;
    for (int ww = 0; ww < pw; ++ww) { while (flag[ww] != seq) __builtin_amdgcn_s_sleep(1);
        asm volatile("" ::: "memory"); Pw *= wtot[ww * 64 + lane]; }
    if (pw == 3) ptot[lane] = Pw * L;
    float Pprev = Pw;
#pragma unroll
    for (int i = 0; i < 8; ++i) { const int tt = 8 * pw + i; const float Pt = Pw * LA[i], ip = __builtin_amdgcn_rcpf(Pt);
        float* rc = rec + tt * SREC + (lane >> 4) * 68; const int e = lane & 15;
        *(f32x2*)(rc + 2 * e) = (f32x2){Pprev * kkA[i], Pt * rA[i]}; rc[32 + e] = nbA[i] * ip; rc[48 + e] = kpA[i] * ip;
        Pprev = Pt; }
}
__device__ __forceinline__ void scan_post(const bf16_t (&og)[8], bf16_t* dst0, const ScanC& C, int pw, int lane, const float* obuf, const float* vbuf, const f32x4* scl) {
#pragma unroll
    for (int i = 0; i < 8; ++i) { const int tt = pw + 4 * i;
        const float o = obuf[tt * 64 + lane], mean = wave_sum(o) * (1.f / 64.f), d = o - mean, var = wave_sum(d * d) * (1.f / 64.f);
        float y = d * __builtin_amdgcn_rsqf(var + 64e-5f) * C.gng + C.gnb; y += scl[tt].z * vbuf[tt * 64 + lane];
        dst0[(size_t)i * 4096] = f2bf(y * bf2f(og[i])); }
}
__device__ __forceinline__ void scan_load_ops(ScanOps& o, const f32x4* rq) {
#pragma unroll
    for (int j = 0; j < 8; ++j) o.a[j] = rq[j];
#pragma unroll
    for (int j = 0; j < 4; ++j) { o.b[j] = rq[8 + j]; o.k[j] = rq[12 + j]; }
}
__device__ __forceinline__ void scan_step(f32x2 (&S)[8], ScanOps& q, const f32x4* rn, const float v, const bool lead, const f32x2 sc, float* obuf, float* dump, int tt, int srow) {
    f32x2 vv = {v, v}; asm volatile("" : "+v"(vv));
    f32x2 d0 = S[0].x * (f32x2){q.a[0][0], q.a[0][1]}, d1 = S[0].y * (f32x2){q.a[0][2], q.a[0][3]}, d2 = S[1].x * (f32x2){q.a[1][0], q.a[1][1]}, d3 = S[1].y * (f32x2){q.a[1][2], q.a[1][3]};
#pragma unroll
    for (int j = 2; j < 8; j += 2) { d0 += S[j].x * (f32x2){q.a[j][0], q.a[j][1]}; d1 += S[j].y * (f32x2){q.a[j][2], q.a[j][3]};
        d2 += S[j + 1].x * (f32x2){q.a[j + 1][0], q.a[j + 1][1]}; d3 += S[j + 1].y * (f32x2){q.a[j + 1][2], q.a[j + 1][3]}; }
#pragma unroll
    for (int j = 0; j < 8; ++j) q.a[j] = rn[j];
    const f32x2 d = (d0 + d1) + (d2 + d3);
    float sk = d.x, o = d.y;
    sk = dpp_add<0xB1>(sk); o = dpp_add<0xB1>(o); sk = dpp_add<0x4E>(sk); o = dpp_add<0x4E>(o);
#pragma unroll
    for (int j = 0; j < 4; ++j) { S[2 * j] += sk * (f32x2){q.b[j][0], q.b[j][1]}; S[2 * j + 1] += sk * (f32x2){q.b[j][2], q.b[j][3]}; }
#pragma unroll
    for (int j = 0; j < 4; ++j) { S[2 * j] += vv * (f32x2){q.k[j][0], q.k[j][1]}; S[2 * j + 1] += vv * (f32x2){q.k[j][2], q.k[j][3]}; }
#pragma unroll
    for (int j = 0; j < 4; ++j) { q.b[j] = rn[8 + j]; q.k[j] = rn[12 + j]; }
    LAS float* op = lead ? (LAS float*)(obuf + tt * 64 + srow) : (LAS float*)dump; *op = o + sk * sc.x + v * sc.y;
}
__device__ void phase_scan(const Params& p, unsigned char* smem) {
    const int tid = tid_opaque(), w = tid >> 6, lane = tid & 63, g = lane & 3, srow = (w & 3) * 16 + (lane >> 2), pw = w & 3;
    const bool cons = w < 4, lead = (g == 0);
    float* recb = (float*)smem;
    float* vbufb = recb + 2 * SCH * SREC;
    float* obufb = vbufb + 3 * SCH * 64;
    f32x4* sclb = (f32x4*)(obufb + 2 * SCH * 64);
    float* wtot = (float*)(sclb + 3 * SCH);
    float* ptotb = wtot + 256;
    volatile unsigned* flag = (volatile unsigned*)(ptotb + 128);
    float* dump = (float*)(ptotb + 128) + 8;
    const bf16_t* RK = (const bf16_t*)(p.ws + OFF_RKVL); const bf16_t* DW = (const bf16_t*)(p.ws + OFF_DW); const bf16_t* AP = (const bf16_t*)p.out;
    bf16_t* OGR = (bf16_t*)(p.ws + OFF_OGR);
    unsigned seq = 0;
    for (int bh = blockIdx.x; bh < 256; bh += gridDim.x) {
        const int b = bh >> 4, h = bh & 15, ch = h * 64 + lane;
        const ScanC C{p.rwkv_mu[ch], p.rwkv_mu[1024 + ch], p.rwkv_mu[2048 + ch], p.rwkv_w0[ch], p.rwkv_a0[ch], p.rwkv_k_k[ch], p.rwkv_k_a[ch], p.rwkv_r_k[ch], p.rwkv_gn_g[ch], p.rwkv_gn_b[ch]};
        f32x2 S[8];
#pragma unroll
        for (int i = 0; i < 8; ++i) S[i] = (f32x2){0.f, 0.f};
        ScanRaw R;
        if (tid < 4) flag[tid] = 0u;
        __syncthreads();
        ++seq;
        if (!cons) { scan_load_raw(R, S, RK, DW, AP, b, 0, pw, ch); scan_prep(R, S, C, 0, pw, lane, seq, recb, vbufb, sclb, wtot, ptotb, flag); scan_load_raw(R, S, RK, DW, AP, b, 1, pw, ch); }
        __syncthreads();
        for (int c = 0; c < SNCH; ++c) {
            const int cb = c & 1, c3 = c % 3, n3 = (c + 1) % 3, p3 = (c + 2) % 3;
            ++seq;
            if (cons) {
                const float* vb = vbufb + c3 * (SCH * 64); const f32x2* sc2 = (const f32x2*)(sclb + c3 * SCH); float* ob = obufb + cb * (SCH * 64);
                const f32x4* rq = (const f32x4*)(recb + cb * (SCH * SREC) + g * 68);
                ScanOps A; scan_load_ops(A, rq);
                float v0 = vb[srow]; f32x2 s0 = sc2[0];
                __builtin_amdgcn_s_setprio(3);
                for (int tt = 0; tt < SCH; ++tt) {
                    const int tn = tt + 1 < SCH ? tt + 1 : SCH - 1;
                    const float nv0 = vb[tn * 64 + srow]; const f32x2 ns0 = sc2[2 * tn];
                    scan_step(S, A, rq + tn * (SREC / 4), v0, lead, s0, ob, dump, tt, srow);
                    v0 = nv0; s0 = ns0;
                }
                __builtin_amdgcn_s_setprio(0);
                { const f32x4* pq = (const f32x4*)(ptotb + cb * 64 + g * 16);
#pragma unroll
                    for (int j = 0; j < 4; ++j) { const f32x4 pp = pq[j]; S[2 * j] *= (f32x2){pp[0], pp[1]}; S[2 * j + 1] *= (f32x2){pp[2], pp[3]}; } }
            } else {
                bf16_t og[8]; bf16_t* dst0 = OGR + ((size_t)b * SEQ + (c > 0 ? c - 1 : 0) * SCH + pw) * 1024 + ch;
#pragma unroll
                for (int i = 0; i < 8; ++i) og[i] = dst0[(size_t)i * 4096];
                if (c + 1 < SNCH) { scan_prep(R, S, C, c + 1, pw, lane, seq, recb + (cb ^ 1) * (SCH * SREC), vbufb + n3 * (SCH * 64), sclb + n3 * SCH, wtot, ptotb + (cb ^ 1) * 64, flag);
                    if (c + 2 < SNCH) scan_load_raw(R, S, RK, DW, AP, b, c + 2, pw, ch); }
                if (c > 0) scan_post(og, dst0, C, pw, lane, obufb + (cb ^ 1) * (SCH * 64), vbufb + p3 * (SCH * 64), sclb + p3 * SCH);
            }
            __syncthreads();
        }
        if (!cons) { const int cl = SNCH - 1; bf16_t og[8]; bf16_t* dst0 = OGR + ((size_t)b * SEQ + cl * SCH + pw) * 1024 + ch;
#pragma unroll
            for (int i = 0; i < 8; ++i) og[i] = dst0[(size_t)i * 4096];
            scan_post(og, dst0, C, pw, lane, obufb + (cl & 1) * (SCH * 64), vbufb + (cl % 3) * (SCH * 64), sclb + (cl % 3) * SCH); }
        __syncthreads();
    }
}
__device__ void phase_final(const Params& p) {
    const int tid = tid_opaque(), w = tid >> 6, lane = tid & 63;
    for (int tok = blockIdx.x * 8 + w; tok < T; tok += gridDim.x * 8) {
        float* xr = p.out + (size_t)tok * 1024; f32x4 v[4]; float ss = 0.f;
#pragma unroll
        for (int q = 0; q < 4; ++q) { v[q] = *(const f32x4*)(xr + q * 256 + lane * 4); ss += v[q][0] * v[q][0] + v[q][1] * v[q][1] + v[q][2] * v[q][2] + v[q][3] * v[q][3]; }
        ss = wave_sum(ss); const float rstd = rsqrtf(ss * (1.f / 1024.f) + 1e-6f);
#pragma unroll
        for (int q = 0; q < 4; ++q) { const int col = q * 256 + lane * 4; *(f32x4*)(xr + col) = v[q] * rstd * *(const f32x4*)(p.final_g + col); }
    }
}

template <int FIRST, int LAST> __global__ __launch_bounds__(512, 2) void mega(Params p) {
    extern __shared__ __attribute__((aligned(16))) unsigned char smem[];
    LAS unsigned char* lds = (LAS unsigned char*)smem;
    cg::grid_group grid = cg::this_grid();
    unsigned* bar = (unsigned*)(uniform_ptr(p.ws) + OFF_BAR);
    volatile LAS unsigned* st = (volatile LAS unsigned*)(lds + LDS_BYTES);
    if (threadIdx.x == 0) { st[0] = 0u; st[1] = 0u; (void)xb_add(&bar[XB_XCNT(xb_xcc_id())], 1u); }
    __syncthreads();
    if (p.ws == nullptr) grid.sync();
    unsigned char* ws = p.ws;
    const int G = gridDim.x, c = blockIdx.x;
    if (FIRST <= 0 && 0 < LAST) { phase_mod(p, smem); phase_weights(p, smem); }
    if (FIRST <= 1 && 1 < LAST) { if (FIRST < 1) grid_barrier(bar, st); phase_h(p); }
    if (FIRST <= 2 && 2 < LAST) { if (FIRST < 2) grid_barrier(bar, st);
        pg8::Sched1 S{T / 256, N1 / 256, G, c, (const char*)p.out, (const char*)(ws + OFF_WINT), (size_t)256 * 1024 * 2};
        EpiG1 E{ws, (unsigned char*)p.out};
        pg8::gemm_phase(lds, 1024, S, E); }
    if (FIRST <= 3 && 3 < LAST) { if (FIRST < 3) grid_barrier(bar, st); phase_conv(p, smem); }
    if (FIRST <= 4 && 4 < LAST) { if (FIRST < 4) grid_barrier(bar, st);
        pg8::Sched1 S{T / 256, 2048 / 256, G, c, (const char*)(ws + OFF_ALORA), (const char*)(ws + OFF_LBT), (size_t)256 * 128 * 2};
        EpiLora E{(bf16_t*)(ws + OFF_DW), (bf16_t*)p.out};
        pg8::gemm_phase(lds, 128, S, E); }
    if (FIRST <= 5 && 5 < LAST) { if (FIRST < 5) grid_barrier(bar, st); phase_scan(p, smem); }
    if (FIRST <= 6 && 6 < LAST) { if (FIRST < 6) grid_barrier(bar, st);
        pg8::Sched2 S{T / 256, 4, G, c, (const char*)(ws + OFF_OGC), (const char*)(ws + OFF_OGR), (const char*)(ws + OFF_W2T), (const char*)(ws + OFF_W2T + 2 * MiB), (size_t)256 * 1024 * 2};
        EpiG2 E{(const bf16_t*)(ws + OFF_GC), (const bf16_t*)((unsigned char*)p.out + 64 * MiB), (bf16_t*)(ws + OFF_M)};
        pg8::gemm_phase(lds, 1024, S, E); }
    if (FIRST <= 7 && 7 < LAST) { if (FIRST < 7) grid_barrier(bar, st);
        pg8::Sched1 S{T / 256, 4, G, c, (const char*)(ws + OFF_M), (const char*)(ws + OFF_WOT), (size_t)256 * 1024 * 2};
        EpiG3 E{p.x, (const float*)(ws + OFF_MOD), p.final_g, p.out, (float*)(ws + OFF_ROWSS), (unsigned*)(ws + OFF_PCNT)};
        pg8::gemm_phase(lds, 1024, S, E); }
}

template <int PH> static void launch_one(const Params& p, hipStream_t stream) {
    hipFuncSetAttribute((const void*)mega<PH, PH + 1>, hipFuncAttributeMaxDynamicSharedMemorySize, LDS_BYTES);
    mega<PH, PH + 1><<<256, 512, LDS_BYTES, stream>>>(p);
}

extern "C" void kernel_launch(void* const* d_in, const int* in_sizes, int n_in, void* d_out, int out_size, void* d_ws, size_t ws_size, hipStream_t stream) {
    Params p{};
    const float** f = (const float**)&p;
    for (int i = 0; i < 24; ++i) f[i] = (const float*)d_in[i];
    p.out = (float*)d_out; p.ws = (unsigned char*)d_ws;
    if (ws_size < WS_END) { fprintf(stderr, "workspace too small: %zu < %zu\n", ws_size, (size_t)WS_END); return; }
#if SINGLE_LAUNCH
    static int grid_blocks = 0;
    if (!grid_blocks) {
        int dev = 0, cus = 0, per_cu = 0;
        hipGetDevice(&dev);
        hipDeviceGetAttribute(&cus, hipDeviceAttributeMultiprocessorCount, dev);
        hipFuncSetAttribute((const void*)mega<0, NPHASE>, hipFuncAttributeMaxDynamicSharedMemorySize, LDS_BYTES + 16);
        hipOccupancyMaxActiveBlocksPerMultiprocessor(&per_cu, mega<0, NPHASE>, 512, LDS_BYTES + 16);
        grid_blocks = cus * (per_cu > 1 ? 1 : per_cu);
        if (grid_blocks > 256) grid_blocks = 256;
    }
    hipMemsetAsync((unsigned char*)d_ws + OFF_BAR, 0, 3456 * 4, stream);
    void* args[] = {(void*)&p};
    hipError_t e = hipLaunchCooperativeKernel((const void*)mega<0, NPHASE>, dim3(grid_blocks), dim3(512), args, LDS_BYTES + 16, stream);
    if (e != hipSuccess) fprintf(stderr, "cooperative launch failed: %s (grid %d)\n", hipGetErrorString(e), grid_blocks);
#else
    launch_one<0>(p, stream); launch_one<1>(p, stream); launch_one<2>(p, stream); launch_one<3>(p, stream); launch_one<4>(p, stream);
    launch_one<5>(p, stream); launch_one<6>(p, stream); launch_one<7>(p, stream); launch_one<8>(p, stream);
#endif
}
```

```cpp
#include <hip/hip_runtime.h>
#include <hip/hip_cooperative_groups.h>
#include <cstdio>
namespace cg = cooperative_groups;

#ifndef SINGLE_LAUNCH
#define SINGLE_LAUNCH 1
#endif

#define LAS __attribute__((address_space(3)))
#define GAS __attribute__((address_space(1)))
typedef unsigned short bf16_t;
typedef short bf16x8 __attribute__((ext_vector_type(8)));
typedef float f32x8 __attribute__((ext_vector_type(8)));
typedef float f32x4 __attribute__((ext_vector_type(4)));
typedef float f32x2 __attribute__((ext_vector_type(2)));
typedef unsigned u32x4 __attribute__((ext_vector_type(4)));
typedef unsigned u32x2 __attribute__((ext_vector_type(2)));

constexpr int T = 32768, DM = 1024, SEQ = 2048, NB_ = 16;
constexpr int N1 = 9472;
constexpr int LDR = 3328;
constexpr int LDS_BYTES = 131072;
constexpr int NPHASE = 9;

constexpr size_t MiB = 1u << 20;
constexpr size_t OFF_U = 0, OFF_OGC = 64 * MiB, OFF_RKVL = 128 * MiB, OFF_OGR = 336 * MiB, OFF_GC = 400 * MiB, OFF_WINT = 464 * MiB;
constexpr size_t OFF_ALORA = OFF_WINT + (size_t)N1 * 1024 * 2;
constexpr size_t OFF_W2T = OFF_ALORA + 16 * MiB, OFF_WOT = OFF_W2T + 4 * MiB, OFF_LBT = OFF_WOT + 2 * MiB, OFF_MOD = OFF_LBT + 1 * MiB;
constexpr size_t OFF_BAR = OFF_MOD + 16 * 3072 * 4;
constexpr size_t OFF_ROWSS = OFF_BAR + 3456 * 4 + 128;
constexpr size_t OFF_PCNT = OFF_ROWSS + (size_t)T * 4;
constexpr size_t WS_END = OFF_PCNT + 256 * 4;
constexpr size_t OFF_MP = OFF_RKVL, OFF_M = OFF_RKVL + 128 * MiB, OFF_DW = OFF_U;

struct Params {
    const float *x, *c, *ada_w, *ada_b, *norm_g, *w_in, *conv_k, *conv_b, *conv_ln_g, *conv_ln_b, *w_conv_out, *rwkv_mu, *rwkv_w0, *rwkv_w2, *rwkv_a0, *rwkv_a2,
        *rwkv_k_k, *rwkv_k_a, *rwkv_r_k, *rwkv_gn_g, *rwkv_gn_b, *w_rwkv_out, *w_out, *final_g;
    float* out;
    unsigned char* ws;
};

typedef __bf16 bf16x2_t __attribute__((ext_vector_type(2)));
__device__ __forceinline__ unsigned cvt_pk_bf16(float lo, float hi) { const bf16x2_t r = __builtin_convertvector((f32x2){lo, hi}, bf16x2_t); return __builtin_bit_cast(unsigned, r); }
__device__ __forceinline__ bf16_t f2bf(float f) { return (bf16_t)(cvt_pk_bf16(f, 0.f) & 0xffffu); }
__device__ __forceinline__ float bf2f(bf16_t b) { return __uint_as_float(((unsigned)b) << 16); }
__device__ __forceinline__ float bflo(unsigned v) { return __uint_as_float(v << 16); }
__device__ __forceinline__ float bfhi(unsigned v) { return __uint_as_float(v & 0xffff0000u); }
__device__ __forceinline__ float sigm(float x) { return __builtin_amdgcn_rcpf(1.f + __expf(-x)); }
__device__ __forceinline__ int tid_opaque() { int t = threadIdx.x; asm volatile("" : "+v"(t)); return t; }
__device__ __forceinline__ unsigned char* uniform_ptr(unsigned char* p) { const size_t v = (size_t)p; const unsigned lo = __builtin_amdgcn_readfirstlane((unsigned)v), hi = __builtin_amdgcn_readfirstlane((unsigned)(v >> 32)); return (unsigned char*)(((size_t)hi << 32) | lo); }
template <int CTRL> __device__ __forceinline__ float dpp_add(float v) { return v + __int_as_float(__builtin_amdgcn_update_dpp(0, __float_as_int(v), CTRL, 0xF, 0xF, true)); }
__device__ __forceinline__ float wave_sum(float v) {
    v = dpp_add<0xB1>(v); v = dpp_add<0x4E>(v); v = dpp_add<0x141>(v); v = dpp_add<0x140>(v);
    const int iv = __float_as_int(v);
    return (__int_as_float(__builtin_amdgcn_readlane(iv, 0)) + __int_as_float(__builtin_amdgcn_readlane(iv, 16))) + (__int_as_float(__builtin_amdgcn_readlane(iv, 32)) + __int_as_float(__builtin_amdgcn_readlane(iv, 48)));
}

#define XB_TMO      128
#define XB_XCNT(j)  (256  + 64 * (j))
#define XB_XSUB(j)  (1280 + 64 * (j))
#define XB_XGEN(j)  (2304 + 64 * (j))
#define XB_TOP      3328
#define XB_TOPGEN   3392
#define XB_WORDS    3456
#define XB_SPIN_CAP (1u << 22)
__device__ __forceinline__ unsigned xb_ld(unsigned* p)              { return __hip_atomic_load(p, __ATOMIC_RELAXED, __HIP_MEMORY_SCOPE_AGENT); }
__device__ __forceinline__ unsigned xb_add(unsigned* p, unsigned v) { return __hip_atomic_fetch_add(p, v, __ATOMIC_RELAXED, __HIP_MEMORY_SCOPE_AGENT); }
__device__ __forceinline__ unsigned xb_xcc_id() { return (unsigned)__builtin_amdgcn_s_getreg((3 << 11) | 20) & 0xFu; }
#define XB_SPIN(cond, bar) do { unsigned _sp = 0; while (cond) { __builtin_amdgcn_s_sleep(1); \
    if ((++_sp & 255u) == 0u) { if (xb_ld(&(bar)[XB_TMO])) break; if (_sp > XB_SPIN_CAP) { atomicAdd(&(bar)[XB_TMO], 1u); break; } } } } while (0)
__device__ __forceinline__ void xcd_barrier_complete(unsigned* bar, unsigned x, unsigned& nloc, unsigned& nx) {
    const unsigned G = gridDim.x; unsigned sum, cnt, mine, sp = 0u;
    for (;;) { sum = 0u; cnt = 0u; mine = 0u;
#pragma unroll
        for (unsigned j = 0; j < 16; ++j) { const unsigned c = xb_ld(&bar[XB_XCNT(j)]); sum += c; cnt += (c > 0u) ? 1u : 0u; mine = (j == x) ? c : mine; }
        if (sum == G) break;
        __builtin_amdgcn_s_sleep(1);
        if ((++sp & 255u) == 0u) { if (xb_ld(&bar[XB_TMO])) break; if (sp > XB_SPIN_CAP) { atomicAdd(&bar[XB_TMO], 1u); break; } } }
    nloc = mine > 0u ? mine : 1u; nx = cnt > 0u ? cnt : 1u;
}
__device__ __forceinline__ void grid_barrier(unsigned* bar, volatile LAS unsigned* st) {
    asm volatile("s_waitcnt vmcnt(0) lgkmcnt(0)" ::: "memory");
    __syncthreads();
    if (threadIdx.x == 0) {
        const unsigned x = xb_xcc_id();
        unsigned nloc = st[0], nx = st[1];
        if (nloc == 0u) { xcd_barrier_complete(bar, x, nloc, nx); st[0] = nloc; st[1] = nx; }
        const unsigned old = xb_add(&bar[XB_XSUB(x)], 1u);
        const unsigned gen = old / nloc;
        if (old + 1u == (gen + 1u) * nloc) {
            __builtin_amdgcn_fence(__ATOMIC_RELEASE, "agent");
            asm volatile("s_waitcnt vmcnt(0)" ::: "memory");
            const unsigned og = xb_add(&bar[XB_TOP], 1u);
            const unsigned tg = og / nx;
            if (og + 1u == (tg + 1u) * nx) xb_add(&bar[XB_TOPGEN], 1u);
            else XB_SPIN(xb_ld(&bar[XB_TOPGEN]) == tg, bar);
            __builtin_amdgcn_fence(__ATOMIC_ACQUIRE, "agent");
            xb_add(&bar[XB_XGEN(x)], 1u);
            asm volatile("s_waitcnt vmcnt(0)" ::: "memory");
        } else {
            XB_SPIN(xb_ld(&bar[XB_XGEN(x)]) == gen, bar);
            __builtin_amdgcn_fence(__ATOMIC_ACQUIRE, "agent");
            asm volatile("s_waitcnt vmcnt(0)" ::: "memory");
        }
    }
    __syncthreads();
}

namespace pg8 {
constexpr int BM = 256, BK = 64, HALF = 128, HTB = HALF * BK * 2, NXCD = 8, WGM = 8;
__host__ __device__ __forceinline__ int lds_byte(int r, int c) { const int st = (r >> 4) * 2 + (c >> 5), rr = r & 15, cc = c & 31, ob = rr * 64 + cc * 2; return st * 1024 + (ob ^ (((ob >> 9) & 1) << 5)); }
__host__ __device__ __forceinline__ void stage_rc(int b, int& R, int& C) { const int st = b / 1024, sb = b % 1024, swz = sb ^ (((sb >> 9) & 1) << 5); R = (st >> 1) * 16 + swz / 64; C = (st & 1) * 32 + (swz % 64) / 2; }
__host__ __device__ __forceinline__ int perm32(int rho) { const int n = rho >> 4, i = rho & 15; return 8 * (i >> 2) + 4 * n + (i & 3); }
struct Unit { int pm, pn, kind; };

__device__ __forceinline__ void map_unit(int L, int nM, int nN, Unit& u) {
    const int nwg = nM * nN; int wgid = L;
    { const int q = nwg / NXCD, r = nwg % NXCD, xcd = wgid % NXCD, off = wgid / NXCD; wgid = (xcd < r ? xcd * (q + 1) : r * (q + 1) + (xcd - r) * q) + off; }
    const int nig = WGM * nN, gid = wgid / nig, fm = gid * WGM, gsz = (nM - fm) < WGM ? (nM - fm) : WGM;
    u.pm = fm + ((wgid % nig) % gsz); u.pn = (wgid % nig) / gsz;
}
struct Sched1 {
    int nM, nN, G, c; const char* A; const char* Bt; size_t tstep;
    __device__ __forceinline__ bool next(int i, Unit& u) const { const long L = (long)i * G + c; if (L >= (long)nM * nN) return false; map_unit((int)L, nM, nN, u); u.kind = 0; return true; }
    __device__ __forceinline__ const char* aptr(const Unit& u) const { return A + (size_t)u.pm * tstep; }
    __device__ __forceinline__ const char* bptr(const Unit& u) const { return Bt + (size_t)u.pn * tstep; }
};
struct Sched2 {
    int nM, nN, G, c; const char* A0; const char* A1; const char* B0; const char* B1; size_t tstep;
    __device__ __forceinline__ bool next(int i, Unit& u) const { const long L = (long)(i >> 1) * G + c; if (L >= (long)nM * nN) return false; map_unit((int)L, nM, nN, u); u.kind = i & 1; return true; }
    __device__ __forceinline__ const char* aptr(const Unit& u) const { return (u.kind ? A1 : A0) + (size_t)u.pm * tstep; }
    __device__ __forceinline__ const char* bptr(const Unit& u) const { return (u.kind ? B1 : B0) + (size_t)u.pn * tstep; }
};

template <class Epi, class Sched>
__device__ __forceinline__ void gemm_phase(LAS unsigned char* lds, const int K, const Sched& S, const Epi& E) {
    const int tid = tid_opaque(), wid = __builtin_amdgcn_readfirstlane(tid >> 6), lane = tid & 63, wr = wid >> 2, wc = wid & 3, fr = lane & 15, fq = lane >> 4;
    const int nt = K / BK;
    unsigned voffA[2], voffB[2];
#pragma unroll
    for (int i = 0; i < 2; ++i) { int R, C; stage_rc(tid * 16 + i * 8192, R, C); const int Rb = Epi::PERM ? ((R & ~31) + perm32(R & 31)) : R;
        voffA[i] = (unsigned)(R * K + C) * 2u; voffB[i] = (unsigned)(Rb * K + C) * 2u; }
    const size_t kstep = (size_t)(BK * 2);
    const size_t hstep = (size_t)HALF * K * 2;
    const unsigned ldsw = (unsigned)wid * 1024u;
    const int aoff = lds_byte(wr * 64 + fr, fq * 8), boff = lds_byte(wc * 32 + fr, fq * 8);
#define PG8_SA(b, h) (((b) * 2 + (h)) * HTB)
#define PG8_SB(b, h) ((4 + (b) * 2 + (h)) * HTB)
#define PG8_STAGE(bufoff, gbase, voff) do { _Pragma("unroll") for (int _i = 0; _i < 2; ++_i) \
        __builtin_amdgcn_global_load_lds((const unsigned*)((const char*)(gbase) + (voff)[_i]), (LAS unsigned*)(lds + (bufoff) + ldsw + _i * 8192), 16, 0, 0); } while (0)
#define PG8_LDA(dst, b, h) do { _Pragma("unroll") for (int m = 0; m < 4; ++m) _Pragma("unroll") for (int k = 0; k < 2; ++k) dst[m][k] = *(const LAS bf16x8*)(lds + PG8_SA(b, h) + aoff + m * 2048 + k * 1024); } while (0)
#define PG8_LDB(dst, b, h) do { _Pragma("unroll") for (int n = 0; n < 2; ++n) _Pragma("unroll") for (int k = 0; k < 2; ++k) dst[n][k] = *(const LAS bf16x8*)(lds + PG8_SB(b, h) + boff + n * 2048 + k * 1024); } while (0)
#define PG8_MMA(ai, bj, At, Bt) do { __builtin_amdgcn_s_setprio(1); _Pragma("unroll") for (int m = 0; m < 4; ++m) _Pragma("unroll") for (int n = 0; n < 2; ++n) _Pragma("unroll") for (int k = 0; k < 2; ++k) \
        acc[ai][bj][m][n] = __builtin_amdgcn_mfma_f32_16x16x32_bf16(Bt[n][k], At[m][k], acc[ai][bj][m][n], 0, 0, 0); __builtin_amdgcn_s_setprio(0); } while (0)
#define PG8_WAIT_V(n) asm volatile("s_waitcnt vmcnt(" #n ")" ::: "memory")
#define PG8_WAIT_L(n) asm volatile("s_waitcnt lgkmcnt(" #n ")" ::: "memory")
#define PG8_BAR __builtin_amdgcn_s_barrier()
#define PG8_SCHED __builtin_amdgcn_sched_barrier(0)
    Unit cur, nxt; int ui = 0;
    if (!S.next(0, cur)) return;
    f32x4 acc[2][2][4][2];
#pragma unroll
    for (int a = 0; a < 2; ++a)
#pragma unroll
        for (int b = 0; b < 2; ++b)
#pragma unroll
            for (int m = 0; m < 4; ++m)
#pragma unroll
                for (int n = 0; n < 2; ++n) acc[a][b][m][n] = (f32x4){0.f, 0.f, 0.f, 0.f};
    bf16x8 At[4][2], B0[2][2], B1[2][2];
    const char* cA = S.aptr(cur); const char* cB = S.bptr(cur);
    PG8_STAGE(PG8_SB(0, 0), cB, voffB); PG8_STAGE(PG8_SA(0, 0), cA, voffA); PG8_STAGE(PG8_SB(0, 1), cB + hstep, voffB); PG8_STAGE(PG8_SA(0, 1), cA + hstep, voffA);
    if (wr == 1) PG8_BAR;
    PG8_WAIT_V(4); PG8_BAR;
    PG8_STAGE(PG8_SB(1, 0), cB + kstep, voffB); PG8_STAGE(PG8_SA(1, 0), cA + kstep, voffA); PG8_STAGE(PG8_SB(1, 1), cB + hstep + kstep, voffB);
    PG8_WAIT_V(6); PG8_BAR;
    for (;;) {
        const bool has_next = S.next(ui + 1, nxt);
        const char* nA = has_next ? S.aptr(nxt) : cA; const char* nB = has_next ? S.bptr(nxt) : cB;
        for (int t = 0; t < nt; t += 2) {
            const bool last = (t == nt - 2);
            const char* a1 = cA + (size_t)(t + 1) * kstep;
            const char* a2 = last ? nA : cA + (size_t)(t + 2) * kstep; const char* b2 = last ? nB : cB + (size_t)(t + 2) * kstep;
            const char* a3 = a2 + kstep; const char* b3 = b2 + kstep;
            PG8_LDB(B0, 0, 0); PG8_SCHED; PG8_LDA(At, 0, 0); PG8_STAGE(PG8_SA(1, 1), a1 + hstep, voffA);
            PG8_WAIT_L(8); PG8_BAR; PG8_WAIT_L(0); PG8_MMA(0, 0, At, B0); PG8_BAR; PG8_SCHED;
            PG8_LDB(B1, 0, 1); PG8_STAGE(PG8_SB(0, 0), b2, voffB);
            PG8_BAR; PG8_WAIT_L(0); PG8_MMA(0, 1, At, B1); PG8_BAR;
            PG8_LDA(At, 0, 1); PG8_STAGE(PG8_SA(0, 0), a2, voffA);
            PG8_BAR; PG8_WAIT_L(0); PG8_MMA(1, 0, At, B0); PG8_BAR; PG8_SCHED;
            PG8_STAGE(PG8_SB(0, 1), b2 + hstep, voffB);
            PG8_WAIT_V(6); PG8_BAR; PG8_MMA(1, 1, At, B1); PG8_BAR;
            PG8_LDB(B0, 1, 0); PG8_SCHED; PG8_LDA(At, 1, 0); PG8_STAGE(PG8_SA(0, 1), a2 + hstep, voffA);
            PG8_WAIT_L(8); PG8_BAR; PG8_WAIT_L(0); PG8_MMA(0, 0, At, B0); PG8_BAR; PG8_SCHED;
            PG8_LDB(B1, 1, 1); PG8_STAGE(PG8_SB(1, 0), b3, voffB);
            PG8_BAR; PG8_WAIT_L(0); PG8_MMA(0, 1, At, B1); PG8_BAR;
            PG8_LDA(At, 1, 1); PG8_STAGE(PG8_SA(1, 0), a3, voffA);
            PG8_BAR; PG8_WAIT_L(0); PG8_MMA(1, 0, At, B0); PG8_BAR; PG8_SCHED;
            PG8_STAGE(PG8_SB(1, 1), b3 + hstep, voffB);
            PG8_WAIT_V(6); PG8_BAR; PG8_MMA(1, 1, At, B1); PG8_BAR;
        }
        E(acc, cur, wr, wc, fr, fq);
        if (!has_next) break;
        if (!E.keep(cur)) {
#pragma unroll
        for (int a = 0; a < 2; ++a)
#pragma unroll
            for (int b = 0; b < 2; ++b)
#pragma unroll
                for (int m = 0; m < 4; ++m)
#pragma unroll
                    for (int n = 0; n < 2; ++n) acc[a][b][m][n] = (f32x4){0.f, 0.f, 0.f, 0.f};
        }
        cur = nxt; cA = nA; cB = nB; ++ui;
    }
    PG8_WAIT_V(0);
    if (wr == 0) PG8_BAR;
    PG8_BAR;
#undef PG8_SA
#undef PG8_SB
#undef PG8_STAGE
#undef PG8_LDA
#undef PG8_LDB
#undef PG8_MMA
#undef PG8_WAIT_V
#undef PG8_WAIT_L
#undef PG8_BAR
#undef PG8_SCHED
}
}
using pg8::Unit;

template <int ACT> __device__ __forceinline__ float actf(float v) { return ACT == 1 ? v * sigm(v) : (ACT == 2 ? sigm(v) : v); }
template <int ACT> __device__ __forceinline__ void store_tile_bf16(const f32x4 (&acc)[2][2][4][2], bf16_t* base  , int ld) {
#pragma unroll
    for (int ai = 0; ai < 2; ++ai)
#pragma unroll
        for (int m = 0; m < 4; ++m) { bf16_t* rowp = base + (size_t)(ai * 128 + m * 16) * ld;
#pragma unroll
            for (int bj = 0; bj < 2; ++bj) { const f32x4 v0 = acc[ai][bj][m][0], v1 = acc[ai][bj][m][1]; u32x4 w;
                w.x = cvt_pk_bf16(actf<ACT>(v0[0]), actf<ACT>(v0[1])); w.y = cvt_pk_bf16(actf<ACT>(v0[2]), actf<ACT>(v0[3]));
                w.z = cvt_pk_bf16(actf<ACT>(v1[0]), actf<ACT>(v1[1])); w.w = cvt_pk_bf16(actf<ACT>(v1[2]), actf<ACT>(v1[3]));
                *(GAS u32x4*)(rowp + bj * 128) = w; } }
}
struct EpiG1 {
    static constexpr bool PERM = true;
    __device__ __forceinline__ bool keep(const Unit&) const { return false; }
    unsigned char *ws, *outb;
    __device__ __forceinline__ void operator()(const f32x4 (&acc)[2][2][4][2], const Unit& u, int wr, int wc, int fr, int fq) const {
        unsigned char* w = uniform_ptr(ws); unsigned char* ob = uniform_ptr(outb); asm volatile("" : "+s"(w), "+s"(ob));
        const int row0 = u.pm * 256 + wr * 64 + fr, pn = u.pn, cw = wc * 32 + 8 * fq;
        if (pn < 8) {
            bf16_t* base = (bf16_t*)(w + OFF_U) + (size_t)row0 * 1024 + pn * 128 + cw;
#pragma unroll
            for (int ai = 0; ai < 2; ++ai)
#pragma unroll
                for (int m = 0; m < 4; ++m) { const f32x4 a0 = acc[ai][0][m][0], a1 = acc[ai][0][m][1], g0 = acc[ai][1][m][0], g1 = acc[ai][1][m][1]; u32x4 wv;
                    wv.x = cvt_pk_bf16(a0[0] * sigm(g0[0]), a0[1] * sigm(g0[1])); wv.y = cvt_pk_bf16(a0[2] * sigm(g0[2]), a0[3] * sigm(g0[3]));
                    wv.z = cvt_pk_bf16(a1[0] * sigm(g1[0]), a1[1] * sigm(g1[1])); wv.w = cvt_pk_bf16(a1[2] * sigm(g1[2]), a1[3] * sigm(g1[3]));
                    *(GAS u32x4*)(base + (size_t)(ai * 128 + m * 16) * 1024) = wv; }
        } else if (pn < 12) store_tile_bf16<1>(acc, (bf16_t*)(w + OFF_OGC) + (size_t)row0 * 1024 + (pn - 8) * 256 + cw, 1024);
        else if (pn < 25) store_tile_bf16<0>(acc, (bf16_t*)(w + OFF_RKVL) + (size_t)row0 * LDR + (pn - 12) * 256 + cw, LDR);
        else if (pn < 29) store_tile_bf16<1>(acc, (bf16_t*)(w + OFF_OGR) + (size_t)row0 * 1024 + (pn - 25) * 256 + cw, 1024);
        else if (pn < 33) store_tile_bf16<2>(acc, (bf16_t*)(w + OFF_GC) + (size_t)row0 * 1024 + (pn - 29) * 256 + cw, 1024);
        else store_tile_bf16<2>(acc, (bf16_t*)(ob + 64 * MiB) + (size_t)row0 * 1024 + (pn - 33) * 256 + cw, 1024);
    }
};
struct EpiLora {
    static constexpr bool PERM = true;
    __device__ __forceinline__ bool keep(const Unit&) const { return false; }
    bf16_t *DW, *AP;
    __device__ __forceinline__ void operator()(const f32x4 (&acc)[2][2][4][2], const Unit& u, int wr, int wc, int fr, int fq) const {
        const int row0 = u.pm * 256 + wr * 64 + fr, cw = wc * 32 + 8 * fq;
        bf16_t* base = (u.pn < 4 ? DW + (size_t)u.pn * 256 : AP + (size_t)(u.pn - 4) * 256) + (size_t)row0 * 1024 + cw;
        store_tile_bf16<0>(acc, base, 1024);
    }
};
struct EpiG2 {
    static constexpr bool PERM = true;
    const bf16_t *GC, *GR; bf16_t* M;
    __device__ __forceinline__ bool keep(const Unit& u) const { return u.kind == 0; }
    __device__ __forceinline__ void operator()(f32x4 (&acc)[2][2][4][2], const Unit& u, int wr, int wc, int fr, int fq) const {
        const size_t off0 = (size_t)(u.pm * 256 + wr * 64 + fr) * 1024 + u.pn * 256 + wc * 32 + 8 * fq;
#pragma unroll
        for (int ai = 0; ai < 2; ++ai)
#pragma unroll
        for (int mh = 0; mh < 2; ++mh) {
            u32x4 grv[4][2];
#pragma unroll
            for (int m = 2 * mh; m < 2 * mh + 2; ++m)
#pragma unroll
                for (int bj = 0; bj < 2; ++bj) grv[m][bj] = *(const GAS u32x4*)(GR + off0 + (size_t)(ai * 128 + m * 16) * 1024 + bj * 128);
            if (u.kind == 0) {
                u32x4 gcv[4][2];
#pragma unroll
                for (int m = 2 * mh; m < 2 * mh + 2; ++m)
#pragma unroll
                    for (int bj = 0; bj < 2; ++bj) gcv[m][bj] = *(const GAS u32x4*)(GC + off0 + (size_t)(ai * 128 + m * 16) * 1024 + bj * 128);
#pragma unroll
                for (int m = 2 * mh; m < 2 * mh + 2; ++m)
#pragma unroll
                    for (int bj = 0; bj < 2; ++bj) { const u32x4 gr = grv[m][bj], gc = gcv[m][bj]; f32x4& v0 = acc[ai][bj][m][0]; f32x4& v1 = acc[ai][bj][m][1];
                        const f32x4 r0 = {bflo(gr.x), bfhi(gr.x), bflo(gr.y), bfhi(gr.y)}, r1 = {bflo(gr.z), bfhi(gr.z), bflo(gr.w), bfhi(gr.w)};
                        const f32x4 c0 = {bflo(gc.x), bfhi(gc.x), bflo(gc.y), bfhi(gc.y)}, c1 = {bflo(gc.z), bfhi(gc.z), bflo(gc.w), bfhi(gc.w)};
#pragma unroll
                        for (int j = 0; j < 4; ++j) { v0[j] *= c0[j] * __builtin_amdgcn_rcpf(fmaxf(r0[j], 1e-30f)); v1[j] *= c1[j] * __builtin_amdgcn_rcpf(fmaxf(r1[j], 1e-30f)); } }
            } else {
#pragma unroll
                for (int m = 2 * mh; m < 2 * mh + 2; ++m)
#pragma unroll
                    for (int bj = 0; bj < 2; ++bj) { const u32x4 gr = grv[m][bj]; const f32x4 v0 = acc[ai][bj][m][0], v1 = acc[ai][bj][m][1];
                        const f32x4 r0 = {bflo(gr.x), bfhi(gr.x), bflo(gr.y), bfhi(gr.y)}, r1 = {bflo(gr.z), bfhi(gr.z), bflo(gr.w), bfhi(gr.w)};
                        const f32x4 m0 = v0 * r0, m1 = v1 * r1; u32x4 w;
                        w.x = cvt_pk_bf16(m0[0], m0[1]); w.y = cvt_pk_bf16(m0[2], m0[3]); w.z = cvt_pk_bf16(m1[0], m1[1]); w.w = cvt_pk_bf16(m1[2], m1[3]);
                        *(GAS u32x4*)(M + off0 + (size_t)(ai * 128 + m * 16) * 1024 + bj * 128) = w; }
            }
        }
    }
};
struct EpiG3 {
    static constexpr bool PERM = false;
    const float *x, *mod, *fg; float* out; float* rowss; unsigned* pcnt;
    __device__ __forceinline__ bool keep(const Unit&) const { return false; }
    __device__ __forceinline__ void operator()(f32x4 (&acc)[2][2][4][2], const Unit& u, int wr, int wc, int fr, int fq) const {
        const int col0 = u.pn * 256 + wc * 32 + 4 * fq, row0 = u.pm * 256 + wr * 64 + fr; const size_t off0 = (size_t)row0 * 1024 + col0;
        const float* gp = mod + (size_t)(u.pm >> 3) * 3072 + 2048 + col0;
        { f32x4 gv[2][2];
#pragma unroll
        for (int bj = 0; bj < 2; ++bj)
#pragma unroll
            for (int n = 0; n < 2; ++n) gv[bj][n] = *(const GAS f32x4*)(gp + bj * 128 + n * 16);
#pragma unroll
        for (int ai = 0; ai < 2; ++ai)
#pragma unroll
            for (int m = 0; m < 4; ++m) { float ps = 0.f;
#pragma unroll
                for (int bj = 0; bj < 2; ++bj)
#pragma unroll
                    for (int n = 0; n < 2; ++n) { const size_t off = off0 + (size_t)(ai * 128 + m * 16) * 1024 + bj * 128 + n * 16;
                        const f32x4 v = *(const GAS f32x4*)(x + off) + gv[bj][n] * acc[ai][bj][m][n]; acc[ai][bj][m][n] = v; ps += v[0] * v[0] + v[1] * v[1] + v[2] * v[2] + v[3] * v[3]; }
                ps += __shfl_xor(ps, 16); ps += __shfl_xor(ps, 32);
                if (fq == 0) __hip_atomic_fetch_add(rowss + row0 + ai * 128 + m * 16, ps, __ATOMIC_RELAXED, __HIP_MEMORY_SCOPE_AGENT); } }
        asm volatile("s_waitcnt vmcnt(0)" ::: "memory");
        unsigned* pc = pcnt + u.pm * 2 + wr;
        if (fr == 0 && fq == 0) __hip_atomic_fetch_add(pc, 1u, __ATOMIC_RELAXED, __HIP_MEMORY_SCOPE_AGENT);
        { unsigned sp = 0; while (__hip_atomic_load(pc, __ATOMIC_RELAXED, __HIP_MEMORY_SCOPE_AGENT) < 16u && ++sp < (1u << 22)) __builtin_amdgcn_s_sleep(1); }
#pragma unroll
        for (int ai = 0; ai < 2; ++ai)
#pragma unroll
            for (int m = 0; m < 4; ++m) { const float ss = __hip_atomic_load(rowss + row0 + ai * 128 + m * 16, __ATOMIC_RELAXED, __HIP_MEMORY_SCOPE_AGENT);
                const float rstd = __builtin_amdgcn_rsqf(ss * (1.f / 1024.f) + 1e-6f);
#pragma unroll
                for (int bj = 0; bj < 2; ++bj)
#pragma unroll
                    for (int n = 0; n < 2; ++n) { const size_t off = off0 + (size_t)(ai * 128 + m * 16) * 1024 + bj * 128 + n * 16;
                        *(GAS f32x4*)(out + off) = acc[ai][bj][m][n] * rstd * *(const GAS f32x4*)(fg + col0 + bj * 128 + n * 16); } }
    }
};

__device__ void phase_mod(const Params& p, unsigned char* smem) {
    if (blockIdx.x >= 48) return;
    float* sc = (float*)smem;
    float* red = sc + 16384;
    const int tid = tid_opaque(), w = tid >> 6, lane = tid & 63;
    for (int i = tid; i < 16384; i += 512) { const int b = i >> 10, d = i & 1023; const float cv = p.c[i]; sc[d * 16 + b] = cv * sigm(cv); }
    __syncthreads();
    const int e = blockIdx.x * 64 + lane;
    float acc[16];
#pragma unroll
    for (int b = 0; b < 16; ++b) acc[b] = 0.f;
    for (int d0 = w * 128; d0 < w * 128 + 128; d0 += 16) {
        float wvs[16];
#pragma unroll
        for (int u = 0; u < 16; ++u) wvs[u] = p.ada_w[(size_t)(d0 + u) * 3072 + e];
#pragma unroll
        for (int u = 0; u < 16; ++u) { const int d = d0 + u; const float wv = wvs[u];
        const f32x4* s4 = (const f32x4*)(sc + d * 16);
#pragma unroll
        for (int q = 0; q < 4; ++q) { const f32x4 s = s4[q]; acc[4 * q] += s[0] * wv; acc[4 * q + 1] += s[1] * wv; acc[4 * q + 2] += s[2] * wv; acc[4 * q + 3] += s[3] * wv; }
        }
    }
#pragma unroll
    for (int b = 0; b < 16; ++b) red[(w * 16 + b) * 64 + lane] = acc[b];
    __syncthreads();
    float* mod = (float*)(p.ws + OFF_MOD);
    for (int i = tid; i < 1024; i += 512) { const int b = i >> 6, l = i & 63; float s = 0.f;
#pragma unroll
        for (int ww = 0; ww < 8; ++ww) s += red[(ww * 16 + b) * 64 + l];
        mod[b * 3072 + blockIdx.x * 64 + l] = s + p.ada_b[blockIdx.x * 64 + l]; }
    __syncthreads();
}
__device__ __forceinline__ void transpose_tile(const float* src, int ld, int n_src0, int k0, bf16_t* dst, int n_dst0, float* tile) {
    const int tid = tid_opaque();
#pragma unroll
    for (int r = 0; r < 2; ++r) { const int i = (tid >> 4) + 32 * r, j4 = (tid & 15) * 4;
        f32x4 v = {0.f, 0.f, 0.f, 0.f}; if (n_src0 >= 0) v = *(const f32x4*)(src + (size_t)(k0 + i) * ld + n_src0 + j4);
        tile[i * 65 + j4] = v[0]; tile[i * 65 + j4 + 1] = v[1]; tile[i * 65 + j4 + 2] = v[2]; tile[i * 65 + j4 + 3] = v[3]; }
    __syncthreads();
    const int j = tid >> 3, i8 = (tid & 7) * 8; u32x4 w;
    w.x = cvt_pk_bf16(tile[(i8 + 0) * 65 + j], tile[(i8 + 1) * 65 + j]); w.y = cvt_pk_bf16(tile[(i8 + 2) * 65 + j], tile[(i8 + 3) * 65 + j]);
    w.z = cvt_pk_bf16(tile[(i8 + 4) * 65 + j], tile[(i8 + 5) * 65 + j]); w.w = cvt_pk_bf16(tile[(i8 + 6) * 65 + j], tile[(i8 + 7) * 65 + j]);
    *(u32x4*)(dst + (size_t)(n_dst0 + j) * 1024 + k0 + i8) = w;
    __syncthreads();
}
__device__ void phase_weights(const Params& p, unsigned char* smem) {
    float* tile = (float*)smem;
    for (int i = blockIdx.x * 512 + threadIdx.x; i < T + 256; i += gridDim.x * 512) ((unsigned*)(p.ws + OFF_ROWSS))[i] = 0u;
    bf16_t* WinT = (bf16_t*)(p.ws + OFF_WINT); bf16_t* W2T = (bf16_t*)(p.ws + OFF_W2T); bf16_t* WoT = (bf16_t*)(p.ws + OFF_WOT); bf16_t* LBt = (bf16_t*)(p.ws + OFF_LBT);
    constexpr int NT1 = (N1 / 64) * 16;
    const bool bal = (gridDim.x == 256); const int nb = blockIdx.x;
    const int first = bal ? (nb >= 48 ? nb - 48 : 2704 + nb) : nb, stride = bal ? (nb >= 48 ? 208 : 48) : (int)gridDim.x, last = bal ? (nb >= 48 ? 2704 : 3136) : NT1 + 768;
    for (int idx = first; idx < last; idx += stride) {
        if (idx < NT1) { const int a = idx >> 4, kt = idx & 15, n0 = a * 64; int src;
            if (n0 < 2048) { const int j = n0 >> 8, wi = n0 & 255; src = wi < 128 ? 128 * j + wi : 1024 + 128 * j + wi - 128; }
            else if (n0 < 6272) src = n0; else if (n0 < 6400) src = -1; else src = n0 - 128;
            transpose_tile(p.w_in, 9344, src, kt * 64, WinT, n0, tile);
        } else { const int r = idx - NT1, which = r >> 8, a = (r >> 4) & 15, kt = r & 15;
            const float* src = which == 0 ? p.w_conv_out : (which == 1 ? p.w_rwkv_out : p.w_out);
            bf16_t* dst = which == 0 ? W2T : (which == 1 ? W2T + (size_t)1024 * 1024 : WoT);
            transpose_tile(src, 1024, a * 64, kt * 64, dst, a * 64, tile); }
    }
    for (int idx = blockIdx.x * 512 + tid_opaque(); idx < 2048 * 128; idx += gridDim.x * 512) { const int n = idx >> 7, k = idx & 127; float v = 0.f;
        if (n < 1024) { if (k < 64) v = p.rwkv_w2[k * 1024 + n]; } else { if (k >= 64) v = p.rwkv_a2[(k - 64) * 1024 + n - 1024]; }
        LBt[idx] = f2bf(v); }
}
__device__ void phase_h(const Params& p) {
    const int tid = tid_opaque(), w = tid >> 6, lane = tid & 63;
    const float* mod = (const float*)(p.ws + OFF_MOD); bf16_t* Hh = (bf16_t*)p.out;
    for (int tok = blockIdx.x * 8 + w; tok < T; tok += gridDim.x * 8) {
        const int b = tok >> 11; const float* xr = p.x + (size_t)tok * 1024; f32x4 v[4]; float ss = 0.f;
#pragma unroll
        for (int q = 0; q < 4; ++q) { v[q] = *(const f32x4*)(xr + q * 256 + lane * 4); ss += v[q][0] * v[q][0] + v[q][1] * v[q][1] + v[q][2] * v[q][2] + v[q][3] * v[q][3]; }
        ss = wave_sum(ss); const float rstd = rsqrtf(ss * (1.f / 1024.f) + 1e-6f);
#pragma unroll
        for (int q = 0; q < 4; ++q) { const int col = q * 256 + lane * 4; const f32x4 g = *(const f32x4*)(p.norm_g + col), sh = *(const f32x4*)(mod + b * 3072 + col), sc = *(const f32x4*)(mod + b * 3072 + 1024 + col);
            const f32x4 y = v[q] * rstd * g * (sc + 1.f) + sh; u32x2 o; o.x = cvt_pk_bf16(y[0], y[1]); o.y = cvt_pk_bf16(y[2], y[3]);
            *(u32x2*)(Hh + (size_t)tok * 1024 + col) = o; }
    }
}
__device__ void phase_conv(const Params& p, unsigned char* smem) {
    const int tid = tid_opaque(), w = tid >> 6, lane = tid & 63, c0 = tid * 2;
    const bf16_t* U = (const bf16_t*)(p.ws + OFF_U); bf16_t* OGC = (bf16_t*)(p.ws + OFF_OGC);
    float* part = (float*)smem;
    float* stat = part + 32 * 512;
    f32x2 wk[31];
#pragma unroll
    for (int j = 0; j < 31; ++j) wk[j] = *(const f32x2*)(p.conv_k + j * 1024 + c0);
    const f32x2 cb = *(const f32x2*)(p.conv_b + c0), lg = *(const f32x2*)(p.conv_ln_g + c0), lb = *(const f32x2*)(p.conv_ln_b + c0);
    for (int tile = blockIdx.x; tile < T / 16; tile += gridDim.x) {
        const int b = tile >> 7, t0 = (tile & 127) * 16; const size_t row0 = (size_t)b * SEQ + t0;
        f32x2 u[46];
#pragma unroll
        for (int i = 0; i < 46; ++i) { const int t = t0 - 30 + i; unsigned v = 0u; if (t >= 0) v = *(const unsigned*)(U + ((size_t)b * SEQ + t) * 1024 + c0); u[i] = (f32x2){bflo(v), bfhi(v)}; }
        f32x2 o[16];
#pragma unroll
        for (int i = 0; i < 16; ++i) { f32x2 a = cb;
#pragma unroll
            for (int j = 0; j < 31; ++j) a = wk[j] * u[i + j] + a;
            o[i] = a; }
#pragma unroll
        for (int i = 0; i < 16; ++i) { part[i * 512 + tid] = o[i].x + o[i].y; part[(16 + i) * 512 + tid] = o[i].x * o[i].x + o[i].y * o[i].y; }
        __syncthreads();
#pragma unroll
        for (int q = 0; q < 4; ++q) { const int v = 4 * w + q; float s = 0.f;
#pragma unroll
            for (int r = 0; r < 8; ++r) s += part[v * 512 + lane + 64 * r];
            s = wave_sum(s); if (lane == 0) stat[v] = s; }
        __syncthreads();
#pragma unroll
        for (int i = 0; i < 16; ++i) { const float mean = stat[i] * (1.f / 1024.f), var = stat[16 + i] * (1.f / 1024.f) - mean * mean, rstd = __builtin_amdgcn_rsqf(var + 1e-5f);
            float y0 = (o[i].x - mean) * rstd * lg.x + lb.x, y1 = (o[i].y - mean) * rstd * lg.y + lb.y; y0 *= sigm(y0); y1 *= sigm(y1);
            bf16_t* gp = OGC + (row0 + i) * 1024 + c0; const unsigned og = *(const unsigned*)gp;
            *(unsigned*)gp = cvt_pk_bf16(y0 * bflo(og), y1 * bfhi(og)); }
    }
    const bf16_t* RK = (const bf16_t*)(p.ws + OFF_RKVL); bf16_t* AL = (bf16_t*)(p.ws + OFF_ALORA);
    for (int idx = blockIdx.x * 512 + tid; idx < T * 128; idx += gridDim.x * 512) { const int t = idx >> 7, j = idx & 127;
        const float z = bf2f(RK[(size_t)t * LDR + 3072 + j]), pv = (t & (SEQ - 1)) ? bf2f(RK[(size_t)(t - 1) * LDR + 3072 + j]) : 0.f;
        const float s = z + p.rwkv_mu[3072 + j] * (pv - z); const float val = j < 64 ? tanhf(s) : s;
        AL[(size_t)t * 128 + j] = f2bf(val); }
}
constexpr int SCH = 32, SNCH = SEQ / SCH, SREC = 272;
struct ScanRaw { unsigned v[8], wa[8]; };
struct ScanOps { f32x4 a[8], b[4], k[4]; };
struct ScanC { float mu_r, mu_k, mu_v, w0c, a0c, kkc, kac, rkc, gng, gnb; };
__device__ __forceinline__ void scan_load_raw(ScanRaw& R, f32x2 (&S)[8], const bf16_t* RK, const bf16_t* DW, const bf16_t* AP, int b, int c, int pw, int ch) {
#pragma unroll
    for (int i = 0; i < 8; ++i) { const int t = c * SCH + 8 * pw + i; const size_t row = (size_t)b * SEQ + t; const bf16_t* rp = RK + row * LDR + ch;
        const bf16_t* rq = t > 0 ? rp - LDR : rp;
        S[i >> 1][i & 1] = __uint_as_float((unsigned)rp[0] | ((unsigned)rq[0] << 16)); S[4 + (i >> 1)][i & 1] = __uint_as_float((unsigned)rp[1024] | ((unsigned)rq[1024] << 16));
        R.v[i] = (unsigned)rp[2048] | ((unsigned)rq[2048] << 16); R.wa[i] = (unsigned)DW[row * 1024 + ch] | ((unsigned)AP[row * 1024 + ch] << 16); }
}
__device__ __forceinline__ void scan_prep(const ScanRaw& R, const f32x2 (&S)[8], const ScanC& C, int c, int pw, int lane, unsigned seq, float* rec, float* vbuf, f32x4* scl, float* wtot, float* ptot, volatile unsigned* flag) {
    float kkA[8], rA[8], nbA[8], kpA[8], LA[8]; float L = 1.f;
#pragma unroll
    for (int i = 0; i < 8; ++i) { const int tt = 8 * pw + i, t = c * SCH + tt;
        const unsigned Rr = __float_as_uint(S[i >> 1][i & 1]), Rk = __float_as_uint(S[4 + (i >> 1)][i & 1]);
        float r = bflo(Rr), k = bflo(Rk), v = bflo(R.v[i]); const float pm = t > 0 ? 1.f : 0.f;
        const float r1 = pm * bfhi(Rr), k1 = pm * bfhi(Rk), v1 = pm * bfhi(R.v[i]);
        r += C.mu_r * (r1 - r); k += C.mu_k * (k1 - k); v += C.mu_v * (v1 - v);
        const float wpre = C.w0c + bflo(R.wa[i]), apre = C.a0c + bfhi(R.wa[i]);
        const float decay = __expf(-0.60653066f * sigm(wpre)), a = sigm(apre);
        const float kkv = k * C.kkc, n2 = wave_sum(kkv * kkv), kk = kkv * __builtin_amdgcn_rsqf(fmaxf(n2, 1e-24f));
        const float kp = k * (1.f + (a - 1.f) * C.kac), bv = kk * a;
        const float br = wave_sum(bv * r), kr = wave_sum(kp * r), bonus = wave_sum(r * kp * C.rkc);
        L *= decay; kkA[i] = kk; rA[i] = r; nbA[i] = -bv; kpA[i] = kp; LA[i] = L;
        vbuf[tt * 64 + lane] = v;
        if (lane == 0) scl[tt] = (f32x4){-br, kr, bonus, 0.f};
        if (i & 1) __builtin_amdgcn_sched_barrier(0);
    }
    wtot[pw * 64 + lane] = L;
    asm volatile("s_waitcnt lgkmcnt(0)" ::: "memory");
    if (lane == 0) flag[pw] = seq;
    float Pw = 1.f;
    for (int ww = 0; ww < pw; ++ww) { while (flag[ww] != seq) __builtin_amdgcn_s_sleep(1);
        asm volatile("" ::: "memory"); Pw *= wtot[ww * 64 + lane]; }
    if (pw == 3) ptot[lane] = Pw * L;
    float Pprev = Pw;
#pragma unroll
    for (int i = 0; i < 8; ++i) { const int tt = 8 * pw + i; const float Pt = Pw * LA[i], ip = __builtin_amdgcn_rcpf(Pt);
        float* rc = rec + tt * SREC + (lane >> 4) * 68; const int e = lane & 15;
        *(f32x2*)(rc + 2 * e) = (f32x2){Pprev * kkA[i], Pt * rA[i]}; rc[32 + e] = nbA[i] * ip; rc[48 + e] = kpA[i] * ip;
        Pprev = Pt; }
}
__device__ __forceinline__ void scan_post(const bf16_t (&og)[8], bf16_t* dst0, const ScanC& C, int pw, int lane, const float* obuf, const float* vbuf, const f32x4* scl) {
#pragma unroll
    for (int i = 0; i < 8; ++i) { const int tt = pw + 4 * i;
        const float o = obuf[tt * 64 + lane], mean = wave_sum(o) * (1.f / 64.f), d = o - mean, var = wave_sum(d * d) * (1.f / 64.f);
        float y = d * __builtin_amdgcn_rsqf(var + 64e-5f) * C.gng + C.gnb; y += scl[tt].z * vbuf[tt * 64 + lane];
        dst0[(size_t)i * 4096] = f2bf(y * bf2f(og[i])); }
}
__device__ __forceinline__ void scan_load_ops(ScanOps& o, const f32x4* rq) {
#pragma unroll
    for (int j = 0; j < 8; ++j) o.a[j] = rq[j];
#pragma unroll
    for (int j = 0; j < 4; ++j) { o.b[j] = rq[8 + j]; o.k[j] = rq[12 + j]; }
}
__device__ __forceinline__ void scan_step(f32x2 (&S)[8], ScanOps& q, const f32x4* rn, const float v, const bool lead, const f32x2 sc, float* obuf, float* dump, int tt, int srow) {
    f32x2 vv = {v, v}; asm volatile("" : "+v"(vv));
    f32x2 d0 = S[0].x * (f32x2){q.a[0][0], q.a[0][1]}, d1 = S[0].y * (f32x2){q.a[0][2], q.a[0][3]}, d2 = S[1].x * (f32x2){q.a[1][0], q.a[1][1]}, d3 = S[1].y * (f32x2){q.a[1][2], q.a[1][3]};
#pragma unroll
    for (int j = 2; j < 8; j += 2) { d0 += S[j].x * (f32x2){q.a[j][0], q.a[j][1]}; d1 += S[j].y * (f32x2){q.a[j][2], q.a[j][3]};
        d2 += S[j + 1].x * (f32x2){q.a[j + 1][0], q.a[j + 1][1]}; d3 += S[j + 1].y * (f32x2){q.a[j + 1][2], q.a[j + 1][3]}; }
#pragma unroll
    for (int j = 0; j < 8; ++j) q.a[j] = rn[j];
    const f32x2 d = (d0 + d1) + (d2 + d3);
    float sk = d.x, o = d.y;
    sk = dpp_add<0xB1>(sk); o = dpp_add<0xB1>(o); sk = dpp_add<0x4E>(sk); o = dpp_add<0x4E>(o);
#pragma unroll
    for (int j = 0; j < 4; ++j) { S[2 * j] += sk * (f32x2){q.b[j][0], q.b[j][1]}; S[2 * j + 1] += sk * (f32x2){q.b[j][2], q.b[j][3]}; }
#pragma unroll
    for (int j = 0; j < 4; ++j) { S[2 * j] += vv * (f32x2){q.k[j][0], q.k[j][1]}; S[2 * j + 1] += vv * (f32x2){q.k[j][2], q.k[j][3]}; }
#pragma unroll
    for (int j = 0; j < 4; ++j) { q.b[j] = rn[8 + j]; q.k[j] = rn[12 + j]; }
    LAS float* op = lead ? (LAS float*)(obuf + tt * 64 + srow) : (LAS float*)dump; *op = o + sk * sc.x + v * sc.y;
}
__device__ void phase_scan(const Params& p, unsigned char* smem) {
    const int tid = tid_opaque(), w = tid >> 6, lane = tid & 63, g = lane & 3, srow = (w & 3) * 16 + (lane >> 2), pw = w & 3;
    const bool cons = w < 4, lead = (g == 0);
    float* recb = (float*)smem;
    float* vbufb = recb + 2 * SCH * SREC;
    float* obufb = vbufb + 3 * SCH * 64;
    f32x4* sclb = (f32x4*)(obufb + 2 * SCH * 64);
    float* wtot = (float*)(sclb + 3 * SCH);
    float* ptotb = wtot + 256;
    volatile unsigned* flag = (volatile unsigned*)(ptotb + 128);
    float* dump = (float*)(ptotb + 128) + 8;
    const bf16_t* RK = (const bf16_t*)(p.ws + OFF_RKVL); const bf16_t* DW = (const bf16_t*)(p.ws + OFF_DW); const bf16_t* AP = (const bf16_t*)p.out;
    bf16_t* OGR = (bf16_t*)(p.ws + OFF_OGR);
    unsigned seq = 0;
    for (int bh = blockIdx.x; bh < 256; bh += gridDim.x) {
        const int b = bh >> 4, h = bh & 15, ch = h * 64 + lane;
        const ScanC C{p.rwkv_mu[ch], p.rwkv_mu[1024 + ch], p.rwkv_mu[2048 + ch], p.rwkv_w0[ch], p.rwkv_a0[ch], p.rwkv_k_k[ch], p.rwkv_k_a[ch], p.rwkv_r_k[ch], p.rwkv_gn_g[ch], p.rwkv_gn_b[ch]};
        f32x2 S[8];
#pragma unroll
        for (int i = 0; i < 8; ++i) S[i] = (f32x2){0.f, 0.f};
        ScanRaw R;
        if (tid < 4) flag[tid] = 0u;
        __syncthreads();
        ++seq;
        if (!cons) { scan_load_raw(R, S, RK, DW, AP, b, 0, pw, ch); scan_prep(R, S, C, 0, pw, lane, seq, recb, vbufb, sclb, wtot, ptotb, flag); scan_load_raw(R, S, RK, DW, AP, b, 1, pw, ch); }
        __syncthreads();
        for (int c = 0; c < SNCH; ++c) {
            const int cb = c & 1, c3 = c % 3, n3 = (c + 1) % 3, p3 = (c + 2) % 3;
            ++seq;
            if (cons) {
                const float* vb = vbufb + c3 * (SCH * 64); const f32x2* sc2 = (const f32x2*)(sclb + c3 * SCH); float* ob = obufb + cb * (SCH * 64);
                const f32x4* rq = (const f32x4*)(recb + cb * (SCH * SREC) + g * 68);
                ScanOps A; scan_load_ops(A, rq);
                float v0 = vb[srow]; f32x2 s0 = sc2[0];
                __builtin_amdgcn_s_setprio(3);
                for (int tt = 0; tt < SCH; ++tt) {
                    const int tn = tt + 1 < SCH ? tt + 1 : SCH - 1;
                    const float nv0 = vb[tn * 64 + srow]; const f32x2 ns0 = sc2[2 * tn];
                    scan_step(S, A, rq + tn * (SREC / 4), v0, lead, s0, ob, dump, tt, srow);
                    v0 = nv0; s0 = ns0;
                }
                __builtin_amdgcn_s_setprio(0);
                { const f32x4* pq = (const f32x4*)(ptotb + cb * 64 + g * 16);
#pragma unroll
                    for (int j = 0; j < 4; ++j) { const f32x4 pp = pq[j]; S[2 * j] *= (f32x2){pp[0], pp[1]}; S[2 * j + 1] *= (f32x2){pp[2], pp[3]}; } }
            } else {
                bf16_t og[8]; bf16_t* dst0 = OGR + ((size_t)b * SEQ + (c > 0 ? c - 1 : 0) * SCH + pw) * 1024 + ch;
#pragma unroll
                for (int i = 0; i < 8; ++i) og[i] = dst0[(size_t)i * 4096];
                if (c + 1 < SNCH) { scan_prep(R, S, C, c + 1, pw, lane, seq, recb + (cb ^ 1) * (SCH * SREC), vbufb + n3 * (SCH * 64), sclb + n3 * SCH, wtot, ptotb + (cb ^ 1) * 64, flag);
                    if (c + 2 < SNCH) scan_load_raw(R, S, RK, DW, AP, b, c + 2, pw, ch); }
                if (c > 0) scan_post(og, dst0, C, pw, lane, obufb + (cb ^ 1) * (SCH * 64), vbufb + p3 * (SCH * 64), sclb + p3 * SCH);
            }
            __syncthreads();
        }
        if (!cons) { const int cl = SNCH - 1; bf16_t og[8]; bf16_t* dst0 = OGR + ((size_t)b * SEQ + cl * SCH + pw) * 1024 + ch;
#pragma unroll
            for (int i = 0; i < 8; ++i) og[i] = dst0[(size_t)i * 4096];
            scan_post(og, dst0, C, pw, lane, obufb + (cl & 1) * (SCH * 64), vbufb + (cl % 3) * (SCH * 64), sclb + (cl % 3) * SCH); }
        __syncthreads();
    }
}
__device__ void phase_final(const Params& p) {
    const int tid = tid_opaque(), w = tid >> 6, lane = tid & 63;
    for (int tok = blockIdx.x * 8 + w; tok < T; tok += gridDim.x * 8) {
        float* xr = p.out + (size_t)tok * 1024; f32x4 v[4]; float ss = 0.f;
#pragma unroll
        for (int q = 0; q < 4; ++q) { v[q] = *(const f32x4*)(xr + q * 256 + lane * 4); ss += v[q][0] * v[q][0] + v[q][1] * v[q][1] + v[q][2] * v[q][2] + v[q][3] * v[q][3]; }
        ss = wave_sum(ss); const float rstd = rsqrtf(ss * (1.f / 1024.f) + 1e-6f);
#pragma unroll
        for (int q = 0; q < 4; ++q) { const int col = q * 256 + lane * 4; *(f32x4*)(xr + col) = v[q] * rstd * *(const f32x4*)(p.final_g + col); }
    }
}

template <int FIRST, int LAST> __global__ __launch_bounds__(512, 2) void mega(Params p) {
    extern __shared__ __attribute__((aligned(16))) unsigned char smem[];
    LAS unsigned char* lds = (LAS unsigned char*)smem;
    cg::grid_group grid = cg::this_grid();
    unsigned* bar = (unsigned*)(uniform_ptr(p.ws) + OFF_BAR);
    volatile LAS unsigned* st = (volatile LAS unsigned*)(lds + LDS_BYTES);
    if (threadIdx.x == 0) { st[0] = 0u; st[1] = 0u; (void)xb_add(&bar[XB_XCNT(xb_xcc_id())], 1u); }
    __syncthreads();
    if (p.ws == nullptr) grid.sync();
    unsigned char* ws = p.ws;
    const int G = gridDim.x, c = blockIdx.x;
    if (FIRST <= 0 && 0 < LAST) { phase_mod(p, smem); phase_weights(p, smem); }
    if (FIRST <= 1 && 1 < LAST) { if (FIRST < 1) grid_barrier(bar, st); phase_h(p); }
    if (FIRST <= 2 && 2 < LAST) { if (FIRST < 2) grid_barrier(bar, st);
        pg8::Sched1 S{T / 256, N1 / 256, G, c, (const char*)p.out, (const char*)(ws + OFF_WINT), (size_t)256 * 1024 * 2};
        EpiG1 E{ws, (unsigned char*)p.out};
        pg8::gemm_phase(lds, 1024, S, E); }
    if (FIRST <= 3 && 3 < LAST) { if (FIRST < 3) grid_barrier(bar, st); phase_conv(p, smem); }
    if (FIRST <= 4 && 4 < LAST) { if (FIRST < 4) grid_barrier(bar, st);
        pg8::Sched1 S{T / 256, 2048 / 256, G, c, (const char*)(ws + OFF_ALORA), (const char*)(ws + OFF_LBT), (size_t)256 * 128 * 2};
        EpiLora E{(bf16_t*)(ws + OFF_DW), (bf16_t*)p.out};
        pg8::gemm_phase(lds, 128, S, E); }
    if (FIRST <= 5 && 5 < LAST) { if (FIRST < 5) grid_barrier(bar, st); phase_scan(p, smem); }
    if (FIRST <= 6 && 6 < LAST) { if (FIRST < 6) grid_barrier(bar, st);
        pg8::Sched2 S{T / 256, 4, G, c, (const char*)(ws + OFF_OGC), (const char*)(ws + OFF_OGR), (const char*)(ws + OFF_W2T), (const char*)(ws + OFF_W2T + 2 * MiB), (size_t)256 * 1024 * 2};
        EpiG2 E{(const bf16_t*)(ws + OFF_GC), (const bf16_t*)((unsigned char*)p.out + 64 * MiB), (bf16_t*)(ws + OFF_M)};
        pg8::gemm_phase(lds, 1024, S, E); }
    if (FIRST <= 7 && 7 < LAST) { if (FIRST < 7) grid_barrier(bar, st);
        pg8::Sched1 S{T / 256, 4, G, c, (const char*)(ws + OFF_M), (const char*)(ws + OFF_WOT), (size_t)256 * 1024 * 2};
        EpiG3 E{p.x, (const float*)(ws + OFF_MOD), p.final_g, p.out, (float*)(ws + OFF_ROWSS), (unsigned*)(ws + OFF_PCNT)};
        pg8::gemm_phase(lds, 1024, S, E); }
}

template <int PH> static void launch_one(const Params& p, hipStream_t stream) {
    hipFuncSetAttribute((const void*)mega<PH, PH + 1>, hipFuncAttributeMaxDynamicSharedMemorySize, LDS_BYTES);
    mega<PH, PH + 1><<<256, 512, LDS_BYTES, stream>>>(p);
}

extern "C" void kernel_launch(void* const* d_in, const int* in_sizes, int n_in, void* d_out, int out_size, void* d_ws, size_t ws_size, hipStream_t stream) {
    Params p{};
    const float** f = (const float**)&p;
    for (int i = 0; i < 24; ++i) f[i] = (const float*)d_in[i];
    p.out = (float*)d_out; p.ws = (unsigned char*)d_ws;
    if (ws_size < WS_END) { fprintf(stderr, "workspace too small: %zu < %zu\n", ws_size, (size_t)WS_END); return; }
#if SINGLE_LAUNCH
    static int grid_blocks = 0;
    if (!grid_blocks) {
        int dev = 0, cus = 0, per_cu = 0;
        hipGetDevice(&dev);
        hipDeviceGetAttribute(&cus, hipDeviceAttributeMultiprocessorCount, dev);
        hipFuncSetAttribute((const void*)mega<0, NPHASE>, hipFuncAttributeMaxDynamicSharedMemorySize, LDS_BYTES + 16);
        hipOccupancyMaxActiveBlocksPerMultiprocessor(&per_cu, mega<0, NPHASE>, 512, LDS_BYTES + 16);
        grid_blocks = cus * (per_cu > 1 ? 1 : per_cu);
        if (grid_blocks > 256) grid_blocks = 256;
    }
    hipMemsetAsync((unsigned char*)d_ws + OFF_BAR, 0, 3456 * 4, stream);
    void* args[] = {(void*)&p};
    hipError_t e = hipLaunchCooperativeKernel((const void*)mega<0, NPHASE>, dim3(grid_blocks), dim3(512), args, LDS_BYTES + 16, stream);
    if (e != hipSuccess) fprintf(stderr, "cooperative launch failed: %s (grid %d)\n", hipGetErrorString(e), grid_blocks);
#else
    launch_one<0>(p, stream); launch_one<1>(p, stream); launch_one<2>(p, stream); launch_one<3>(p, stream); launch_one<4>(p, stream);
    launch_one<5>(p, stream); launch_one<6>(p, stream); launch_one<7>(p, stream); launch_one<8>(p, stream);
#endif
}
```

```cpp
#include <hip/hip_runtime.h>
#include <hip/hip_cooperative_groups.h>
#include <cstdio>
namespace cg = cooperative_groups;

#ifndef SINGLE_LAUNCH
#define SINGLE_LAUNCH 1
#endif

#define LAS __attribute__((address_space(3)))
#define GAS __attribute__((address_space(1)))
typedef unsigned short bf16_t;
typedef short bf16x8 __attribute__((ext_vector_type(8)));
typedef float f32x8 __attribute__((ext_vector_type(8)));
typedef float f32x4 __attribute__((ext_vector_type(4)));
typedef float f32x2 __attribute__((ext_vector_type(2)));
typedef unsigned u32x4 __attribute__((ext_vector_type(4)));
typedef unsigned u32x2 __attribute__((ext_vector_type(2)));

constexpr int T = 32768, DM = 1024, SEQ = 2048, NB_ = 16;
constexpr int N1 = 9472;
constexpr int LDR = 3328;
constexpr int LDS_BYTES = 131072;
constexpr int NPHASE = 9;

constexpr size_t MiB = 1u << 20;
constexpr size_t OFF_U = 0, OFF_OGC = 64 * MiB, OFF_RKVL = 128 * MiB, OFF_OGR = 336 * MiB, OFF_GC = 400 * MiB, OFF_WINT = 464 * MiB;
constexpr size_t OFF_ALORA = OFF_WINT + (size_t)N1 * 1024 * 2;
constexpr size_t OFF_W2T = OFF_ALORA + 16 * MiB, OFF_WOT = OFF_W2T + 4 * MiB, OFF_LBT = OFF_WOT + 2 * MiB, OFF_MOD = OFF_LBT + 1 * MiB;
constexpr size_t OFF_BAR = OFF_MOD + 16 * 3072 * 4;
constexpr size_t OFF_ROWSS = OFF_BAR + 3456 * 4 + 128;
constexpr size_t OFF_PCNT = OFF_ROWSS + (size_t)T * 4;
constexpr size_t WS_END = OFF_PCNT + 256 * 4;
constexpr size_t OFF_MP = OFF_RKVL, OFF_M = OFF_RKVL + 128 * MiB, OFF_DW = OFF_U;

struct Params {
    const float *x, *c, *ada_w, *ada_b, *norm_g, *w_in, *conv_k, *conv_b, *conv_ln_g, *conv_ln_b, *w_conv_out, *rwkv_mu, *rwkv_w0, *rwkv_w2, *rwkv_a0, *rwkv_a2,
        *rwkv_k_k, *rwkv_k_a, *rwkv_r_k, *rwkv_gn_g, *rwkv_gn_b, *w_rwkv_out, *w_out, *final_g;
    float* out;
    unsigned char* ws;
};

typedef __bf16 bf16x2_t __attribute__((ext_vector_type(2)));
__device__ __forceinline__ unsigned cvt_pk_bf16(float lo, float hi) { const bf16x2_t r = __builtin_convertvector((f32x2){lo, hi}, bf16x2_t); return __builtin_bit_cast(unsigned, r); }
__device__ __forceinline__ bf16_t f2bf(float f) { return (bf16_t)(cvt_pk_bf16(f, 0.f) & 0xffffu); }
__device__ __forceinline__ float bf2f(bf16_t b) { return __uint_as_float(((unsigned)b) << 16); }
__device__ __forceinline__ float bflo(unsigned v) { return __uint_as_float(v << 16); }
__device__ __forceinline__ float bfhi(unsigned v) { return __uint_as_float(v & 0xffff0000u); }
__device__ __forceinline__ float sigm(float x) { return __builtin_amdgcn_rcpf(1.f + __expf(-x)); }
__device__ __forceinline__ int tid_opaque() { int t = threadIdx.x; asm volatile("" : "+v"(t)); return t; }
__device__ __forceinline__ unsigned char* uniform_ptr(unsigned char* p) { const size_t v = (size_t)p; const unsigned lo = __builtin_amdgcn_readfirstlane((unsigned)v), hi = __builtin_amdgcn_readfirstlane((unsigned)(v >> 32)); return (unsigned char*)(((size_t)hi << 32) | lo); }
template <int CTRL> __device__ __forceinline__ float dpp_add(float v) { return v + __int_as_float(__builtin_amdgcn_update_dpp(0, __float_as_int(v), CTRL, 0xF, 0xF, true)); }
__device__ __forceinline__ float wave_sum(float v) {
    v = dpp_add<0xB1>(v); v = dpp_add<0x4E>(v); v = dpp_add<0x141>(v); v = dpp_add<0x140>(v);
    const int iv = __float_as_int(v);
    return (__int_as_float(__builtin_amdgcn_readlane(iv, 0)) + __int_as_float(__builtin_amdgcn_readlane(iv, 16))) + (__int_as_float(__builtin_amdgcn_readlane(iv, 32)) + __int_as_float(__builtin_amdgcn_readlane(iv, 48)));
}

#define XB_TMO      128
#define XB_XCNT(j)  (256  + 64 * (j))
#define XB_XSUB(j)  (1280 + 64 * (j))
#define XB_XGEN(j)  (2304 + 64 * (j))
#define XB_TOP      3328
#define XB_TOPGEN   3392
#define XB_WORDS    3456
#define XB_SPIN_CAP (1u << 22)
__device__ __forceinline__ unsigned xb_ld(unsigned* p)              { return __hip_atomic_load(p, __ATOMIC_RELAXED, __HIP_MEMORY_SCOPE_AGENT); }
__device__ __forceinline__ unsigned xb_add(unsigned* p, unsigned v) { return __hip_atomic_fetch_add(p, v, __ATOMIC_RELAXED, __HIP_MEMORY_SCOPE_AGENT); }
__device__ __forceinline__ unsigned xb_xcc_id() { return (unsigned)__builtin_amdgcn_s_getreg((3 << 11) | 20) & 0xFu; }
#define XB_SPIN(cond, bar) do { unsigned _sp = 0; while (cond) { __builtin_amdgcn_s_sleep(1); \
    if ((++_sp & 255u) == 0u) { if (xb_ld(&(bar)[XB_TMO])) break; if (_sp > XB_SPIN_CAP) { atomicAdd(&(bar)[XB_TMO], 1u); break; } } } } while (0)
__device__ __forceinline__ void xcd_barrier_complete(unsigned* bar, unsigned x, unsigned& nloc, unsigned& nx) {
    const unsigned G = gridDim.x; unsigned sum, cnt, mine, sp = 0u;
    for (;;) { sum = 0u; cnt = 0u; mine = 0u;
#pragma unroll
        for (unsigned j = 0; j < 16; ++j) { const unsigned c = xb_ld(&bar[XB_XCNT(j)]); sum += c; cnt += (c > 0u) ? 1u : 0u; mine = (j == x) ? c : mine; }
        if (sum == G) break;
        __builtin_amdgcn_s_sleep(1);
        if ((++sp & 255u) == 0u) { if (xb_ld(&bar[XB_TMO])) break; if (sp > XB_SPIN_CAP) { atomicAdd(&bar[XB_TMO], 1u); break; } } }
    nloc = mine > 0u ? mine : 1u; nx = cnt > 0u ? cnt : 1u;
}
__device__ __forceinline__ void grid_barrier(unsigned* bar, volatile LAS unsigned* st) {
    asm volatile("s_waitcnt vmcnt(0) lgkmcnt(0)" ::: "memory");
    __syncthreads();
    if (threadIdx.x == 0) {
        const unsigned x = xb_xcc_id();
        unsigned nloc = st[0], nx = st[1];
        if (nloc == 0u) { xcd_barrier_complete(bar, x, nloc, nx); st[0] = nloc; st[1] = nx; }
        const unsigned old = xb_add(&bar[XB_XSUB(x)], 1u);
        const unsigned gen = old / nloc;
        if (old + 1u == (gen + 1u) * nloc) {
            __builtin_amdgcn_fence(__ATOMIC_RELEASE, "agent");
            asm volatile("s_waitcnt vmcnt(0)" ::: "memory");
            const unsigned og = xb_add(&bar[XB_TOP], 1u);
            const unsigned tg = og / nx;
            if (og + 1u == (tg + 1u) * nx) xb_add(&bar[XB_TOPGEN], 1u);
            else XB_SPIN(xb_ld(&bar[XB_TOPGEN]) == tg, bar);
            __builtin_amdgcn_fence(__ATOMIC_ACQUIRE, "agent");
            xb_add(&bar[XB_XGEN(x)], 1u);
            asm volatile("s_waitcnt vmcnt(0)" ::: "memory");
        } else {
            XB_SPIN(xb_ld(&bar[XB_XGEN(x)]) == gen, bar);
            __builtin_amdgcn_fence(__ATOMIC_ACQUIRE, "agent");
            asm volatile("s_waitcnt vmcnt(0)" ::: "memory");
        }
    }
    __syncthreads();
}

namespace pg8 {
constexpr int BM = 256, BK = 64, HALF = 128, HTB = HALF * BK * 2, NXCD = 8, WGM = 8;
__host__ __device__ __forceinline__ int lds_byte(int r, int c) { const int st = (r >> 4) * 2 + (c >> 5), rr = r & 15, cc = c & 31, ob = rr * 64 + cc * 2; return st * 1024 + (ob ^ (((ob >> 9) & 1) << 5)); }
__host__ __device__ __forceinline__ void stage_rc(int b, int& R, int& C) { const int st = b / 1024, sb = b % 1024, swz = sb ^ (((sb >> 9) & 1) << 5); R = (st >> 1) * 16 + swz / 64; C = (st & 1) * 32 + (swz % 64) / 2; }
__host__ __device__ __forceinline__ int perm32(int rho) { const int n = rho >> 4, i = rho & 15; return 8 * (i >> 2) + 4 * n + (i & 3); }
struct Unit { int pm, pn, kind; };

__device__ __forceinline__ void map_unit(int L, int nM, int nN, Unit& u) {
    const int nwg = nM * nN; int wgid = L;
    { const int q = nwg / NXCD, r = nwg % NXCD, xcd = wgid % NXCD, off = wgid / NXCD; wgid = (xcd < r ? xcd * (q + 1) : r * (q + 1) + (xcd - r) * q) + off; }
    const int nig = WGM * nN, gid = wgid / nig, fm = gid * WGM, gsz = (nM - fm) < WGM ? (nM - fm) : WGM;
    u.pm = fm + ((wgid % nig) % gsz); u.pn = (wgid % nig) / gsz;
}
struct Sched1 {
    int nM, nN, G, c; const char* A; const char* Bt; size_t tstep;
    __device__ __forceinline__ bool next(int i, Unit& u) const { const long L = (long)i * G + c; if (L >= (long)nM * nN) return false; map_unit((int)L, nM, nN, u); u.kind = 0; return true; }
    __device__ __forceinline__ const char* aptr(const Unit& u) const { return A + (size_t)u.pm * tstep; }
    __device__ __forceinline__ const char* bptr(const Unit& u) const { return Bt + (size_t)u.pn * tstep; }
};
struct Sched2 {
    int nM, nN, G, c; const char* A0; const char* A1; const char* B0; const char* B1; size_t tstep;
    __device__ __forceinline__ bool next(int i, Unit& u) const { const long L = (long)(i >> 1) * G + c; if (L >= (long)nM * nN) return false; map_unit((int)L, nM, nN, u); u.kind = i & 1; return true; }
    __device__ __forceinline__ const char* aptr(const Unit& u) const { return (u.kind ? A1 : A0) + (size_t)u.pm * tstep; }
    __device__ __forceinline__ const char* bptr(const Unit& u) const { return (u.kind ? B1 : B0) + (size_t)u.pn * tstep; }
};

template <class Epi, class Sched>
__device__ __forceinline__ void gemm_phase(LAS unsigned char* lds, const int K, const Sched& S, const Epi& E) {
    const int tid = tid_opaque(), wid = __builtin_amdgcn_readfirstlane(tid >> 6), lane = tid & 63, wr = wid >> 2, wc = wid & 3, fr = lane & 15, fq = lane >> 4;
    const int nt = K / BK;
    unsigned voffA[2], voffB[2];
#pragma unroll
    for (int i = 0; i < 2; ++i) { int R, C; stage_rc(tid * 16 + i * 8192, R, C); const int Rb = Epi::PERM ? ((R & ~31) + perm32(R & 31)) : R;
        voffA[i] = (unsigned)(R * K + C) * 2u; voffB[i] = (unsigned)(Rb * K + C) * 2u; }
    const size_t kstep = (size_t)(BK * 2);
    const size_t hstep = (size_t)HALF * K * 2;
    const unsigned ldsw = (unsigned)wid * 1024u;
    const int aoff = lds_byte(wr * 64 + fr, fq * 8), boff = lds_byte(wc * 32 + fr, fq * 8);
#define PG8_SA(b, h) (((b) * 2 + (h)) * HTB)
#define PG8_SB(b, h) ((4 + (b) * 2 + (h)) * HTB)
#define PG8_STAGE(bufoff, gbase, voff) do { _Pragma("unroll") for (int _i = 0; _i < 2; ++_i) \
        __builtin_amdgcn_global_load_lds((const unsigned*)((const char*)(gbase) + (voff)[_i]), (LAS unsigned*)(lds + (bufoff) + ldsw + _i * 8192), 16, 0, 0); } while (0)
#define PG8_LDA(dst, b, h) do { _Pragma("unroll") for (int m = 0; m < 4; ++m) _Pragma("unroll") for (int k = 0; k < 2; ++k) dst[m][k] = *(const LAS bf16x8*)(lds + PG8_SA(b, h) + aoff + m * 2048 + k * 1024); } while (0)
#define PG8_LDB(dst, b, h) do { _Pragma("unroll") for (int n = 0; n < 2; ++n) _Pragma("unroll") for (int k = 0; k < 2; ++k) dst[n][k] = *(const LAS bf16x8*)(lds + PG8_SB(b, h) + boff + n * 2048 + k * 1024); } while (0)
#define PG8_MMA(ai, bj, At, Bt) do { __builtin_amdgcn_s_setprio(1); _Pragma("unroll") for (int m = 0; m < 4; ++m) _Pragma("unroll") for (int n = 0; n < 2; ++n) _Pragma("unroll") for (int k = 0; k < 2; ++k) \
        acc[ai][bj][m][n] = __builtin_amdgcn_mfma_f32_16x16x32_bf16(Bt[n][k], At[m][k], acc[ai][bj][m][n], 0, 0, 0); __builtin_amdgcn_s_setprio(0); } while (0)
#define PG8_WAIT_V(n) asm volatile("s_waitcnt vmcnt(" #n ")" ::: "memory")
#define PG8_WAIT_L(n) asm volatile("s_waitcnt lgkmcnt(" #n ")" ::: "memory")
#define PG8_BAR __builtin_amdgcn_s_barrier()
#define PG8_SCHED __builtin_amdgcn_sched_barrier(0)
    Unit cur, nxt; int ui = 0;
    if (!S.next(0, cur)) return;
    f32x4 acc[2][2][4][2];
#pragma unroll
    for (int a = 0; a < 2; ++a)
#pragma unroll
        for (int b = 0; b < 2; ++b)
#pragma unroll
            for (int m = 0; m < 4; ++m)
#pragma unroll
                for (int n = 0; n < 2; ++n) acc[a][b][m][n] = (f32x4){0.f, 0.f, 0.f, 0.f};
    bf16x8 At[4][2], B0[2][2], B1[2][2];
    const char* cA = S.aptr(cur); const char* cB = S.bptr(cur);
    PG8_STAGE(PG8_SB(0, 0), cB, voffB); PG8_STAGE(PG8_SA(0, 0), cA, voffA); PG8_STAGE(PG8_SB(0, 1), cB + hstep, voffB); PG8_STAGE(PG8_SA(0, 1), cA + hstep, voffA);
    if (wr == 1) PG8_BAR;
    PG8_WAIT_V(4); PG8_BAR;
    PG8_STAGE(PG8_SB(1, 0), cB + kstep, voffB); PG8_STAGE(PG8_SA(1, 0), cA + kstep, voffA); PG8_STAGE(PG8_SB(1, 1), cB + hstep + kstep, voffB);
    PG8_WAIT_V(6); PG8_BAR;
    for (;;) {
        const bool has_next = S.next(ui + 1, nxt);
        const char* nA = has_next ? S.aptr(nxt) : cA; const char* nB = has_next ? S.bptr(nxt) : cB;
        for (int t = 0; t < nt; t += 2) {
            const bool last = (t == nt - 2);
            const char* a1 = cA + (size_t)(t + 1) * kstep;
            const char* a2 = last ? nA : cA + (size_t)(t + 2) * kstep; const char* b2 = last ? nB : cB + (size_t)(t + 2) * kstep;
            const char* a3 = a2 + kstep; const char* b3 = b2 + kstep;
            PG8_LDB(B0, 0, 0); PG8_SCHED; PG8_LDA(At, 0, 0); PG8_STAGE(PG8_SA(1, 1), a1 + hstep, voffA);
            PG8_WAIT_L(8); PG8_BAR; PG8_WAIT_L(0); PG8_MMA(0, 0, At, B0); PG8_BAR; PG8_SCHED;
            PG8_LDB(B1, 0, 1); PG8_STAGE(PG8_SB(0, 0), b2, voffB);
            PG8_BAR; PG8_WAIT_L(0); PG8_MMA(0, 1, At, B1); PG8_BAR;
            PG8_LDA(At, 0, 1); PG8_STAGE(PG8_SA(0, 0), a2, voffA);
            PG8_BAR; PG8_WAIT_L(0); PG8_MMA(1, 0, At, B0); PG8_BAR; PG8_SCHED;
            PG8_STAGE(PG8_SB(0, 1), b2 + hstep, voffB);
            PG8_WAIT_V(6); PG8_BAR; PG8_MMA(1, 1, At, B1); PG8_BAR;
            PG8_LDB(B0, 1, 0); PG8_SCHED; PG8_LDA(At, 1, 0); PG8_STAGE(PG8_SA(0, 1), a2 + hstep, voffA);
            PG8_WAIT_L(8); PG8_BAR; PG8_WAIT_L(0); PG8_MMA(0, 0, At, B0); PG8_BAR; PG8_SCHED;
            PG8_LDB(B1, 1, 1); PG8_STAGE(PG8_SB(1, 0), b3, voffB);
            PG8_BAR; PG8_WAIT_L(0); PG8_MMA(0, 1, At, B1); PG8_BAR;
            PG8_LDA(At, 1, 1); PG8_STAGE(PG8_SA(1, 0), a3, voffA);
            PG8_BAR; PG8_WAIT_L(0); PG8_MMA(1, 0, At, B0); PG8_BAR; PG8_SCHED;
            PG8_STAGE(PG8_SB(1, 1), b3 + hstep, voffB);
            PG8_WAIT_V(6); PG8_BAR; PG8_MMA(1, 1, At, B1); PG8_BAR;
        }
        E(acc, cur, wr, wc, fr, fq);
        if (!has_next) break;
        if (!E.keep(cur)) {
#pragma unroll
        for (int a = 0; a < 2; ++a)
#pragma unroll
            for (int b = 0; b < 2; ++b)
#pragma unroll
                for (int m = 0; m < 4; ++m)
#pragma unroll
                    for (int n = 0; n < 2; ++n) acc[a][b][m][n] = (f32x4){0.f, 0.f, 0.f, 0.f};
        }
        cur = nxt; cA = nA; cB = nB; ++ui;
    }
    PG8_WAIT_V(0);
    if (wr == 0) PG8_BAR;
    PG8_BAR;
#undef PG8_SA
#undef PG8_SB
#undef PG8_STAGE
#undef PG8_LDA
#undef PG8_LDB
#undef PG8_MMA
#undef PG8_WAIT_V
#undef PG8_WAIT_L
#undef PG8_BAR
#undef PG8_SCHED
}
}
using pg8::Unit;

template <int ACT> __device__ __forceinline__ float actf(float v) { return ACT == 1 ? v * sigm(v) : (ACT == 2 ? sigm(v) : v); }
template <int ACT> __device__ __forceinline__ void store_tile_bf16(const f32x4 (&acc)[2][2][4][2], bf16_t* base  , int ld) {
#pragma unroll
    for (int ai = 0; ai < 2; ++ai)
#pragma unroll
        for (int m = 0; m < 4; ++m) { bf16_t* rowp = base + (size_t)(ai * 128 + m * 16) * ld;
#pragma unroll
            for (int bj = 0; bj < 2; ++bj) { const f32x4 v0 = acc[ai][bj][m][0], v1 = acc[ai][bj][m][1]; u32x4 w;
                w.x = cvt_pk_bf16(actf<ACT>(v0[0]), actf<ACT>(v0[1])); w.y = cvt_pk_bf16(actf<ACT>(v0[2]), actf<ACT>(v0[3]));
                w.z = cvt_pk_bf16(actf<ACT>(v1[0]), actf<ACT>(v1[1])); w.w = cvt_pk_bf16(actf<ACT>(v1[2]), actf<ACT>(v1[3]));
                *(GAS u32x4*)(rowp + bj * 128) = w; } }
}
struct EpiG1 {
    static constexpr bool PERM = true;
    __device__ __forceinline__ bool keep(const Unit&) const { return false; }
    unsigned char *ws, *outb;
    __device__ __forceinline__ void operator()(const f32x4 (&acc)[2][2][4][2], const Unit& u, int wr, int wc, int fr, int fq) const {
        unsigned char* w = uniform_ptr(ws); unsigned char* ob = uniform_ptr(outb); asm volatile("" : "+s"(w), "+s"(ob));
        const int row0 = u.pm * 256 + wr * 64 + fr, pn = u.pn, cw = wc * 32 + 8 * fq;
        if (pn < 8) {
            bf16_t* base = (bf16_t*)(w + OFF_U) + (size_t)row0 * 1024 + pn * 128 + cw;
#pragma unroll
            for (int ai = 0; ai < 2; ++ai)
#pragma unroll
                for (int m = 0; m < 4; ++m) { const f32x4 a0 = acc[ai][0][m][0], a1 = acc[ai][0][m][1], g0 = acc[ai][1][m][0], g1 = acc[ai][1][m][1]; u32x4 wv;
                    wv.x = cvt_pk_bf16(a0[0] * sigm(g0[0]), a0[1] * sigm(g0[1])); wv.y = cvt_pk_bf16(a0[2] * sigm(g0[2]), a0[3] * sigm(g0[3]));
                    wv.z = cvt_pk_bf16(a1[0] * sigm(g1[0]), a1[1] * sigm(g1[1])); wv.w = cvt_pk_bf16(a1[2] * sigm(g1[2]), a1[3] * sigm(g1[3]));
                    *(GAS u32x4*)(base + (size_t)(ai * 128 + m * 16) * 1024) = wv; }
        } else if (pn < 12) store_tile_bf16<1>(acc, (bf16_t*)(w + OFF_OGC) + (size_t)row0 * 1024 + (pn - 8) * 256 + cw, 1024);
        else if (pn < 25) store_tile_bf16<0>(acc, (bf16_t*)(w + OFF_RKVL) + (size_t)row0 * LDR + (pn - 12) * 256 + cw, LDR);
        else if (pn < 29) store_tile_bf16<1>(acc, (bf16_t*)(w + OFF_OGR) + (size_t)row0 * 1024 + (pn - 25) * 256 + cw, 1024);
        else if (pn < 33) store_tile_bf16<2>(acc, (bf16_t*)(w + OFF_GC) + (size_t)row0 * 1024 + (pn - 29) * 256 + cw, 1024);
        else store_tile_bf16<2>(acc, (bf16_t*)(ob + 64 * MiB) + (size_t)row0 * 1024 + (pn - 33) * 256 + cw, 1024);
    }
};
struct EpiLora {
    static constexpr bool PERM = true;
    __device__ __forceinline__ bool keep(const Unit&) const { return false; }
    bf16_t *DW, *AP;
    __device__ __forceinline__ void operator()(const f32x4 (&acc)[2][2][4][2], const Unit& u, int wr, int wc, int fr, int fq) const {
        const int row0 = u.pm * 256 + wr * 64 + fr, cw = wc * 32 + 8 * fq;
        bf16_t* base = (u.pn < 4 ? DW + (size_t)u.pn * 256 : AP + (size_t)(u.pn - 4) * 256) + (size_t)row0 * 1024 + cw;
        store_tile_bf16<0>(acc, base, 1024);
    }
};
struct EpiG2 {
    static constexpr bool PERM = true;
    const bf16_t *GC, *GR; bf16_t* M;
    __device__ __forceinline__ bool keep(const Unit& u) const { return u.kind == 0; }
    __device__ __forceinline__ void operator()(f32x4 (&acc)[2][2][4][2], const Unit& u, int wr, int wc, int fr, int fq) const {
        const size_t off0 = (size_t)(u.pm * 256 + wr * 64 + fr) * 1024 + u.pn * 256 + wc * 32 + 8 * fq;
#pragma unroll
        for (int ai = 0; ai < 2; ++ai)
#pragma unroll
        for (int mh = 0; mh < 2; ++mh) {
            u32x4 grv[4][2];
#pragma unroll
            for (int m = 2 * mh; m < 2 * mh + 2; ++m)
#pragma unroll
                for (int bj = 0; bj < 2; ++bj) grv[m][bj] = *(const GAS u32x4*)(GR + off0 + (size_t)(ai * 128 + m * 16) * 1024 + bj * 128);
            if (u.kind == 0) {
                u32x4 gcv[4][2];
#pragma unroll
                for (int m = 2 * mh; m < 2 * mh + 2; ++m)
#pragma unroll
                    for (int bj = 0; bj < 2; ++bj) gcv[m][bj] = *(const GAS u32x4*)(GC + off0 + (size_t)(ai * 128 + m * 16) * 1024 + bj * 128);
#pragma unroll
                for (int m = 2 * mh; m < 2 * mh + 2; ++m)
#pragma unroll
                    for (int bj = 0; bj < 2; ++bj) { const u32x4 gr = grv[m][bj], gc = gcv[m][bj]; f32x4& v0 = acc[ai][bj][m][0]; f32x4& v1 = acc[ai][bj][m][1];
                        const f32x4 r0 = {bflo(gr.x), bfhi(gr.x), bflo(gr.y), bfhi(gr.y)}, r1 = {bflo(gr.z), bfhi(gr.z), bflo(gr.w), bfhi(gr.w)};
                        const f32x4 c0 = {bflo(gc.x), bfhi(gc.x), bflo(gc.y), bfhi(gc.y)}, c1 = {bflo(gc.z), bfhi(gc.z), bflo(gc.w), bfhi(gc.w)};
#pragma unroll
                        for (int j = 0; j < 4; ++j) { v0[j] *= c0[j] * __builtin_amdgcn_rcpf(fmaxf(r0[j], 1e-30f)); v1[j] *= c1[j] * __builtin_amdgcn_rcpf(fmaxf(r1[j], 1e-30f)); } }
            } else {
#pragma unroll
                for (int m = 2 * mh; m < 2 * mh + 2; ++m)
#pragma unroll
                    for (int bj = 0; bj < 2; ++bj) { const u32x4 gr = grv[m][bj]; const f32x4 v0 = acc[ai][bj][m][0], v1 = acc[ai][bj][m][1];
                        const f32x4 r0 = {bflo(gr.x), bfhi(gr.x), bflo(gr.y), bfhi(gr.y)}, r1 = {bflo(gr.z), bfhi(gr.z), bflo(gr.w), bfhi(gr.w)};
                        const f32x4 m0 = v0 * r0, m1 = v1 * r1; u32x4 w;
                        w.x = cvt_pk_bf16(m0[0], m0[1]); w.y = cvt_pk_bf16(m0[2], m0[3]); w.z = cvt_pk_bf16(m1[0], m1[1]); w.w = cvt_pk_bf16(m1[2], m1[3]);
                        *(GAS u32x4*)(M + off0 + (size_t)(ai * 128 + m * 16) * 1024 + bj * 128) = w; }
            }
        }
    }
};
struct EpiG3 {
    static constexpr bool PERM = false;
    const float *x, *mod, *fg; float* out; float* rowss; unsigned* pcnt;
    __device__ __forceinline__ bool keep(const Unit&) const { return false; }
    __device__ __forceinline__ void operator()(f32x4 (&acc)[2][2][4][2], const Unit& u, int wr, int wc, int fr, int fq) const {
        const int col0 = u.pn * 256 + wc * 32 + 4 * fq, row0 = u.pm * 256 + wr * 64 + fr; const size_t off0 = (size_t)row0 * 1024 + col0;
        const float* gp = mod + (size_t)(u.pm >> 3) * 3072 + 2048 + col0;
        { f32x4 gv[2][2];
#pragma unroll
        for (int bj = 0; bj < 2; ++bj)
#pragma unroll
            for (int n = 0; n < 2; ++n) gv[bj][n] = *(const GAS f32x4*)(gp + bj * 128 + n * 16);
#pragma unroll
        for (int ai = 0; ai < 2; ++ai)
#pragma unroll
            for (int m = 0; m < 4; ++m) { float ps = 0.f;
#pragma unroll
                for (int bj = 0; bj < 2; ++bj)
#pragma unroll
                    for (int n = 0; n < 2; ++n) { const size_t off = off0 + (size_t)(ai * 128 + m * 16) * 1024 + bj * 128 + n * 16;
                        const f32x4 v = *(const GAS f32x4*)(x + off) + gv[bj][n] * acc[ai][bj][m][n]; acc[ai][bj][m][n] = v; ps += v[0] * v[0] + v[1] * v[1] + v[2] * v[2] + v[3] * v[3]; }
                ps += __shfl_xor(ps, 16); ps += __shfl_xor(ps, 32);
                if (fq == 0) __hip_atomic_fetch_add(rowss + row0 + ai * 128 + m * 16, ps, __ATOMIC_RELAXED, __HIP_MEMORY_SCOPE_AGENT); } }
        asm volatile("s_waitcnt vmcnt(0)" ::: "memory");
        unsigned* pc = pcnt + u.pm * 2 + wr;
        if (fr == 0 && fq == 0) __hip_atomic_fetch_add(pc, 1u, __ATOMIC_RELAXED, __HIP_MEMORY_SCOPE_AGENT);
        { unsigned sp = 0; while (__hip_atomic_load(pc, __ATOMIC_RELAXED, __HIP_MEMORY_SCOPE_AGENT) < 16u && ++sp < (1u << 22)) __builtin_amdgcn_s_sleep(1); }
#pragma unroll
        for (int ai = 0; ai < 2; ++ai)
#pragma unroll
            for (int m = 0; m < 4; ++m) { const float ss = __hip_atomic_load(rowss + row0 + ai * 128 + m * 16, __ATOMIC_RELAXED, __HIP_MEMORY_SCOPE_AGENT);
                const float rstd = __builtin_amdgcn_rsqf(ss * (1.f / 1024.f) + 1e-6f);
#pragma unroll
                for (int bj = 0; bj < 2; ++bj)
#pragma unroll
                    for (int n = 0; n < 2; ++n) { const size_t off = off0 + (size_t)(ai * 128 + m * 16) * 1024 + bj * 128 + n * 16;
                        *(GAS f32x4*)(out + off) = acc[ai][bj][m][n] * rstd * *(const GAS f32x4*)(fg + col0 + bj * 128 + n * 16); } }
    }
};

__device__ void phase_mod(const Params& p, unsigned char* smem) {
    if (blockIdx.x >= 48) return;
    float* sc = (float*)smem;
    float* red = sc + 16384;
    const int tid = tid_opaque(), w = tid >> 6, lane = tid & 63;
    for (int i = tid; i < 16384; i += 512) { const int b = i >> 10, d = i & 1023; const float cv = p.c[i]; sc[d * 16 + b] = cv * sigm(cv); }
    __syncthreads();
    const int e = blockIdx.x * 64 + lane;
    float acc[16];
#pragma unroll
    for (int b = 0; b < 16; ++b) acc[b] = 0.f;
    for (int d0 = w * 128; d0 < w * 128 + 128; d0 += 16) {
        float wvs[16];
#pragma unroll
        for (int u = 0; u < 16; ++u) wvs[u] = p.ada_w[(size_t)(d0 + u) * 3072 + e];
#pragma unroll
        for (int u = 0; u < 16; ++u) { const int d = d0 + u; const float wv = wvs[u];
        const f32x4* s4 = (const f32x4*)(sc + d * 16);
#pragma unroll
        for (int q = 0; q < 4; ++q) { const f32x4 s = s4[q]; acc[4 * q] += s[0] * wv; acc[4 * q + 1] += s[1] * wv; acc[4 * q + 2] += s[2] * wv; acc[4 * q + 3] += s[3] * wv; }
        }
    }
#pragma unroll
    for (int b = 0; b < 16; ++b) red[(w * 16 + b) * 64 + lane] = acc[b];
    __syncthreads();
    float* mod = (float*)(p.ws + OFF_MOD);
    for (int i = tid; i < 1024; i += 512) { const int b = i >> 6, l = i & 63; float s = 0.f;
#pragma unroll
        for (int ww = 0; ww < 8; ++ww) s += red[(ww * 16 + b) * 64 + l];
        mod[b * 3072 + blockIdx.x * 64 + l] = s + p.ada_b[blockIdx.x * 64 + l]; }
    __syncthreads();
}
__device__ __forceinline__ void transpose_tile(const float* src, int ld, int n_src0, int k0, bf16_t* dst, int n_dst0, float* tile) {
    const int tid = tid_opaque();
#pragma unroll
    for (int r = 0; r < 2; ++r) { const int i = (tid >> 4) + 32 * r, j4 = (tid & 15) * 4;
        f32x4 v = {0.f, 0.f, 0.f, 0.f}; if (n_src0 >= 0) v = *(const f32x4*)(src + (size_t)(k0 + i) * ld + n_src0 + j4);
        tile[i * 65 + j4] = v[0]; tile[i * 65 + j4 + 1] = v[1]; tile[i * 65 + j4 + 2] = v[2]; tile[i * 65 + j4 + 3] = v[3]; }
    __syncthreads();
    const int j = tid >> 3, i8 = (tid & 7) * 8; u32x4 w;
    w.x = cvt_pk_bf16(tile[(i8 + 0) * 65 + j], tile[(i8 + 1) * 65 + j]); w.y = cvt_pk_bf16(tile[(i8 + 2) * 65 + j], tile[(i8 + 3) * 65 + j]);
    w.z = cvt_pk_bf16(tile[(i8 + 4) * 65 + j], tile[(i8 + 5) * 65 + j]); w.w = cvt_pk_bf16(tile[(i8 + 6) * 65 + j], tile[(i8 + 7) * 65 + j]);
    *(u32x4*)(dst + (size_t)(n_dst0 + j) * 1024 + k0 + i8) = w;
    __syncthreads();
}
__device__ void phase_weights(const Params& p, unsigned char* smem) {
    float* tile = (float*)smem;
    for (int i = blockIdx.x * 512 + threadIdx.x; i < T + 256; i += gridDim.x * 512) ((unsigned*)(p.ws + OFF_ROWSS))[i] = 0u;
    bf16_t* WinT = (bf16_t*)(p.ws + OFF_WINT); bf16_t* W2T = (bf16_t*)(p.ws + OFF_W2T); bf16_t* WoT = (bf16_t*)(p.ws + OFF_WOT); bf16_t* LBt = (bf16_t*)(p.ws + OFF_LBT);
    constexpr int NT1 = (N1 / 64) * 16;
    const bool bal = (gridDim.x == 256); const int nb = blockIdx.x;
    const int first = bal ? (nb >= 48 ? nb - 48 : 2704 + nb) : nb, stride = bal ? (nb >= 48 ? 208 : 48) : (int)gridDim.x, last = bal ? (nb >= 48 ? 2704 : 3136) : NT1 + 768;
    for (int idx = first; idx < last; idx += stride) {
        if (idx < NT1) { const int a = idx >> 4, kt = idx & 15, n0 = a * 64; int src;
            if (n0 < 2048) { const int j = n0 >> 8, wi = n0 & 255; src = wi < 128 ? 128 * j + wi : 1024 + 128 * j + wi - 128; }
            else if (n0 < 6272) src = n0; else if (n0 < 6400) src = -1; else src = n0 - 128;
            transpose_tile(p.w_in, 9344, src, kt * 64, WinT, n0, tile);
        } else { const int r = idx - NT1, which = r >> 8, a = (r >> 4) & 15, kt = r & 15;
            const float* src = which == 0 ? p.w_conv_out : (which == 1 ? p.w_rwkv_out : p.w_out);
            bf16_t* dst = which == 0 ? W2T : (which == 1 ? W2T + (size_t)1024 * 1024 : WoT);
            transpose_tile(src, 1024, a * 64, kt * 64, dst, a * 64, tile); }
    }
    for (int idx = blockIdx.x * 512 + tid_opaque(); idx < 2048 * 128; idx += gridDim.x * 512) { const int n = idx >> 7, k = idx & 127; float v = 0.f;
        if (n < 1024) { if (k < 64) v = p.rwkv_w2[k * 1024 + n]; } else { if (k >= 64) v = p.rwkv_a2[(k - 64) * 1024 + n - 1024]; }
        LBt[idx] = f2bf(v); }
}
__device__ void phase_h(const Params& p) {
    const int tid = tid_opaque(), w = tid >> 6, lane = tid & 63;
    const float* mod = (const float*)(p.ws + OFF_MOD); bf16_t* Hh = (bf16_t*)p.out;
    for (int tok = blockIdx.x * 8 + w; tok < T; tok += gridDim.x * 8) {
        const int b = tok >> 11; const float* xr = p.x + (size_t)tok * 1024; f32x4 v[4]; float ss = 0.f;
#pragma unroll
        for (int q = 0; q < 4; ++q) { v[q] = *(const f32x4*)(xr + q * 256 + lane * 4); ss += v[q][0] * v[q][0] + v[q][1] * v[q][1] + v[q][2] * v[q][2] + v[q][3] * v[q][3]; }
        ss = wave_sum(ss); const float rstd = rsqrtf(ss * (1.f / 1024.f) + 1e-6f);
#pragma unroll
        for (int q = 0; q < 4; ++q) { const int col = q * 256 + lane * 4; const f32x4 g = *(const f32x4*)(p.norm_g + col), sh = *(const f32x4*)(mod + b * 3072 + col), sc = *(const f32x4*)(mod + b * 3072 + 1024 + col);
            const f32x4 y = v[q] * rstd * g * (sc + 1.f) + sh; u32x2 o; o.x = cvt_pk_bf16(y[0], y[1]); o.y = cvt_pk_bf16(y[2], y[3]);
            *(u32x2*)(Hh + (size_t)tok * 1024 + col) = o; }
    }
}
__device__ void phase_conv(const Params& p, unsigned char* smem) {
    const int tid = tid_opaque(), w = tid >> 6, lane = tid & 63, c0 = tid * 2;
    const bf16_t* U = (const bf16_t*)(p.ws + OFF_U); bf16_t* OGC = (bf16_t*)(p.ws + OFF_OGC);
    float* part = (float*)smem;
    float* stat = part + 32 * 512;
    f32x2 wk[31];
#pragma unroll
    for (int j = 0; j < 31; ++j) wk[j] = *(const f32x2*)(p.conv_k + j * 1024 + c0);
    const f32x2 cb = *(const f32x2*)(p.conv_b + c0), lg = *(const f32x2*)(p.conv_ln_g + c0), lb = *(const f32x2*)(p.conv_ln_b + c0);
    for (int tile = blockIdx.x; tile < T / 16; tile += gridDim.x) {
        const int b = tile >> 7, t0 = (tile & 127) * 16; const size_t row0 = (size_t)b * SEQ + t0;
        f32x2 u[46];
#pragma unroll
        for (int i = 0; i < 46; ++i) { const int t = t0 - 30 + i; unsigned v = 0u; if (t >= 0) v = *(const unsigned*)(U + ((size_t)b * SEQ + t) * 1024 + c0); u[i] = (f32x2){bflo(v), bfhi(v)}; }
        f32x2 o[16];
#pragma unroll
        for (int i = 0; i < 16; ++i) { f32x2 a = cb;
#pragma unroll
            for (int j = 0; j < 31; ++j) a = wk[j] * u[i + j] + a;
            o[i] = a; }
        unsigned ogv[16];
#pragma unroll
        for (int i = 0; i < 16; ++i) ogv[i] = *(const unsigned*)(OGC + (row0 + i) * 1024 + c0);
#pragma unroll
        for (int i = 0; i < 16; ++i) { part[i * 512 + tid] = o[i].x + o[i].y; part[(16 + i) * 512 + tid] = o[i].x * o[i].x + o[i].y * o[i].y; }
        __syncthreads();
#pragma unroll
        for (int q = 0; q < 4; ++q) { const int v = 4 * w + q; float s = 0.f;
#pragma unroll
            for (int r = 0; r < 8; ++r) s += part[v * 512 + lane + 64 * r];
            s = wave_sum(s); if (lane == 0) stat[v] = s; }
        __syncthreads();
#pragma unroll
        for (int i = 0; i < 16; ++i) { const float mean = stat[i] * (1.f / 1024.f), var = stat[16 + i] * (1.f / 1024.f) - mean * mean, rstd = __builtin_amdgcn_rsqf(var + 1e-5f);
            float y0 = (o[i].x - mean) * rstd * lg.x + lb.x, y1 = (o[i].y - mean) * rstd * lg.y + lb.y; y0 *= sigm(y0); y1 *= sigm(y1);
            bf16_t* gp = OGC + (row0 + i) * 1024 + c0; const unsigned og = ogv[i];
            *(unsigned*)gp = cvt_pk_bf16(y0 * bflo(og), y1 * bfhi(og)); }
    }
    const bf16_t* RK = (const bf16_t*)(p.ws + OFF_RKVL); bf16_t* AL = (bf16_t*)(p.ws + OFF_ALORA);
    for (int idx = blockIdx.x * 512 + tid; idx < T * 128; idx += gridDim.x * 512) { const int t = idx >> 7, j = idx & 127;
        const float z = bf2f(RK[(size_t)t * LDR + 3072 + j]), pv = (t & (SEQ - 1)) ? bf2f(RK[(size_t)(t - 1) * LDR + 3072 + j]) : 0.f;
        const float s = z + p.rwkv_mu[3072 + j] * (pv - z); const float val = j < 64 ? tanhf(s) : s;
        AL[(size_t)t * 128 + j] = f2bf(val); }
}
constexpr int SCH = 32, SNCH = SEQ / SCH, SREC = 272;
struct ScanRaw { unsigned v[8], wa[8]; };
struct ScanOps { f32x4 a[8], b[4], k[4]; };
struct ScanC { float mu_r, mu_k, mu_v, w0c, a0c, kkc, kac, rkc, gng, gnb; };
__device__ __forceinline__ void scan_load_raw(ScanRaw& R, f32x2 (&S)[8], const bf16_t* RK, const bf16_t* DW, const bf16_t* AP, int b, int c, int pw, int ch) {
#pragma unroll
    for (int i = 0; i < 8; ++i) { const int t = c * SCH + 8 * pw + i; const size_t row = (size_t)b * SEQ + t; const bf16_t* rp = RK + row * LDR + ch;
        const bf16_t* rq = t > 0 ? rp - LDR : rp;
        S[i >> 1][i & 1] = __uint_as_float((unsigned)rp[0] | ((unsigned)rq[0] << 16)); S[4 + (i >> 1)][i & 1] = __uint_as_float((unsigned)rp[1024] | ((unsigned)rq[1024] << 16));
        R.v[i] = (unsigned)rp[2048] | ((unsigned)rq[2048] << 16); R.wa[i] = (unsigned)DW[row * 1024 + ch] | ((unsigned)AP[row * 1024 + ch] << 16); }
}
__device__ __forceinline__ void scan_prep(const ScanRaw& R, const f32x2 (&S)[8], const ScanC& C, int c, int pw, int lane, unsigned seq, float* rec, float* vbuf, f32x4* scl, float* wtot, float* ptot, volatile unsigned* flag) {
    float kkA[8], rA[8], nbA[8], kpA[8], LA[8]; float L = 1.f;
#pragma unroll
    for (int i = 0; i < 8; ++i) { const int tt = 8 * pw + i, t = c * SCH + tt;
        const unsigned Rr = __float_as_uint(S[i >> 1][i & 1]), Rk = __float_as_uint(S[4 + (i >> 1)][i & 1]);
        float r = bflo(Rr), k = bflo(Rk), v = bflo(R.v[i]); const float pm = t > 0 ? 1.f : 0.f;
        const float r1 = pm * bfhi(Rr), k1 = pm * bfhi(Rk), v1 = pm * bfhi(R.v[i]);
        r += C.mu_r * (r1 - r); k += C.mu_k * (k1 - k); v += C.mu_v * (v1 - v);
        const float wpre = C.w0c + bflo(R.wa[i]), apre = C.a0c + bfhi(R.wa[i]);
        const float decay = __expf(-0.60653066f * sigm(wpre)), a = sigm(apre);
        const float kkv = k * C.kkc, n2 = wave_sum(kkv * kkv), kk = kkv * __builtin_amdgcn_rsqf(fmaxf(n2, 1e-24f));
        const float kp = k * (1.f + (a - 1.f) * C.kac), bv = kk * a;
        const float br = wave_sum(bv * r), kr = wave_sum(kp * r), bonus = wave_sum(r * kp * C.rkc);
        L *= decay; kkA[i] = kk; rA[i] = r; nbA[i] = -bv; kpA[i] = kp; LA[i] = L;
        vbuf[tt * 64 + lane] = v;
        if (lane == 0) scl[tt] = (f32x4){-br, kr, bonus, 0.f};
        if (i & 1) __builtin_amdgcn_sched_barrier(0);
    }
    wtot[pw * 64 + lane] = L;
    asm volatile("s_waitcnt lgkmcnt(0)" ::: "memory");
    if (lane == 0) flag[pw] = seq;
    float Pw = 1.f;
    for (int ww = 0; ww < pw; ++ww) { while (flag[ww] != seq) __builtin_amdgcn_s_sleep(1);
        asm volatile("" ::: "memory"); Pw *= wtot[ww * 64 + lane]; }
    if (pw == 3) ptot[lane] = Pw * L;
    float Pprev = Pw;
#pragma unroll
    for (int i = 0; i < 8; ++i) { const int tt = 8 * pw + i; const float Pt = Pw * LA[i], ip = __builtin_amdgcn_rcpf(Pt);
        float* rc = rec + tt * SREC + (lane >> 4) * 68; const int e = lane & 15;
        *(f32x2*)(rc + 2 * e) = (f32x2){Pprev * kkA[i], Pt * rA[i]}; rc[32 + e] = nbA[i] * ip; rc[48 + e] = kpA[i] * ip;
        Pprev = Pt; }
}
__device__ __forceinline__ void scan_post(const bf16_t (&og)[8], bf16_t* dst0, const ScanC& C, int pw, int lane, const float* obuf, const float* vbuf, const f32x4* scl) {
#pragma unroll
    for (int i = 0; i < 8; ++i) { const int tt = pw + 4 * i;
        const float o = obuf[tt * 64 + lane], mean = wave_sum(o) * (1.f / 64.f), d = o - mean, var = wave_sum(d * d) * (1.f / 64.f);
        float y = d * __builtin_amdgcn_rsqf(var + 64e-5f) * C.gng + C.gnb; y += scl[tt].z * vbuf[tt * 64 + lane];
        dst0[(size_t)i * 4096] = f2bf(y * bf2f(og[i])); }
}
__device__ __forceinline__ void scan_load_ops(ScanOps& o, const f32x4* rq) {
#pragma unroll
    for (int j = 0; j < 8; ++j) o.a[j] = rq[j];
#pragma unroll
    for (int j = 0; j < 4; ++j) { o.b[j] = rq[8 + j]; o.k[j] = rq[12 + j]; }
}
__device__ __forceinline__ void scan_step(f32x2 (&S)[8], ScanOps& q, const f32x4* rn, const float v, const bool lead, const f32x2 sc, float* obuf, float* dump, int tt, int srow) {
    f32x2 vv = {v, v}; asm volatile("" : "+v"(vv));
    f32x2 d0 = S[0].x * (f32x2){q.a[0][0], q.a[0][1]}, d1 = S[0].y * (f32x2){q.a[0][2], q.a[0][3]}, d2 = S[1].x * (f32x2){q.a[1][0], q.a[1][1]}, d3 = S[1].y * (f32x2){q.a[1][2], q.a[1][3]};
#pragma unroll
    for (int j = 2; j < 8; j += 2) { d0 += S[j].x * (f32x2){q.a[j][0], q.a[j][1]}; d1 += S[j].y * (f32x2){q.a[j][2], q.a[j][3]};
        d2 += S[j + 1].x * (f32x2){q.a[j + 1][0], q.a[j + 1][1]}; d3 += S[j + 1].y * (f32x2){q.a[j + 1][2], q.a[j + 1][3]}; }
#pragma unroll
    for (int j = 0; j < 8; ++j) q.a[j] = rn[j];
    const f32x2 d = (d0 + d1) + (d2 + d3);
    float sk = d.x, o = d.y;
    sk = dpp_add<0xB1>(sk); o = dpp_add<0xB1>(o); sk = dpp_add<0x4E>(sk); o = dpp_add<0x4E>(o);
#pragma unroll
    for (int j = 0; j < 4; ++j) { S[2 * j] += sk * (f32x2){q.b[j][0], q.b[j][1]}; S[2 * j + 1] += sk * (f32x2){q.b[j][2], q.b[j][3]}; }
#pragma unroll
    for (int j = 0; j < 4; ++j) { S[2 * j] += vv * (f32x2){q.k[j][0], q.k[j][1]}; S[2 * j + 1] += vv * (f32x2){q.k[j][2], q.k[j][3]}; }
#pragma unroll
    for (int j = 0; j < 4; ++j) { q.b[j] = rn[8 + j]; q.k[j] = rn[12 + j]; }
    LAS float* op = lead ? (LAS float*)(obuf + tt * 64 + srow) : (LAS float*)dump; *op = o + sk * sc.x + v * sc.y;
}
__device__ void phase_scan(const Params& p, unsigned char* smem) {
    const int tid = tid_opaque(), w = tid >> 6, lane = tid & 63, g = lane & 3, srow = (w & 3) * 16 + (lane >> 2), pw = w & 3;
    const bool cons = w < 4, lead = (g == 0);
    float* recb = (float*)smem;
    float* vbufb = recb + 2 * SCH * SREC;
    float* obufb = vbufb + 3 * SCH * 64;
    f32x4* sclb = (f32x4*)(obufb + 2 * SCH * 64);
    float* wtot = (float*)(sclb + 3 * SCH);
    float* ptotb = wtot + 256;
    volatile unsigned* flag = (volatile unsigned*)(ptotb + 128);
    float* dump = (float*)(ptotb + 128) + 8;
    const bf16_t* RK = (const bf16_t*)(p.ws + OFF_RKVL); const bf16_t* DW = (const bf16_t*)(p.ws + OFF_DW); const bf16_t* AP = (const bf16_t*)p.out;
    bf16_t* OGR = (bf16_t*)(p.ws + OFF_OGR);
    unsigned seq = 0;
    for (int bh = blockIdx.x; bh < 256; bh += gridDim.x) {
        const int b = bh >> 4, h = bh & 15, ch = h * 64 + lane;
        const ScanC C{p.rwkv_mu[ch], p.rwkv_mu[1024 + ch], p.rwkv_mu[2048 + ch], p.rwkv_w0[ch], p.rwkv_a0[ch], p.rwkv_k_k[ch], p.rwkv_k_a[ch], p.rwkv_r_k[ch], p.rwkv_gn_g[ch], p.rwkv_gn_b[ch]};
        f32x2 S[8];
#pragma unroll
        for (int i = 0; i < 8; ++i) S[i] = (f32x2){0.f, 0.f};
        ScanRaw R;
        if (tid < 4) flag[tid] = 0u;
        __syncthreads();
        ++seq;
        if (!cons) { scan_load_raw(R, S, RK, DW, AP, b, 0, pw, ch); scan_prep(R, S, C, 0, pw, lane, seq, recb, vbufb, sclb, wtot, ptotb, flag); scan_load_raw(R, S, RK, DW, AP, b, 1, pw, ch); }
        __syncthreads();
        for (int c = 0; c < SNCH; ++c) {
            const int cb = c & 1, c3 = c % 3, n3 = (c + 1) % 3, p3 = (c + 2) % 3;
            ++seq;
            if (cons) {
                const float* vb = vbufb + c3 * (SCH * 64); const f32x2* sc2 = (const f32x2*)(sclb + c3 * SCH); float* ob = obufb + cb * (SCH * 64);
                const f32x4* rq = (const f32x4*)(recb + cb * (SCH * SREC) + g * 68);
                ScanOps A; scan_load_ops(A, rq);
                float v0 = vb[srow]; f32x2 s0 = sc2[0];
                __builtin_amdgcn_s_setprio(3);
                for (int tt = 0; tt < SCH; ++tt) {
                    const int tn = tt + 1 < SCH ? tt + 1 : SCH - 1;
                    const float nv0 = vb[tn * 64 + srow]; const f32x2 ns0 = sc2[2 * tn];
                    scan_step(S, A, rq + tn * (SREC / 4), v0, lead, s0, ob, dump, tt, srow);
                    v0 = nv0; s0 = ns0;
                }
                __builtin_amdgcn_s_setprio(0);
                { const f32x4* pq = (const f32x4*)(ptotb + cb * 64 + g * 16);
#pragma unroll
                    for (int j = 0; j < 4; ++j) { const f32x4 pp = pq[j]; S[2 * j] *= (f32x2){pp[0], pp[1]}; S[2 * j + 1] *= (f32x2){pp[2], pp[3]}; } }
            } else {
                bf16_t og[8]; bf16_t* dst0 = OGR + ((size_t)b * SEQ + (c > 0 ? c - 1 : 0) * SCH + pw) * 1024 + ch;
#pragma unroll
                for (int i = 0; i < 8; ++i) og[i] = dst0[(size_t)i * 4096];
                if (c + 1 < SNCH) { scan_prep(R, S, C, c + 1, pw, lane, seq, recb + (cb ^ 1) * (SCH * SREC), vbufb + n3 * (SCH * 64), sclb + n3 * SCH, wtot, ptotb + (cb ^ 1) * 64, flag);
                    if (c + 2 < SNCH) scan_load_raw(R, S, RK, DW, AP, b, c + 2, pw, ch); }
                if (c > 0) scan_post(og, dst0, C, pw, lane, obufb + (cb ^ 1) * (SCH * 64), vbufb + p3 * (SCH * 64), sclb + p3 * SCH);
            }
            __syncthreads();
        }
        if (!cons) { const int cl = SNCH - 1; bf16_t og[8]; bf16_t* dst0 = OGR + ((size_t)b * SEQ + cl * SCH + pw) * 1024 + ch;
#pragma unroll
            for (int i = 0; i < 8; ++i) og[i] = dst0[(size_t)i * 4096];
            scan_post(og, dst0, C, pw, lane, obufb + (cl & 1) * (SCH * 64), vbufb + (cl % 3) * (SCH * 64), sclb + (cl % 3) * SCH); }
        __syncthreads();
    }
}
__device__ void phase_final(const Params& p) {
    const int tid = tid_opaque(), w = tid >> 6, lane = tid & 63;
    for (int tok = blockIdx.x * 8 + w; tok < T; tok += gridDim.x * 8) {
        float* xr = p.out + (size_t)tok * 1024; f32x4 v[4]; float ss = 0.f;
#pragma unroll
        for (int q = 0; q < 4; ++q) { v[q] = *(const f32x4*)(xr + q * 256 + lane * 4); ss += v[q][0] * v[q][0] + v[q][1] * v[q][1] + v[q][2] * v[q][2] + v[q][3] * v[q][3]; }
        ss = wave_sum(ss); const float rstd = rsqrtf(ss * (1.f / 1024.f) + 1e-6f);
#pragma unroll
        for (int q = 0; q < 4; ++q) { const int col = q * 256 + lane * 4; *(f32x4*)(xr + col) = v[q] * rstd * *(const f32x4*)(p.final_g + col); }
    }
}

template <int FIRST, int LAST> __global__ __launch_bounds__(512, 2) void mega(Params p) {
    extern __shared__ __attribute__((aligned(16))) unsigned char smem[];
    LAS unsigned char* lds = (LAS unsigned char*)smem;
    cg::grid_group grid = cg::this_grid();
    unsigned* bar = (unsigned*)(uniform_ptr(p.ws) + OFF_BAR);
    volatile LAS unsigned* st = (volatile LAS unsigned*)(lds + LDS_BYTES);
    if (threadIdx.x == 0) { st[0] = 0u; st[1] = 0u; (void)xb_add(&bar[XB_XCNT(xb_xcc_id())], 1u); }
    __syncthreads();
    if (p.ws == nullptr) grid.sync();
    unsigned char* ws = p.ws;
    const int G = gridDim.x, c = blockIdx.x;
    if (FIRST <= 0 && 0 < LAST) { phase_mod(p, smem); phase_weights(p, smem); }
    if (FIRST <= 1 && 1 < LAST) { if (FIRST < 1) grid_barrier(bar, st); phase_h(p); }
    if (FIRST <= 2 && 2 < LAST) { if (FIRST < 2) grid_barrier(bar, st);
        pg8::Sched1 S{T / 256, N1 / 256, G, c, (const char*)p.out, (const char*)(ws + OFF_WINT), (size_t)256 * 1024 * 2};
        EpiG1 E{ws, (unsigned char*)p.out};
        pg8::gemm_phase(lds, 1024, S, E); }
    if (FIRST <= 3 && 3 < LAST) { if (FIRST < 3) grid_barrier(bar, st); phase_conv(p, smem); }
    if (FIRST <= 4 && 4 < LAST) { if (FIRST < 4) grid_barrier(bar, st);
        pg8::Sched1 S{T / 256, 2048 / 256, G, c, (const char*)(ws + OFF_ALORA), (const char*)(ws + OFF_LBT), (size_t)256 * 128 * 2};
        EpiLora E{(bf16_t*)(ws + OFF_DW), (bf16_t*)p.out};
        pg8::gemm_phase(lds, 128, S, E); }
    if (FIRST <= 5 && 5 < LAST) { if (FIRST < 5) grid_barrier(bar, st); phase_scan(p, smem); }
    if (FIRST <= 6 && 6 < LAST) { if (FIRST < 6) grid_barrier(bar, st);
        pg8::Sched2 S{T / 256, 4, G, c, (const char*)(ws + OFF_OGC), (const char*)(ws + OFF_OGR), (const char*)(ws + OFF_W2T), (const char*)(ws + OFF_W2T + 2 * MiB), (size_t)256 * 1024 * 2};
        EpiG2 E{(const bf16_t*)(ws + OFF_GC), (const bf16_t*)((unsigned char*)p.out + 64 * MiB), (bf16_t*)(ws + OFF_M)};
        pg8::gemm_phase(lds, 1024, S, E); }
    if (FIRST <= 7 && 7 < LAST) { if (FIRST < 7) grid_barrier(bar, st);
        pg8::Sched1 S{T / 256, 4, G, c, (const char*)(ws + OFF_M), (const char*)(ws + OFF_WOT), (size_t)256 * 1024 * 2};
        EpiG3 E{p.x, (const float*)(ws + OFF_MOD), p.final_g, p.out, (float*)(ws + OFF_ROWSS), (unsigned*)(ws + OFF_PCNT)};
        pg8::gemm_phase(lds, 1024, S, E); }
}

template <int PH> static void launch_one(const Params& p, hipStream_t stream) {
    hipFuncSetAttribute((const void*)mega<PH, PH + 1>, hipFuncAttributeMaxDynamicSharedMemorySize, LDS_BYTES);
    mega<PH, PH + 1><<<256, 512, LDS_BYTES, stream>>>(p);
}

extern "C" void kernel_launch(void* const* d_in, const int* in_sizes, int n_in, void* d_out, int out_size, void* d_ws, size_t ws_size, hipStream_t stream) {
    Params p{};
    const float** f = (const float**)&p;
    for (int i = 0; i < 24; ++i) f[i] = (const float*)d_in[i];
    p.out = (float*)d_out; p.ws = (unsigned char*)d_ws;
    if (ws_size < WS_END) { fprintf(stderr, "workspace too small: %zu < %zu\n", ws_size, (size_t)WS_END); return; }
#if SINGLE_LAUNCH
    static int grid_blocks = 0;
    if (!grid_blocks) {
        int dev = 0, cus = 0, per_cu = 0;
        hipGetDevice(&dev);
        hipDeviceGetAttribute(&cus, hipDeviceAttributeMultiprocessorCount, dev);
        hipFuncSetAttribute((const void*)mega<0, NPHASE>, hipFuncAttributeMaxDynamicSharedMemorySize, LDS_BYTES + 16);
        hipOccupancyMaxActiveBlocksPerMultiprocessor(&per_cu, mega<0, NPHASE>, 512, LDS_BYTES + 16);
        grid_blocks = cus * (per_cu > 1 ? 1 : per_cu);
        if (grid_blocks > 256) grid_blocks = 256;
    }
    hipMemsetAsync((unsigned char*)d_ws + OFF_BAR, 0, 3456 * 4, stream);
    void* args[] = {(void*)&p};
    hipError_t e = hipLaunchCooperativeKernel((const void*)mega<0, NPHASE>, dim3(grid_blocks), dim3(512), args, LDS_BYTES + 16, stream);
    if (e != hipSuccess) fprintf(stderr, "cooperative launch failed: %s (grid %d)\n", hipGetErrorString(e), grid_blocks);
#else
    launch_one<0>(p, stream); launch_one<1>(p, stream); launch_one<2>(p, stream); launch_one<3>(p, stream); launch_one<4>(p, stream);
    launch_one<5>(p, stream); launch_one<6>(p, stream); launch_one<7>(p, stream); launch_one<8>(p, stream);
#endif
}
```

```cpp
#include <hip/hip_runtime.h>
#include <hip/hip_cooperative_groups.h>
#include <cstdio>
namespace cg = cooperative_groups;

#ifndef SINGLE_LAUNCH
#define SINGLE_LAUNCH 1
#endif

#define LAS __attribute__((address_space(3)))
#define GAS __attribute__((address_space(1)))
typedef unsigned short bf16_t;
typedef short bf16x8 __attribute__((ext_vector_type(8)));
typedef float f32x8 __attribute__((ext_vector_type(8)));
typedef float f32x4 __attribute__((ext_vector_type(4)));
typedef float f32x2 __attribute__((ext_vector_type(2)));
typedef unsigned u32x4 __attribute__((ext_vector_type(4)));
typedef unsigned u32x2 __attribute__((ext_vector_type(2)));

constexpr int T = 32768, DM = 1024, SEQ = 2048, NB_ = 16;
constexpr int N1 = 9472;
constexpr int LDR = 3328;
constexpr int LDS_BYTES = 131072;
constexpr int NPHASE = 9;

constexpr size_t MiB = 1u << 20;
constexpr size_t OFF_U = 0, OFF_OGC = 64 * MiB, OFF_RKVL = 128 * MiB, OFF_OGR = 336 * MiB, OFF_GC = 400 * MiB, OFF_WINT = 464 * MiB;
constexpr size_t OFF_ALORA = OFF_WINT + (size_t)N1 * 1024 * 2;
constexpr size_t OFF_W2T = OFF_ALORA + 16 * MiB, OFF_WOT = OFF_W2T + 4 * MiB, OFF_LBT = OFF_WOT + 2 * MiB, OFF_MOD = OFF_LBT + 1 * MiB;
constexpr size_t OFF_BAR = OFF_MOD + 16 * 3072 * 4;
constexpr size_t OFF_ROWSS = OFF_BAR + 3456 * 4 + 128;
constexpr size_t OFF_PCNT = OFF_ROWSS + (size_t)T * 4;
constexpr size_t WS_END = OFF_PCNT + 256 * 4;
constexpr size_t OFF_MP = OFF_RKVL, OFF_M = OFF_RKVL + 128 * MiB, OFF_DW = OFF_U;

struct Params {
    const float *x, *c, *ada_w, *ada_b, *norm_g, *w_in, *conv_k, *conv_b, *conv_ln_g, *conv_ln_b, *w_conv_out, *rwkv_mu, *rwkv_w0, *rwkv_w2, *rwkv_a0, *rwkv_a2,
        *rwkv_k_k, *rwkv_k_a, *rwkv_r_k, *rwkv_gn_g, *rwkv_gn_b, *w_rwkv_out, *w_out, *final_g;
    float* out;
    unsigned char* ws;
};

typedef __bf16 bf16x2_t __attribute__((ext_vector_type(2)));
__device__ __forceinline__ unsigned cvt_pk_bf16(float lo, float hi) { const bf16x2_t r = __builtin_convertvector((f32x2){lo, hi}, bf16x2_t); return __builtin_bit_cast(unsigned, r); }
__device__ __forceinline__ bf16_t f2bf(float f) { return (bf16_t)(cvt_pk_bf16(f, 0.f) & 0xffffu); }
__device__ __forceinline__ float bf2f(bf16_t b) { return __uint_as_float(((unsigned)b) << 16); }
__device__ __forceinline__ float bflo(unsigned v) { return __uint_as_float(v << 16); }
__device__ __forceinline__ float bfhi(unsigned v) { return __uint_as_float(v & 0xffff0000u); }
__device__ __forceinline__ float sigm(float x) { return __builtin_amdgcn_rcpf(1.f + __expf(-x)); }
__device__ __forceinline__ int tid_opaque() { int t = threadIdx.x; asm volatile("" : "+v"(t)); return t; }
__device__ __forceinline__ unsigned char* uniform_ptr(unsigned char* p) { const size_t v = (size_t)p; const unsigned lo = __builtin_amdgcn_readfirstlane((unsigned)v), hi = __builtin_amdgcn_readfirstlane((unsigned)(v >> 32)); return (unsigned char*)(((size_t)hi << 32) | lo); }
template <int CTRL> __device__ __forceinline__ float dpp_add(float v) { return v + __int_as_float(__builtin_amdgcn_update_dpp(0, __float_as_int(v), CTRL, 0xF, 0xF, true)); }
__device__ __forceinline__ float wave_sum(float v) {
    v = dpp_add<0xB1>(v); v = dpp_add<0x4E>(v); v = dpp_add<0x141>(v); v = dpp_add<0x140>(v);
    const int iv = __float_as_int(v);
    return (__int_as_float(__builtin_amdgcn_readlane(iv, 0)) + __int_as_float(__builtin_amdgcn_readlane(iv, 16))) + (__int_as_float(__builtin_amdgcn_readlane(iv, 32)) + __int_as_float(__builtin_amdgcn_readlane(iv, 48)));
}

#define XB_TMO      128
#define XB_XCNT(j)  (256  + 64 * (j))
#define XB_XSUB(j)  (1280 + 64 * (j))
#define XB_XGEN(j)  (2304 + 64 * (j))
#define XB_TOP      3328
#define XB_TOPGEN   3392
#define XB_WORDS    3456
#define XB_SPIN_CAP (1u << 22)
__device__ __forceinline__ unsigned xb_ld(unsigned* p)              { return __hip_atomic_load(p, __ATOMIC_RELAXED, __HIP_MEMORY_SCOPE_AGENT); }
__device__ __forceinline__ unsigned xb_add(unsigned* p, unsigned v) { return __hip_atomic_fetch_add(p, v, __ATOMIC_RELAXED, __HIP_MEMORY_SCOPE_AGENT); }
__device__ __forceinline__ unsigned xb_xcc_id() { return (unsigned)__builtin_amdgcn_s_getreg((3 << 11) | 20) & 0xFu; }
#define XB_SPIN(cond, bar) do { unsigned _sp = 0; while (cond) { __builtin_amdgcn_s_sleep(1); \
    if ((++_sp & 255u) == 0u) { if (xb_ld(&(bar)[XB_TMO])) break; if (_sp > XB_SPIN_CAP) { atomicAdd(&(bar)[XB_TMO], 1u); break; } } } } while (0)
__device__ __forceinline__ void xcd_barrier_complete(unsigned* bar, unsigned x, unsigned& nloc, unsigned& nx) {
    const unsigned G = gridDim.x; unsigned sum, cnt, mine, sp = 0u;
    for (;;) { sum = 0u; cnt = 0u; mine = 0u;
#pragma unroll
        for (unsigned j = 0; j < 16; ++j) { const unsigned c = xb_ld(&bar[XB_XCNT(j)]); sum += c; cnt += (c > 0u) ? 1u : 0u; mine = (j == x) ? c : mine; }
        if (sum == G) break;
        __builtin_amdgcn_s_sleep(1);
        if ((++sp & 255u) == 0u) { if (xb_ld(&bar[XB_TMO])) break; if (sp > XB_SPIN_CAP) { atomicAdd(&bar[XB_TMO], 1u); break; } } }
    nloc = mine > 0u ? mine : 1u; nx = cnt > 0u ? cnt : 1u;
}
__device__ __forceinline__ void grid_barrier(unsigned* bar, volatile LAS unsigned* st) {
    asm volatile("s_waitcnt vmcnt(0) lgkmcnt(0)" ::: "memory");
    __syncthreads();
    if (threadIdx.x == 0) {
        const unsigned x = xb_xcc_id();
        unsigned nloc = st[0], nx = st[1];
        if (nloc == 0u) { xcd_barrier_complete(bar, x, nloc, nx); st[0] = nloc; st[1] = nx; }
        const unsigned old = xb_add(&bar[XB_XSUB(x)], 1u);
        const unsigned gen = old / nloc;
        if (old + 1u == (gen + 1u) * nloc) {
            __builtin_amdgcn_fence(__ATOMIC_RELEASE, "agent");
            asm volatile("s_waitcnt vmcnt(0)" ::: "memory");
            const unsigned og = xb_add(&bar[XB_TOP], 1u);
            const unsigned tg = og / nx;
            if (og + 1u == (tg + 1u) * nx) xb_add(&bar[XB_TOPGEN], 1u);
            else XB_SPIN(xb_ld(&bar[XB_TOPGEN]) == tg, bar);
            __builtin_amdgcn_fence(__ATOMIC_ACQUIRE, "agent");
            xb_add(&bar[XB_XGEN(x)], 1u);
            asm volatile("s_waitcnt vmcnt(0)" ::: "memory");
        } else {
            XB_SPIN(xb_ld(&bar[XB_XGEN(x)]) == gen, bar);
            __builtin_amdgcn_fence(__ATOMIC_ACQUIRE, "agent");
            asm volatile("s_waitcnt vmcnt(0)" ::: "memory");
        }
    }
    __syncthreads();
}

namespace pg8 {
constexpr int BM = 256, BK = 64, HALF = 128, HTB = HALF * BK * 2, NXCD = 8, WGM = 8;
__host__ __device__ __forceinline__ int lds_byte(int r, int c) { const int st = (r >> 4) * 2 + (c >> 5), rr = r & 15, cc = c & 31, ob = rr * 64 + cc * 2; return st * 1024 + (ob ^ (((ob >> 9) & 1) << 5)); }
__host__ __device__ __forceinline__ void stage_rc(int b, int& R, int& C) { const int st = b / 1024, sb = b % 1024, swz = sb ^ (((sb >> 9) & 1) << 5); R = (st >> 1) * 16 + swz / 64; C = (st & 1) * 32 + (swz % 64) / 2; }
__host__ __device__ __forceinline__ int perm32(int rho) { const int n = rho >> 4, i = rho & 15; return 8 * (i >> 2) + 4 * n + (i & 3); }
struct Unit { int pm, pn, kind; };

__device__ __forceinline__ void map_unit(int L, int nM, int nN, Unit& u) {
    const int nwg = nM * nN; int wgid = L;
    { const int q = nwg / NXCD, r = nwg % NXCD, xcd = wgid % NXCD, off = wgid / NXCD; wgid = (xcd < r ? xcd * (q + 1) : r * (q + 1) + (xcd - r) * q) + off; }
    const int nig = WGM * nN, gid = wgid / nig, fm = gid * WGM, gsz = (nM - fm) < WGM ? (nM - fm) : WGM;
    u.pm = fm + ((wgid % nig) % gsz); u.pn = (wgid % nig) / gsz;
}
struct Sched1 {
    int nM, nN, G, c; const char* A; const char* Bt; size_t tstep;
    __device__ __forceinline__ bool next(int i, Unit& u) const { const long L = (long)i * G + c; if (L >= (long)nM * nN) return false; map_unit((int)L, nM, nN, u); u.kind = 0; return true; }
    __device__ __forceinline__ const char* aptr(const Unit& u) const { return A + (size_t)u.pm * tstep; }
    __device__ __forceinline__ const char* bptr(const Unit& u) const { return Bt + (size_t)u.pn * tstep; }
};
struct Sched2 {
    int nM, nN, G, c; const char* A0; const char* A1; const char* B0; const char* B1; size_t tstep;
    __device__ __forceinline__ bool next(int i, Unit& u) const { const long L = (long)(i >> 1) * G + c; if (L >= (long)nM * nN) return false; map_unit((int)L, nM, nN, u); u.kind = i & 1; return true; }
    __device__ __forceinline__ const char* aptr(const Unit& u) const { return (u.kind ? A1 : A0) + (size_t)u.pm * tstep; }
    __device__ __forceinline__ const char* bptr(const Unit& u) const { return (u.kind ? B1 : B0) + (size_t)u.pn * tstep; }
};

template <class Epi, class Sched>
__device__ __forceinline__ void gemm_phase(LAS unsigned char* lds, const int K, const Sched& S, const Epi& E) {
    const int tid = tid_opaque(), wid = __builtin_amdgcn_readfirstlane(tid >> 6), lane = tid & 63, wr = wid >> 2, wc = wid & 3, fr = lane & 15, fq = lane >> 4;
    const int nt = K / BK;
    unsigned voffA[2], voffB[2];
#pragma unroll
    for (int i = 0; i < 2; ++i) { int R, C; stage_rc(tid * 16 + i * 8192, R, C); const int Rb = Epi::PERM ? ((R & ~31) + perm32(R & 31)) : R;
        voffA[i] = (unsigned)(R * K + C) * 2u; voffB[i] = (unsigned)(Rb * K + C) * 2u; }
    const size_t kstep = (size_t)(BK * 2);
    const size_t hstep = (size_t)HALF * K * 2;
    const unsigned ldsw = (unsigned)wid * 1024u;
    const int aoff = lds_byte(wr * 64 + fr, fq * 8), boff = lds_byte(wc * 32 + fr, fq * 8);
#define PG8_SA(b, h) (((b) * 2 + (h)) * HTB)
#define PG8_SB(b, h) ((4 + (b) * 2 + (h)) * HTB)
#define PG8_STAGE(bufoff, gbase, voff) do { _Pragma("unroll") for (int _i = 0; _i < 2; ++_i) \
        __builtin_amdgcn_global_load_lds((const unsigned*)((const char*)(gbase) + (voff)[_i]), (LAS unsigned*)(lds + (bufoff) + ldsw + _i * 8192), 16, 0, 0); } while (0)
#define PG8_LDA(dst, b, h) do { _Pragma("unroll") for (int m = 0; m < 4; ++m) _Pragma("unroll") for (int k = 0; k < 2; ++k) dst[m][k] = *(const LAS bf16x8*)(lds + PG8_SA(b, h) + aoff + m * 2048 + k * 1024); } while (0)
#define PG8_LDB(dst, b, h) do { _Pragma("unroll") for (int n = 0; n < 2; ++n) _Pragma("unroll") for (int k = 0; k < 2; ++k) dst[n][k] = *(const LAS bf16x8*)(lds + PG8_SB(b, h) + boff + n * 2048 + k * 1024); } while (0)
#define PG8_MMA(ai, bj, At, Bt) do { __builtin_amdgcn_s_setprio(1); _Pragma("unroll") for (int m = 0; m < 4; ++m) _Pragma("unroll") for (int n = 0; n < 2; ++n) _Pragma("unroll") for (int k = 0; k < 2; ++k) \
        acc[ai][bj][m][n] = __builtin_amdgcn_mfma_f32_16x16x32_bf16(Bt[n][k], At[m][k], acc[ai][bj][m][n], 0, 0, 0); __builtin_amdgcn_s_setprio(0); } while (0)
#define PG8_WAIT_V(n) asm volatile("s_waitcnt vmcnt(" #n ")" ::: "memory")
#define PG8_WAIT_L(n) asm volatile("s_waitcnt lgkmcnt(" #n ")" ::: "memory")
#define PG8_BAR __builtin_amdgcn_s_barrier()
#define PG8_SCHED __builtin_amdgcn_sched_barrier(0)
    Unit cur, nxt; int ui = 0;
    if (!S.next(0, cur)) return;
    f32x4 acc[2][2][4][2];
#pragma unroll
    for (int a = 0; a < 2; ++a)
#pragma unroll
        for (int b = 0; b < 2; ++b)
#pragma unroll
            for (int m = 0; m < 4; ++m)
#pragma unroll
                for (int n = 0; n < 2; ++n) acc[a][b][m][n] = (f32x4){0.f, 0.f, 0.f, 0.f};
    bf16x8 At[4][2], B0[2][2], B1[2][2];
    const char* cA = S.aptr(cur); const char* cB = S.bptr(cur);
    PG8_STAGE(PG8_SB(0, 0), cB, voffB); PG8_STAGE(PG8_SA(0, 0), cA, voffA); PG8_STAGE(PG8_SB(0, 1), cB + hstep, voffB); PG8_STAGE(PG8_SA(0, 1), cA + hstep, voffA);
    if (wr == 1) PG8_BAR;
    PG8_WAIT_V(4); PG8_BAR;
    PG8_STAGE(PG8_SB(1, 0), cB + kstep, voffB); PG8_STAGE(PG8_SA(1, 0), cA + kstep, voffA); PG8_STAGE(PG8_SB(1, 1), cB + hstep + kstep, voffB);
    PG8_WAIT_V(6); PG8_BAR;
    for (;;) {
        const bool has_next = S.next(ui + 1, nxt);
        const char* nA = has_next ? S.aptr(nxt) : cA; const char* nB = has_next ? S.bptr(nxt) : cB;
        for (int t = 0; t < nt; t += 2) {
            const bool last = (t == nt - 2);
            const char* a1 = cA + (size_t)(t + 1) * kstep;
            const char* a2 = last ? nA : cA + (size_t)(t + 2) * kstep; const char* b2 = last ? nB : cB + (size_t)(t + 2) * kstep;
            const char* a3 = a2 + kstep; const char* b3 = b2 + kstep;
            PG8_LDB(B0, 0, 0); PG8_SCHED; PG8_LDA(At, 0, 0); PG8_STAGE(PG8_SA(1, 1), a1 + hstep, voffA);
            PG8_WAIT_L(8); PG8_BAR; PG8_WAIT_L(0); PG8_MMA(0, 0, At, B0); PG8_BAR; PG8_SCHED;
            PG8_LDB(B1, 0, 1); PG8_STAGE(PG8_SB(0, 0), b2, voffB);
            PG8_BAR; PG8_WAIT_L(0); PG8_MMA(0, 1, At, B1); PG8_BAR;
            PG8_LDA(At, 0, 1); PG8_STAGE(PG8_SA(0, 0), a2, voffA);
            PG8_BAR; PG8_WAIT_L(0); PG8_MMA(1, 0, At, B0); PG8_BAR; PG8_SCHED;
            PG8_STAGE(PG8_SB(0, 1), b2 + hstep, voffB);
            PG8_WAIT_V(6); PG8_BAR; PG8_MMA(1, 1, At, B1); PG8_BAR;
            PG8_LDB(B0, 1, 0); PG8_SCHED; PG8_LDA(At, 1, 0); PG8_STAGE(PG8_SA(0, 1), a2 + hstep, voffA);
            PG8_WAIT_L(8); PG8_BAR; PG8_WAIT_L(0); PG8_MMA(0, 0, At, B0); PG8_BAR; PG8_SCHED;
            PG8_LDB(B1, 1, 1); PG8_STAGE(PG8_SB(1, 0), b3, voffB);
            PG8_BAR; PG8_WAIT_L(0); PG8_MMA(0, 1, At, B1); PG8_BAR;
            PG8_LDA(At, 1, 1); PG8_STAGE(PG8_SA(1, 0), a3, voffA);
            PG8_BAR; PG8_WAIT_L(0); PG8_MMA(1, 0, At, B0); PG8_BAR; PG8_SCHED;
            PG8_STAGE(PG8_SB(1, 1), b3 + hstep, voffB);
            PG8_WAIT_V(6); PG8_BAR; PG8_MMA(1, 1, At, B1); PG8_BAR;
        }
        E(acc, cur, wr, wc, fr, fq);
        if (!has_next) break;
        if (!E.keep(cur)) {
#pragma unroll
        for (int a = 0; a < 2; ++a)
#pragma unroll
            for (int b = 0; b < 2; ++b)
#pragma unroll
                for (int m = 0; m < 4; ++m)
#pragma unroll
                    for (int n = 0; n < 2; ++n) acc[a][b][m][n] = (f32x4){0.f, 0.f, 0.f, 0.f};
        }
        cur = nxt; cA = nA; cB = nB; ++ui;
    }
    PG8_WAIT_V(0);
    if (wr == 0) PG8_BAR;
    PG8_BAR;
#undef PG8_SA
#undef PG8_SB
#undef PG8_STAGE
#undef PG8_LDA
#undef PG8_LDB
#undef PG8_MMA
#undef PG8_WAIT_V
#undef PG8_WAIT_L
#undef PG8_BAR
#undef PG8_SCHED
}
}
using pg8::Unit;

template <int ACT> __device__ __forceinline__ float actf(float v) { return ACT == 1 ? v * sigm(v) : (ACT == 2 ? sigm(v) : v); }
template <int ACT> __device__ __forceinline__ void store_tile_bf16(const f32x4 (&acc)[2][2][4][2], bf16_t* base  , int ld) {
#pragma unroll
    for (int ai = 0; ai < 2; ++ai)
#pragma unroll
        for (int m = 0; m < 4; ++m) { bf16_t* rowp = base + (size_t)(ai * 128 + m * 16) * ld;
#pragma unroll
            for (int bj = 0; bj < 2; ++bj) { const f32x4 v0 = acc[ai][bj][m][0], v1 = acc[ai][bj][m][1]; u32x4 w;
                w.x = cvt_pk_bf16(actf<ACT>(v0[0]), actf<ACT>(v0[1])); w.y = cvt_pk_bf16(actf<ACT>(v0[2]), actf<ACT>(v0[3]));
                w.z = cvt_pk_bf16(actf<ACT>(v1[0]), actf<ACT>(v1[1])); w.w = cvt_pk_bf16(actf<ACT>(v1[2]), actf<ACT>(v1[3]));
                *(GAS u32x4*)(rowp + bj * 128) = w; } }
}
struct EpiG1 {
    static constexpr bool PERM = true;
    __device__ __forceinline__ bool keep(const Unit&) const { return false; }
    unsigned char *ws, *outb;
    __device__ __forceinline__ void operator()(const f32x4 (&acc)[2][2][4][2], const Unit& u, int wr, int wc, int fr, int fq) const {
        unsigned char* w = uniform_ptr(ws); unsigned char* ob = uniform_ptr(outb); asm volatile("" : "+s"(w), "+s"(ob));
        const int row0 = u.pm * 256 + wr * 64 + fr, pn = u.pn, cw = wc * 32 + 8 * fq;
        if (pn < 8) {
            bf16_t* base = (bf16_t*)(w + OFF_U) + (size_t)row0 * 1024 + pn * 128 + cw;
#pragma unroll
            for (int ai = 0; ai < 2; ++ai)
#pragma unroll
                for (int m = 0; m < 4; ++m) { const f32x4 a0 = acc[ai][0][m][0], a1 = acc[ai][0][m][1], g0 = acc[ai][1][m][0], g1 = acc[ai][1][m][1]; u32x4 wv;
                    wv.x = cvt_pk_bf16(a0[0] * sigm(g0[0]), a0[1] * sigm(g0[1])); wv.y = cvt_pk_bf16(a0[2] * sigm(g0[2]), a0[3] * sigm(g0[3]));
                    wv.z = cvt_pk_bf16(a1[0] * sigm(g1[0]), a1[1] * sigm(g1[1])); wv.w = cvt_pk_bf16(a1[2] * sigm(g1[2]), a1[3] * sigm(g1[3]));
                    *(GAS u32x4*)(base + (size_t)(ai * 128 + m * 16) * 1024) = wv; }
        } else if (pn < 12) store_tile_bf16<1>(acc, (bf16_t*)(w + OFF_OGC) + (size_t)row0 * 1024 + (pn - 8) * 256 + cw, 1024);
        else if (pn < 25) store_tile_bf16<0>(acc, (bf16_t*)(w + OFF_RKVL) + (size_t)row0 * LDR + (pn - 12) * 256 + cw, LDR);
        else if (pn < 29) store_tile_bf16<1>(acc, (bf16_t*)(w + OFF_OGR) + (size_t)row0 * 1024 + (pn - 25) * 256 + cw, 1024);
        else if (pn < 33) store_tile_bf16<2>(acc, (bf16_t*)(w + OFF_GC) + (size_t)row0 * 1024 + (pn - 29) * 256 + cw, 1024);
        else store_tile_bf16<2>(acc, (bf16_t*)(ob + 64 * MiB) + (size_t)row0 * 1024 + (pn - 33) * 256 + cw, 1024);
    }
};
struct EpiLora {
    static constexpr bool PERM = true;
    __device__ __forceinline__ bool keep(const Unit&) const { return false; }
    bf16_t *DW, *AP;
    __device__ __forceinline__ void operator()(const f32x4 (&acc)[2][2][4][2], const Unit& u, int wr, int wc, int fr, int fq) const {
        const int row0 = u.pm * 256 + wr * 64 + fr, cw = wc * 32 + 8 * fq;
        bf16_t* base = (u.pn < 4 ? DW + (size_t)u.pn * 256 : AP + (size_t)(u.pn - 4) * 256) + (size_t)row0 * 1024 + cw;
        store_tile_bf16<0>(acc, base, 1024);
    }
};
struct EpiG2 {
    static constexpr bool PERM = true;
    const bf16_t *GC, *GR; bf16_t* M;
    __device__ __forceinline__ bool keep(const Unit& u) const { return u.kind == 0; }
    __device__ __forceinline__ void operator()(f32x4 (&acc)[2][2][4][2], const Unit& u, int wr, int wc, int fr, int fq) const {
        const size_t off0 = (size_t)(u.pm * 256 + wr * 64 + fr) * 1024 + u.pn * 256 + wc * 32 + 8 * fq;
#pragma unroll
        for (int ai = 0; ai < 2; ++ai)
#pragma unroll
        for (int mh = 0; mh < 2; ++mh) {
            u32x4 grv[4][2];
#pragma unroll
            for (int m = 2 * mh; m < 2 * mh + 2; ++m)
#pragma unroll
                for (int bj = 0; bj < 2; ++bj) grv[m][bj] = *(const GAS u32x4*)(GR + off0 + (size_t)(ai * 128 + m * 16) * 1024 + bj * 128);
            if (u.kind == 0) {
                u32x4 gcv[4][2];
#pragma unroll
                for (int m = 2 * mh; m < 2 * mh + 2; ++m)
#pragma unroll
                    for (int bj = 0; bj < 2; ++bj) gcv[m][bj] = *(const GAS u32x4*)(GC + off0 + (size_t)(ai * 128 + m * 16) * 1024 + bj * 128);
#pragma unroll
                for (int m = 2 * mh; m < 2 * mh + 2; ++m)
#pragma unroll
                    for (int bj = 0; bj < 2; ++bj) { const u32x4 gr = grv[m][bj], gc = gcv[m][bj]; f32x4& v0 = acc[ai][bj][m][0]; f32x4& v1 = acc[ai][bj][m][1];
                        const f32x4 r0 = {bflo(gr.x), bfhi(gr.x), bflo(gr.y), bfhi(gr.y)}, r1 = {bflo(gr.z), bfhi(gr.z), bflo(gr.w), bfhi(gr.w)};
                        const f32x4 c0 = {bflo(gc.x), bfhi(gc.x), bflo(gc.y), bfhi(gc.y)}, c1 = {bflo(gc.z), bfhi(gc.z), bflo(gc.w), bfhi(gc.w)};
#pragma unroll
                        for (int j = 0; j < 4; ++j) { v0[j] *= c0[j] * __builtin_amdgcn_rcpf(fmaxf(r0[j], 1e-30f)); v1[j] *= c1[j] * __builtin_amdgcn_rcpf(fmaxf(r1[j], 1e-30f)); } }
            } else {
#pragma unroll
                for (int m = 2 * mh; m < 2 * mh + 2; ++m)
#pragma unroll
                    for (int bj = 0; bj < 2; ++bj) { const u32x4 gr = grv[m][bj]; const f32x4 v0 = acc[ai][bj][m][0], v1 = acc[ai][bj][m][1];
                        const f32x4 r0 = {bflo(gr.x), bfhi(gr.x), bflo(gr.y), bfhi(gr.y)}, r1 = {bflo(gr.z), bfhi(gr.z), bflo(gr.w), bfhi(gr.w)};
                        const f32x4 m0 = v0 * r0, m1 = v1 * r1; u32x4 w;
                        w.x = cvt_pk_bf16(m0[0], m0[1]); w.y = cvt_pk_bf16(m0[2], m0[3]); w.z = cvt_pk_bf16(m1[0], m1[1]); w.w = cvt_pk_bf16(m1[2], m1[3]);
                        *(GAS u32x4*)(M + off0 + (size_t)(ai * 128 + m * 16) * 1024 + bj * 128) = w; }
            }
        }
    }
};
struct EpiG3 {
    static constexpr bool PERM = false;
    const float *x, *mod, *fg; float* out; float* rowss; unsigned* pcnt;
    __device__ __forceinline__ bool keep(const Unit&) const { return false; }
    __device__ __forceinline__ void operator()(f32x4 (&acc)[2][2][4][2], const Unit& u, int wr, int wc, int fr, int fq) const {
        const int col0 = u.pn * 256 + wc * 32 + 4 * fq, row0 = u.pm * 256 + wr * 64 + fr; const size_t off0 = (size_t)row0 * 1024 + col0;
        const float* gp = mod + (size_t)(u.pm >> 3) * 3072 + 2048 + col0;
        { f32x4 gv[2][2];
#pragma unroll
        for (int bj = 0; bj < 2; ++bj)
#pragma unroll
            for (int n = 0; n < 2; ++n) gv[bj][n] = *(const GAS f32x4*)(gp + bj * 128 + n * 16);
#pragma unroll
        for (int ai = 0; ai < 2; ++ai)
#pragma unroll
            for (int m = 0; m < 4; ++m) { float ps = 0.f;
#pragma unroll
                for (int bj = 0; bj < 2; ++bj)
#pragma unroll
                    for (int n = 0; n < 2; ++n) { const size_t off = off0 + (size_t)(ai * 128 + m * 16) * 1024 + bj * 128 + n * 16;
                        const f32x4 v = *(const GAS f32x4*)(x + off) + gv[bj][n] * acc[ai][bj][m][n]; acc[ai][bj][m][n] = v; ps += v[0] * v[0] + v[1] * v[1] + v[2] * v[2] + v[3] * v[3]; }
                ps += __shfl_xor(ps, 16); ps += __shfl_xor(ps, 32);
                if (fq == 0) __hip_atomic_fetch_add(rowss + row0 + ai * 128 + m * 16, ps, __ATOMIC_RELAXED, __HIP_MEMORY_SCOPE_AGENT); } }
        asm volatile("s_waitcnt vmcnt(0)" ::: "memory");
        unsigned* pc = pcnt + u.pm * 2 + wr;
        if (fr == 0 && fq == 0) __hip_atomic_fetch_add(pc, 1u, __ATOMIC_RELAXED, __HIP_MEMORY_SCOPE_AGENT);
        { unsigned sp = 0; while (__hip_atomic_load(pc, __ATOMIC_RELAXED, __HIP_MEMORY_SCOPE_AGENT) < 16u && ++sp < (1u << 22)) __builtin_amdgcn_s_sleep(1); }
#pragma unroll
        for (int ai = 0; ai < 2; ++ai)
#pragma unroll
            for (int m = 0; m < 4; ++m) { const float ss = __hip_atomic_load(rowss + row0 + ai * 128 + m * 16, __ATOMIC_RELAXED, __HIP_MEMORY_SCOPE_AGENT);
                const float rstd = __builtin_amdgcn_rsqf(ss * (1.f / 1024.f) + 1e-6f);
#pragma unroll
                for (int bj = 0; bj < 2; ++bj)
#pragma unroll
                    for (int n = 0; n < 2; ++n) { const size_t off = off0 + (size_t)(ai * 128 + m * 16) * 1024 + bj * 128 + n * 16;
                        *(GAS f32x4*)(out + off) = acc[ai][bj][m][n] * rstd * *(const GAS f32x4*)(fg + col0 + bj * 128 + n * 16); } }
    }
};

__device__ void phase_mod(const Params& p, unsigned char* smem) {
    if (blockIdx.x >= 48) return;
    float* sc = (float*)smem;
    float* red = sc + 16384;
    const int tid = tid_opaque(), w = tid >> 6, lane = tid & 63;
    for (int i = tid; i < 16384; i += 512) { const int b = i >> 10, d = i & 1023; const float cv = p.c[i]; sc[d * 16 + b] = cv * sigm(cv); }
    __syncthreads();
    const int e = blockIdx.x * 64 + lane;
    float acc[16];
#pragma unroll
    for (int b = 0; b < 16; ++b) acc[b] = 0.f;
    for (int d0 = w * 128; d0 < w * 128 + 128; d0 += 16) {
        float wvs[16];
#pragma unroll
        for (int u = 0; u < 16; ++u) wvs[u] = p.ada_w[(size_t)(d0 + u) * 3072 + e];
#pragma unroll
        for (int u = 0; u < 16; ++u) { const int d = d0 + u; const float wv = wvs[u];
        const f32x4* s4 = (const f32x4*)(sc + d * 16);
#pragma unroll
        for (int q = 0; q < 4; ++q) { const f32x4 s = s4[q]; acc[4 * q] += s[0] * wv; acc[4 * q + 1] += s[1] * wv; acc[4 * q + 2] += s[2] * wv; acc[4 * q + 3] += s[3] * wv; }
        }
    }
#pragma unroll
    for (int b = 0; b < 16; ++b) red[(w * 16 + b) * 64 + lane] = acc[b];
    __syncthreads();
    float* mod = (float*)(p.ws + OFF_MOD);
    for (int i = tid; i < 1024; i += 512) { const int b = i >> 6, l = i & 63; float s = 0.f;
#pragma unroll
        for (int ww = 0; ww < 8; ++ww) s += red[(ww * 16 + b) * 64 + l];
        mod[b * 3072 + blockIdx.x * 64 + l] = s + p.ada_b[blockIdx.x * 64 + l]; }
    __syncthreads();
}
__device__ __forceinline__ void transpose_tile(const float* src, int ld, int n_src0, int k0, bf16_t* dst, int n_dst0, float* tile) {
    const int tid = tid_opaque();
#pragma unroll
    for (int r = 0; r < 2; ++r) { const int i = (tid >> 4) + 32 * r, j4 = (tid & 15) * 4;
        f32x4 v = {0.f, 0.f, 0.f, 0.f}; if (n_src0 >= 0) v = *(const f32x4*)(src + (size_t)(k0 + i) * ld + n_src0 + j4);
        tile[i * 65 + j4] = v[0]; tile[i * 65 + j4 + 1] = v[1]; tile[i * 65 + j4 + 2] = v[2]; tile[i * 65 + j4 + 3] = v[3]; }
    __syncthreads();
    const int j = tid >> 3, i8 = (tid & 7) * 8; u32x4 w;
    w.x = cvt_pk_bf16(tile[(i8 + 0) * 65 + j], tile[(i8 + 1) * 65 + j]); w.y = cvt_pk_bf16(tile[(i8 + 2) * 65 + j], tile[(i8 + 3) * 65 + j]);
    w.z = cvt_pk_bf16(tile[(i8 + 4) * 65 + j], tile[(i8 + 5) * 65 + j]); w.w = cvt_pk_bf16(tile[(i8 + 6) * 65 + j], tile[(i8 + 7) * 65 + j]);
    *(u32x4*)(dst + (size_t)(n_dst0 + j) * 1024 + k0 + i8) = w;
    __syncthreads();
}
__device__ void phase_weights(const Params& p, unsigned char* smem) {
    float* tile = (float*)smem;
    for (int i = blockIdx.x * 512 + threadIdx.x; i < T + 256; i += gridDim.x * 512) ((unsigned*)(p.ws + OFF_ROWSS))[i] = 0u;
    bf16_t* WinT = (bf16_t*)(p.ws + OFF_WINT); bf16_t* W2T = (bf16_t*)(p.ws + OFF_W2T); bf16_t* WoT = (bf16_t*)(p.ws + OFF_WOT); bf16_t* LBt = (bf16_t*)(p.ws + OFF_LBT);
    constexpr int NT1 = (N1 / 64) * 16;
    const bool bal = (gridDim.x == 256); const int nb = blockIdx.x;
    const int first = bal ? (nb >= 48 ? nb - 48 : 2704 + nb) : nb, stride = bal ? (nb >= 48 ? 208 : 48) : (int)gridDim.x, last = bal ? (nb >= 48 ? 2704 : 3136) : NT1 + 768;
    for (int idx = first; idx < last; idx += stride) {
        if (idx < NT1) { const int a = idx >> 4, kt = idx & 15, n0 = a * 64; int src;
            if (n0 < 2048) { const int j = n0 >> 8, wi = n0 & 255; src = wi < 128 ? 128 * j + wi : 1024 + 128 * j + wi - 128; }
            else if (n0 < 6272) src = n0; else if (n0 < 6400) src = -1; else src = n0 - 128;
            transpose_tile(p.w_in, 9344, src, kt * 64, WinT, n0, tile);
        } else { const int r = idx - NT1, which = r >> 8, a = (r >> 4) & 15, kt = r & 15;
            const float* src = which == 0 ? p.w_conv_out : (which == 1 ? p.w_rwkv_out : p.w_out);
            bf16_t* dst = which == 0 ? W2T : (which == 1 ? W2T + (size_t)1024 * 1024 : WoT);
            transpose_tile(src, 1024, a * 64, kt * 64, dst, a * 64, tile); }
    }
    for (int idx = blockIdx.x * 512 + tid_opaque(); idx < 2048 * 128; idx += gridDim.x * 512) { const int n = idx >> 7, k = idx & 127; float v = 0.f;
        if (n < 1024) { if (k < 64) v = p.rwkv_w2[k * 1024 + n]; } else { if (k >= 64) v = p.rwkv_a2[(k - 64) * 1024 + n - 1024]; }
        LBt[idx] = f2bf(v); }
}
__device__ void phase_h(const Params& p) {
    const int tid = tid_opaque(), w = tid >> 6, lane = tid & 63;
    const float* mod = (const float*)(p.ws + OFF_MOD); bf16_t* Hh = (bf16_t*)p.out;
    const int tstride = gridDim.x * 8; f32x4 nv[4];
    { const int tok0 = blockIdx.x * 8 + w; const float* xr = p.x + (size_t)(tok0 < T ? tok0 : 0) * 1024;
#pragma unroll
      for (int q = 0; q < 4; ++q) nv[q] = *(const f32x4*)(xr + q * 256 + lane * 4); }
    for (int tok = blockIdx.x * 8 + w; tok < T; tok += tstride) {
        const int b = tok >> 11; f32x4 v[4]; float ss = 0.f;
#pragma unroll
        for (int q = 0; q < 4; ++q) v[q] = nv[q];
        { const int tn = tok + tstride < T ? tok + tstride : tok; const float* xn = p.x + (size_t)tn * 1024;
#pragma unroll
          for (int q = 0; q < 4; ++q) nv[q] = *(const f32x4*)(xn + q * 256 + lane * 4); }
#pragma unroll
        for (int q = 0; q < 4; ++q) ss += v[q][0] * v[q][0] + v[q][1] * v[q][1] + v[q][2] * v[q][2] + v[q][3] * v[q][3];
        ss = wave_sum(ss); const float rstd = rsqrtf(ss * (1.f / 1024.f) + 1e-6f);
#pragma unroll
        for (int q = 0; q < 4; ++q) { const int col = q * 256 + lane * 4; const f32x4 g = *(const f32x4*)(p.norm_g + col), sh = *(const f32x4*)(mod + b * 3072 + col), sc = *(const f32x4*)(mod + b * 3072 + 1024 + col);
            const f32x4 y = v[q] * rstd * g * (sc + 1.f) + sh; u32x2 o; o.x = cvt_pk_bf16(y[0], y[1]); o.y = cvt_pk_bf16(y[2], y[3]);
            *(u32x2*)(Hh + (size_t)tok * 1024 + col) = o; }
    }
}
__device__ void phase_conv(const Params& p, unsigned char* smem) {
    const int tid = tid_opaque(), w = tid >> 6, lane = tid & 63, c0 = tid * 2;
    const bf16_t* U = (const bf16_t*)(p.ws + OFF_U); bf16_t* OGC = (bf16_t*)(p.ws + OFF_OGC);
    float* part = (float*)smem;
    float* stat = part + 32 * 512;
    f32x2 wk[31];
#pragma unroll
    for (int j = 0; j < 31; ++j) wk[j] = *(const f32x2*)(p.conv_k + j * 1024 + c0);
    const f32x2 cb = *(const f32x2*)(p.conv_b + c0), lg = *(const f32x2*)(p.conv_ln_g + c0), lb = *(const f32x2*)(p.conv_ln_b + c0);
    for (int tile = blockIdx.x; tile < T / 16; tile += gridDim.x) {
        const int b = tile >> 7, t0 = (tile & 127) * 16; const size_t row0 = (size_t)b * SEQ + t0;
        f32x2 u[46];
#pragma unroll
        for (int i = 0; i < 46; ++i) { const int t = t0 - 30 + i; unsigned v = 0u; if (t >= 0) v = *(const unsigned*)(U + ((size_t)b * SEQ + t) * 1024 + c0); u[i] = (f32x2){bflo(v), bfhi(v)}; }
        f32x2 o[16];
#pragma unroll
        for (int i = 0; i < 16; ++i) { f32x2 a = cb;
#pragma unroll
            for (int j = 0; j < 31; ++j) a = wk[j] * u[i + j] + a;
            o[i] = a; }
        unsigned ogv[16];
#pragma unroll
        for (int i = 0; i < 16; ++i) ogv[i] = *(const unsigned*)(OGC + (row0 + i) * 1024 + c0);
#pragma unroll
        for (int i = 0; i < 16; ++i) { part[i * 512 + tid] = o[i].x + o[i].y; part[(16 + i) * 512 + tid] = o[i].x * o[i].x + o[i].y * o[i].y; }
        __syncthreads();
#pragma unroll
        for (int q = 0; q < 4; ++q) { const int v = 4 * w + q; float s = 0.f;
#pragma unroll
            for (int r = 0; r < 8; ++r) s += part[v * 512 + lane + 64 * r];
            s = wave_sum(s); if (lane == 0) stat[v] = s; }
        __syncthreads();
#pragma unroll
        for (int i = 0; i < 16; ++i) { const float mean = stat[i] * (1.f / 1024.f), var = stat[16 + i] * (1.f / 1024.f) - mean * mean, rstd = __builtin_amdgcn_rsqf(var + 1e-5f);
            float y0 = (o[i].x - mean) * rstd * lg.x + lb.x, y1 = (o[i].y - mean) * rstd * lg.y + lb.y; y0 *= sigm(y0); y1 *= sigm(y1);
            bf16_t* gp = OGC + (row0 + i) * 1024 + c0; const unsigned og = ogv[i];
            *(unsigned*)gp = cvt_pk_bf16(y0 * bflo(og), y1 * bfhi(og)); }
    }
    const bf16_t* RK = (const bf16_t*)(p.ws + OFF_RKVL); bf16_t* AL = (bf16_t*)(p.ws + OFF_ALORA);
    for (int idx = blockIdx.x * 512 + tid; idx < T * 128; idx += gridDim.x * 512) { const int t = idx >> 7, j = idx & 127;
        const float z = bf2f(RK[(size_t)t * LDR + 3072 + j]), pv = (t & (SEQ - 1)) ? bf2f(RK[(size_t)(t - 1) * LDR + 3072 + j]) : 0.f;
        const float s = z + p.rwkv_mu[3072 + j] * (pv - z); const float val = j < 64 ? tanhf(s) : s;
        AL[(size_t)t * 128 + j] = f2bf(val); }
}
constexpr int SCH = 32, SNCH = SEQ / SCH, SREC = 272;
struct ScanRaw { unsigned v[8], wa[8]; };
struct ScanOps { f32x4 a[8], b[4], k[4]; };
struct ScanC { float mu_r, mu_k, mu_v, w0c, a0c, kkc, kac, rkc, gng, gnb; };
__device__ __forceinline__ void scan_load_raw(ScanRaw& R, f32x2 (&S)[8], const bf16_t* RK, const bf16_t* DW, const bf16_t* AP, int b, int c, int pw, int ch) {
#pragma unroll
    for (int i = 0; i < 8; ++i) { const int t = c * SCH + 8 * pw + i; const size_t row = (size_t)b * SEQ + t; const bf16_t* rp = RK + row * LDR + ch;
        const bf16_t* rq = t > 0 ? rp - LDR : rp;
        S[i >> 1][i & 1] = __uint_as_float((unsigned)rp[0] | ((unsigned)rq[0] << 16)); S[4 + (i >> 1)][i & 1] = __uint_as_float((unsigned)rp[1024] | ((unsigned)rq[1024] << 16));
        R.v[i] = (unsigned)rp[2048] | ((unsigned)rq[2048] << 16); R.wa[i] = (unsigned)DW[row * 1024 + ch] | ((unsigned)AP[row * 1024 + ch] << 16); }
}
__device__ __forceinline__ void scan_prep(const ScanRaw& R, const f32x2 (&S)[8], const ScanC& C, int c, int pw, int lane, unsigned seq, float* rec, float* vbuf, f32x4* scl, float* wtot, float* ptot, volatile unsigned* flag) {
    float kkA[8], rA[8], nbA[8], kpA[8], LA[8]; float L = 1.f;
#pragma unroll
    for (int i = 0; i < 8; ++i) { const int tt = 8 * pw + i, t = c * SCH + tt;
        const unsigned Rr = __float_as_uint(S[i >> 1][i & 1]), Rk = __float_as_uint(S[4 + (i >> 1)][i & 1]);
        float r = bflo(Rr), k = bflo(Rk), v = bflo(R.v[i]); const float pm = t > 0 ? 1.f : 0.f;
        const float r1 = pm * bfhi(Rr), k1 = pm * bfhi(Rk), v1 = pm * bfhi(R.v[i]);
        r += C.mu_r * (r1 - r); k += C.mu_k * (k1 - k); v += C.mu_v * (v1 - v);
        const float wpre = C.w0c + bflo(R.wa[i]), apre = C.a0c + bfhi(R.wa[i]);
        const float decay = __expf(-0.60653066f * sigm(wpre)), a = sigm(apre);
        const float kkv = k * C.kkc, n2 = wave_sum(kkv * kkv), kk = kkv * __builtin_amdgcn_rsqf(fmaxf(n2, 1e-24f));
        const float kp = k * (1.f + (a - 1.f) * C.kac), bv = kk * a;
        const float br = wave_sum(bv * r), kr = wave_sum(kp * r), bonus = wave_sum(r * kp * C.rkc);
        L *= decay; kkA[i] = kk; rA[i] = r; nbA[i] = -bv; kpA[i] = kp; LA[i] = L;
        vbuf[tt * 64 + lane] = v;
        if (lane == 0) scl[tt] = (f32x4){-br, kr, bonus, 0.f};
        if (i & 1) __builtin_amdgcn_sched_barrier(0);
    }
    wtot[pw * 64 + lane] = L;
    asm volatile("s_waitcnt lgkmcnt(0)" ::: "memory");
    if (lane == 0) flag[pw] = seq;
    float Pw = 1.f;
    for (int ww = 0; ww < pw; ++ww) { while (flag[ww] != seq) __builtin_amdgcn_s_sleep(1);
        asm volatile("" ::: "memory"); Pw *= wtot[ww * 64 + lane]; }
    if (pw == 3) ptot[lane] = Pw * L;
    float Pprev = Pw;
#pragma unroll
    for (int i = 0; i < 8; ++i) { const int tt = 8 * pw + i; const float Pt = Pw * LA[i], ip = __builtin_amdgcn_rcpf(Pt);
        float* rc = rec + tt * SREC + (lane >> 4) * 68; const int e = lane & 15;
        *(f32x2*)(rc + 2 * e) = (f32x2){Pprev * kkA[i], Pt * rA[i]}; rc[32 + e] = nbA[i] * ip; rc[48 + e] = kpA[i] * ip;
        Pprev = Pt; }
}
__device__ __forceinline__ void scan_post(const bf16_t (&og)[8], bf16_t* dst0, const ScanC& C, int pw, int lane, const float* obuf, const float* vbuf, const f32x4* scl) {
#pragma unroll
    for (int i = 0; i < 8; ++i) { const int tt = pw + 4 * i;
        const float o = obuf[tt * 64 + lane], mean = wave_sum(o) * (1.f / 64.f), d = o - mean, var = wave_sum(d * d) * (1.f / 64.f);
        float y = d * __builtin_amdgcn_rsqf(var + 64e-5f) * C.gng + C.gnb; y += scl[tt].z * vbuf[tt * 64 + lane];
        dst0[(size_t)i * 4096] = f2bf(y * bf2f(og[i])); }
}
__device__ __forceinline__ void scan_load_ops(ScanOps& o, const f32x4* rq) {
#pragma unroll
    for (int j = 0; j < 8; ++j) o.a[j] = rq[j];
#pragma unroll
    for (int j = 0; j < 4; ++j) { o.b[j] = rq[8 + j]; o.k[j] = rq[12 + j]; }
}
__device__ __forceinline__ void scan_step(f32x2 (&S)[8], ScanOps& q, const f32x4* rn, const float v, const bool lead, const f32x2 sc, float* obuf, float* dump, int tt, int srow) {
    f32x2 vv = {v, v}; asm volatile("" : "+v"(vv));
    f32x2 d0 = S[0].x * (f32x2){q.a[0][0], q.a[0][1]}, d1 = S[0].y * (f32x2){q.a[0][2], q.a[0][3]}, d2 = S[1].x * (f32x2){q.a[1][0], q.a[1][1]}, d3 = S[1].y * (f32x2){q.a[1][2], q.a[1][3]};
#pragma unroll
    for (int j = 2; j < 8; j += 2) { d0 += S[j].x * (f32x2){q.a[j][0], q.a[j][1]}; d1 += S[j].y * (f32x2){q.a[j][2], q.a[j][3]};
        d2 += S[j + 1].x * (f32x2){q.a[j + 1][0], q.a[j + 1][1]}; d3 += S[j + 1].y * (f32x2){q.a[j + 1][2], q.a[j + 1][3]}; }
#pragma unroll
    for (int j = 0; j < 8; ++j) q.a[j] = rn[j];
    const f32x2 d = (d0 + d1) + (d2 + d3);
    float sk = d.x, o = d.y;
    sk = dpp_add<0xB1>(sk); o = dpp_add<0xB1>(o); sk = dpp_add<0x4E>(sk); o = dpp_add<0x4E>(o);
#pragma unroll
    for (int j = 0; j < 4; ++j) { S[2 * j] += sk * (f32x2){q.b[j][0], q.b[j][1]}; S[2 * j + 1] += sk * (f32x2){q.b[j][2], q.b[j][3]}; }
#pragma unroll
    for (int j = 0; j < 4; ++j) { S[2 * j] += vv * (f32x2){q.k[j][0], q.k[j][1]}; S[2 * j + 1] += vv * (f32x2){q.k[j][2], q.k[j][3]}; }
#pragma unroll
    for (int j = 0; j < 4; ++j) { q.b[j] = rn[8 + j]; q.k[j] = rn[12 + j]; }
    LAS float* op = lead ? (LAS float*)(obuf + tt * 64 + srow) : (LAS float*)dump; *op = o + sk * sc.x + v * sc.y;
}
__device__ void phase_scan(const Params& p, unsigned char* smem) {
    const int tid = tid_opaque(), w = tid >> 6, lane = tid & 63, g = lane & 3, srow = (w & 3) * 16 + (lane >> 2), pw = w & 3;
    const bool cons = w < 4, lead = (g == 0);
    float* recb = (float*)smem;
    float* vbufb = recb + 2 * SCH * SREC;
    float* obufb = vbufb + 3 * SCH * 64;
    f32x4* sclb = (f32x4*)(obufb + 2 * SCH * 64);
    float* wtot = (float*)(sclb + 3 * SCH);
    float* ptotb = wtot + 256;
    volatile unsigned* flag = (volatile unsigned*)(ptotb + 128);
    float* dump = (float*)(ptotb + 128) + 8;
    const bf16_t* RK = (const bf16_t*)(p.ws + OFF_RKVL); const bf16_t* DW = (const bf16_t*)(p.ws + OFF_DW); const bf16_t* AP = (const bf16_t*)p.out;
    bf16_t* OGR = (bf16_t*)(p.ws + OFF_OGR);
    unsigned seq = 0;
    for (int bh = blockIdx.x; bh < 256; bh += gridDim.x) {
        const int b = bh >> 4, h = bh & 15, ch = h * 64 + lane;
        const ScanC C{p.rwkv_mu[ch], p.rwkv_mu[1024 + ch], p.rwkv_mu[2048 + ch], p.rwkv_w0[ch], p.rwkv_a0[ch], p.rwkv_k_k[ch], p.rwkv_k_a[ch], p.rwkv_r_k[ch], p.rwkv_gn_g[ch], p.rwkv_gn_b[ch]};
        f32x2 S[8];
#pragma unroll
        for (int i = 0; i < 8; ++i) S[i] = (f32x2){0.f, 0.f};
        ScanRaw R;
        if (tid < 4) flag[tid] = 0u;
        __syncthreads();
        ++seq;
        if (!cons) { scan_load_raw(R, S, RK, DW, AP, b, 0, pw, ch); scan_prep(R, S, C, 0, pw, lane, seq, recb, vbufb, sclb, wtot, ptotb, flag); scan_load_raw(R, S, RK, DW, AP, b, 1, pw, ch); }
        __syncthreads();
        for (int c = 0; c < SNCH; ++c) {
            const int cb = c & 1, c3 = c % 3, n3 = (c + 1) % 3, p3 = (c + 2) % 3;
            ++seq;
            if (cons) {
                const float* vb = vbufb + c3 * (SCH * 64); const f32x2* sc2 = (const f32x2*)(sclb + c3 * SCH); float* ob = obufb + cb * (SCH * 64);
                const f32x4* rq = (const f32x4*)(recb + cb * (SCH * SREC) + g * 68);
                ScanOps A; scan_load_ops(A, rq);
                float v0 = vb[srow]; f32x2 s0 = sc2[0];
                __builtin_amdgcn_s_setprio(3);
                for (int tt = 0; tt < SCH; ++tt) {
                    const int tn = tt + 1 < SCH ? tt + 1 : SCH - 1;
                    const float nv0 = vb[tn * 64 + srow]; const f32x2 ns0 = sc2[2 * tn];
                    scan_step(S, A, rq + tn * (SREC / 4), v0, lead, s0, ob, dump, tt, srow);
                    v0 = nv0; s0 = ns0;
                }
                __builtin_amdgcn_s_setprio(0);
                { const f32x4* pq = (const f32x4*)(ptotb + cb * 64 + g * 16);
#pragma unroll
                    for (int j = 0; j < 4; ++j) { const f32x4 pp = pq[j]; S[2 * j] *= (f32x2){pp[0], pp[1]}; S[2 * j + 1] *= (f32x2){pp[2], pp[3]}; } }
            } else {
                bf16_t og[8]; bf16_t* dst0 = OGR + ((size_t)b * SEQ + (c > 0 ? c - 1 : 0) * SCH + pw) * 1024 + ch;
#pragma unroll
                for (int i = 0; i < 8; ++i) og[i] = dst0[(size_t)i * 4096];
                if (c + 1 < SNCH) { scan_prep(R, S, C, c + 1, pw, lane, seq, recb + (cb ^ 1) * (SCH * SREC), vbufb + n3 * (SCH * 64), sclb + n3 * SCH, wtot, ptotb + (cb ^ 1) * 64, flag);
                    if (c + 2 < SNCH) scan_load_raw(R, S, RK, DW, AP, b, c + 2, pw, ch); }
                if (c > 0) scan_post(og, dst0, C, pw, lane, obufb + (cb ^ 1) * (SCH * 64), vbufb + p3 * (SCH * 64), sclb + p3 * SCH);
            }
            __syncthreads();
        }
        if (!cons) { const int cl = SNCH - 1; bf16_t og[8]; bf16_t* dst0 = OGR + ((size_t)b * SEQ + cl * SCH + pw) * 1024 + ch;
#pragma unroll
            for (int i = 0; i < 8; ++i) og[i] = dst0[(size_t)i * 4096];
            scan_post(og, dst0, C, pw, lane, obufb + (cl & 1) * (SCH * 64), vbufb + (cl % 3) * (SCH * 64), sclb + (cl % 3) * SCH); }
        __syncthreads();
    }
}
__device__ void phase_final(const Params& p) {
    const int tid = tid_opaque(), w = tid >> 6, lane = tid & 63;
    for (int tok = blockIdx.x * 8 + w; tok < T; tok += gridDim.x * 8) {
        float* xr = p.out + (size_t)tok * 1024; f32x4 v[4]; float ss = 0.f;
#pragma unroll
        for (int q = 0; q < 4; ++q) { v[q] = *(const f32x4*)(xr + q * 256 + lane * 4); ss += v[q][0] * v[q][0] + v[q][1] * v[q][1] + v[q][2] * v[q][2] + v[q][3] * v[q][3]; }
        ss = wave_sum(ss); const float rstd = rsqrtf(ss * (1.f / 1024.f) + 1e-6f);
#pragma unroll
        for (int q = 0; q < 4; ++q) { const int col = q * 256 + lane * 4; *(f32x4*)(xr + col) = v[q] * rstd * *(const f32x4*)(p.final_g + col); }
    }
}

template <int FIRST, int LAST> __global__ __launch_bounds__(512, 2) void mega(Params p) {
    extern __shared__ __attribute__((aligned(16))) unsigned char smem[];
    LAS unsigned char* lds = (LAS unsigned char*)smem;
    cg::grid_group grid = cg::this_grid();
    unsigned* bar = (unsigned*)(uniform_ptr(p.ws) + OFF_BAR);
    volatile LAS unsigned* st = (volatile LAS unsigned*)(lds + LDS_BYTES);
    if (threadIdx.x == 0) { st[0] = 0u; st[1] = 0u; (void)xb_add(&bar[XB_XCNT(xb_xcc_id())], 1u); }
    __syncthreads();
    if (p.ws == nullptr) grid.sync();
    unsigned char* ws = p.ws;
    const int G = gridDim.x, c = blockIdx.x;
    if (FIRST <= 0 && 0 < LAST) { phase_mod(p, smem); phase_weights(p, smem); }
    if (FIRST <= 1 && 1 < LAST) { if (FIRST < 1) grid_barrier(bar, st); phase_h(p); }
    if (FIRST <= 2 && 2 < LAST) { if (FIRST < 2) grid_barrier(bar, st);
        pg8::Sched1 S{T / 256, N1 / 256, G, c, (const char*)p.out, (const char*)(ws + OFF_WINT), (size_t)256 * 1024 * 2};
        EpiG1 E{ws, (unsigned char*)p.out};
        pg8::gemm_phase(lds, 1024, S, E); }
    if (FIRST <= 3 && 3 < LAST) { if (FIRST < 3) grid_barrier(bar, st); phase_conv(p, smem); }
    if (FIRST <= 4 && 4 < LAST) { if (FIRST < 4) grid_barrier(bar, st);
        pg8::Sched1 S{T / 256, 2048 / 256, G, c, (const char*)(ws + OFF_ALORA), (const char*)(ws + OFF_LBT), (size_t)256 * 128 * 2};
        EpiLora E{(bf16_t*)(ws + OFF_DW), (bf16_t*)p.out};
        pg8::gemm_phase(lds, 128, S, E); }
    if (FIRST <= 5 && 5 < LAST) { if (FIRST < 5) grid_barrier(bar, st); phase_scan(p, smem); }
    if (FIRST <= 6 && 6 < LAST) { if (FIRST < 6) grid_barrier(bar, st);
        pg8::Sched2 S{T / 256, 4, G, c, (const char*)(ws + OFF_OGC), (const char*)(ws + OFF_OGR), (const char*)(ws + OFF_W2T), (const char*)(ws + OFF_W2T + 2 * MiB), (size_t)256 * 1024 * 2};
        EpiG2 E{(const bf16_t*)(ws + OFF_GC), (const bf16_t*)((unsigned char*)p.out + 64 * MiB), (bf16_t*)(ws + OFF_M)};
        pg8::gemm_phase(lds, 1024, S, E); }
    if (FIRST <= 7 && 7 < LAST) { if (FIRST < 7) grid_barrier(bar, st);
        pg8::Sched1 S{T / 256, 4, G, c, (const char*)(ws + OFF_M), (const char*)(ws + OFF_WOT), (size_t)256 * 1024 * 2};
        EpiG3 E{p.x, (const float*)(ws + OFF_MOD), p.final_g, p.out, (float*)(ws + OFF_ROWSS), (unsigned*)(ws + OFF_PCNT)};
        pg8::gemm_phase(lds, 1024, S, E); }
}

template <int PH> static void launch_one(const Params& p, hipStream_t stream) {
    hipFuncSetAttribute((const void*)mega<PH, PH + 1>, hipFuncAttributeMaxDynamicSharedMemorySize, LDS_BYTES);
    mega<PH, PH + 1><<<256, 512, LDS_BYTES, stream>>>(p);
}

extern "C" void kernel_launch(void* const* d_in, const int* in_sizes, int n_in, void* d_out, int out_size, void* d_ws, size_t ws_size, hipStream_t stream) {
    Params p{};
    const float** f = (const float**)&p;
    for (int i = 0; i < 24; ++i) f[i] = (const float*)d_in[i];
    p.out = (float*)d_out; p.ws = (unsigned char*)d_ws;
    if (ws_size < WS_END) { fprintf(stderr, "workspace too small: %zu < %zu\n", ws_size, (size_t)WS_END); return; }
#if SINGLE_LAUNCH
    static int grid_blocks = 0;
    if (!grid_blocks) {
        int dev = 0, cus = 0, per_cu = 0;
        hipGetDevice(&dev);
        hipDeviceGetAttribute(&cus, hipDeviceAttributeMultiprocessorCount, dev);
        hipFuncSetAttribute((const void*)mega<0, NPHASE>, hipFuncAttributeMaxDynamicSharedMemorySize, LDS_BYTES + 16);
        hipOccupancyMaxActiveBlocksPerMultiprocessor(&per_cu, mega<0, NPHASE>, 512, LDS_BYTES + 16);
        grid_blocks = cus * (per_cu > 1 ? 1 : per_cu);
        if (grid_blocks > 256) grid_blocks = 256;
    }
    hipMemsetAsync((unsigned char*)d_ws + OFF_BAR, 0, 3456 * 4, stream);
    void* args[] = {(void*)&p};
    hipError_t e = hipLaunchCooperativeKernel((const void*)mega<0, NPHASE>, dim3(grid_blocks), dim3(512), args, LDS_BYTES + 16, stream);
    if (e != hipSuccess) fprintf(stderr, "cooperative launch failed: %s (grid %d)\n", hipGetErrorString(e), grid_blocks);
#else
    launch_one<0>(p, stream); launch_one<1>(p, stream); launch_one<2>(p, stream); launch_one<3>(p, stream); launch_one<4>(p, stream);
    launch_one<5>(p, stream); launch_one<6>(p, stream); launch_one<7>(p, stream); launch_one<8>(p, stream);
#endif
}
```
